# Optimizing an MI355X kernel written in HIP

```python
import math
import jax
import jax.numpy as jnp
from jax import lax
import numpy as np

D_MODEL = 2048
BATCH = 4
SEQ = 2048
DEPTH = 2

EPS = 1e-6
EXPAND = 2
MIX = EXPAND * D_MODEL
N_EVEN = (DEPTH + 1) // 2
N_ODD = DEPTH // 2

CONV_W = MIX // 2
CONV_K = 3

HEAD_DIM = 128
N_HEADS = (MIX // 2) // HEAD_DIM
N_KV = 4
GQA = N_HEADS // N_KV
ROT_DIM = HEAD_DIM // 4
ROPE_THETA = 500000.0
CMP_LEN = 32
CMP_STRIDE = 16
SLC_LEN = 64
N_SEL = 8
WINDOW = 512
Q_BLOCK = 64

L0_SIZES = (CONV_W, CONV_W, CONV_W, CONV_W,
            N_HEADS * HEAD_DIM,
            N_KV * HEAD_DIM, N_KV * HEAD_DIM, N_KV * HEAD_DIM,
            N_KV * HEAD_DIM, N_KV * HEAD_DIM, N_KV * HEAD_DIM,
            3 * N_HEADS,
            N_HEADS * HEAD_DIM)
L0_IN = 4 * CONV_W + 2 * N_HEADS * HEAD_DIM + 6 * N_KV * HEAD_DIM + 3 * N_HEADS

SGU_W = MIX
CHUNK = 128
N_GROUPS = 16
GROUP_W = SGU_W // N_GROUPS

kernel_name = "hybrid_conv_nsa_chunked_gmlp"


def rms_norm(x, g):
    x32 = x.astype(jnp.float32)
    y = x32 * lax.rsqrt(jnp.mean(x32 * x32, axis=-1, keepdims=True) + EPS)
    return (y * g.astype(jnp.float32)).astype(x.dtype)


def layer_norm(x, g, b):
    x32 = x.astype(jnp.float32)
    mu = jnp.mean(x32, axis=-1, keepdims=True)
    xc = x32 - mu
    y = xc * lax.rsqrt(jnp.mean(xc * xc, axis=-1, keepdims=True) + EPS)
    return (y * g.astype(jnp.float32) + b.astype(jnp.float32)).astype(x.dtype)


def masked_softmax(s, mask):
    s = jnp.where(mask, s.astype(jnp.float32), -jnp.inf)
    m = jnp.max(s, axis=-1, keepdims=True)
    m = jnp.where(jnp.isfinite(m), m, 0.0)
    e = jnp.exp(s - m)
    den = jnp.sum(e, axis=-1, keepdims=True)
    return e / jnp.where(den > 0, den, 1.0)


def partial_rotary(x, pos):
    half = ROT_DIM // 2
    inv_freq = jnp.power(ROPE_THETA, -jnp.arange(half, dtype=jnp.float32) * 2.0 / ROT_DIM)
    ang = pos.astype(jnp.float32)[:, None] * inv_freq[None, :]
    cos = jnp.cos(ang).astype(x.dtype)
    sin = jnp.sin(ang).astype(x.dtype)
    x1 = x[..., :half]
    x2 = x[..., half:ROT_DIM]
    return jnp.concatenate([x1 * cos - x2 * sin, x2 * cos + x1 * sin, x[..., ROT_DIM:]], axis=-1)


def split_cols(z, sizes):
    offs = []
    acc = 0
    for s in sizes[:-1]:
        acc += s
        offs.append(acc)
    return jnp.split(z, offs, axis=-1)


def short_conv(h, w):
    return lax.conv_general_dilated(
        h, w[:, None, :].astype(h.dtype), window_strides=(1,),
        padding=[(CONV_K - 1, 0)], dimension_numbers=("NWC", "WIO", "NWC"),
        feature_group_count=h.shape[-1])


def compress(k, pos_emb, w1, b1, w2):
    T = k.shape[2]
    n_cmp = (T - CMP_LEN) // CMP_STRIDE + 1
    idx = jnp.arange(n_cmp)[:, None] * CMP_STRIDE + jnp.arange(CMP_LEN)[None, :]
    blocks = k[:, :, idx] + pos_emb
    flat = blocks.reshape(blocks.shape[0], blocks.shape[1], n_cmp, CMP_LEN * HEAD_DIM)
    return jax.nn.silu(flat @ w1 + b1) @ w2


def nsa_mixer(q, k_cmp, v_cmp, k_slc, v_slc, k_win, v_win, gate_logits,
              ck_pos, ck_w1, ck_b1, ck_w2, cv_pos, cv_w1, cv_b1, cv_w2):
    Bsz, T = q.shape[0], q.shape[1]
    pos = jnp.arange(T)
    scale = HEAD_DIM ** -0.5
    q = q.reshape(Bsz, T, N_KV, GQA, HEAD_DIM).transpose(0, 2, 3, 1, 4)

    def kv(a):
        return a.reshape(Bsz, T, N_KV, HEAD_DIM).transpose(0, 2, 1, 3)

    k_cmp, v_cmp, k_slc, v_slc, k_win, v_win = (kv(a) for a in (k_cmp, v_cmp, k_slc, v_slc, k_win, v_win))
    q_rot = partial_rotary(q, pos)
    k_slc = partial_rotary(k_slc, pos)
    k_win = partial_rotary(k_win, pos)

    kc = compress(k_cmp, ck_pos, ck_w1, ck_b1, ck_w2)
    vc = compress(v_cmp, cv_pos, cv_w1, cv_b1, cv_w2)
    n_cmp = kc.shape[2]
    cmp_start = jnp.arange(n_cmp) * CMP_STRIDE
    cmp_mask = (cmp_start + CMP_LEN - 1)[None, :] <= pos[:, None]
    s_c = jnp.einsum("bgntd,bgcd->bgntc", q, kc) * scale
    p_c = masked_softmax(s_c, cmp_mask)
    o_c = jnp.einsum("bgntc,bgcd->bgntd", p_c.astype(vc.dtype), vc)

    n_blk = T // SLC_LEN
    n_sel = min(N_SEL, n_blk)
    blk = jnp.arange(n_blk)
    blk_start = blk * SLC_LEN
    overlap = ((cmp_start[:, None] < blk_start[None, :] + SLC_LEN)
               & (cmp_start[:, None] + CMP_LEN > blk_start[None, :])).astype(jnp.float32)
    imp = jnp.einsum("bgtc,cj->bgtj", jnp.sum(p_c, axis=2), overlap)
    forced = (blk[None, :] == 0) | (blk[None, :] == (pos // SLC_LEN)[:, None])
    causal_blk = blk_start[None, :] <= pos[:, None]
    imp = jnp.where(forced, jnp.inf, jnp.where(causal_blk, imp, -jnp.inf))
    sel_val, sel_idx = lax.top_k(imp, n_sel)
    sel_ok = sel_val > -jnp.inf

    n_qb = T // Q_BLOCK
    q_blocks = jnp.moveaxis(q_rot.reshape(Bsz, N_KV, GQA, n_qb, Q_BLOCK, HEAD_DIM), 3, 0)
    idx_blocks = jnp.moveaxis(sel_idx.reshape(Bsz, N_KV, n_qb, Q_BLOCK, n_sel), 2, 0)
    ok_blocks = jnp.moveaxis(sel_ok.reshape(Bsz, N_KV, n_qb, Q_BLOCK, n_sel), 2, 0)

    kb = k_slc.reshape(Bsz, N_KV, n_blk, SLC_LEN, HEAD_DIM)
    vb = v_slc.reshape(Bsz, N_KV, n_blk, SLC_LEN, HEAD_DIM)
    take = jax.vmap(jax.vmap(lambda a, i: a[i]))
    k_win_pad = jnp.pad(k_win, ((0, 0), (0, 0), (WINDOW, 0), (0, 0)))
    v_win_pad = jnp.pad(v_win, ((0, 0), (0, 0), (WINDOW, 0), (0, 0)))
    offs = jnp.arange(SLC_LEN)
    n_keys = n_sel * SLC_LEN

    def block_step(args):
        qb, ib, okb, i = args
        start = i * Q_BLOCK
        tb = start + jnp.arange(Q_BLOCK)
        kg = take(kb, ib).reshape(Bsz, N_KV, Q_BLOCK, n_keys, HEAD_DIM)
        vg = take(vb, ib).reshape(Bsz, N_KV, Q_BLOCK, n_keys, HEAD_DIM)
        kpos = (ib[..., None] * SLC_LEN + offs).reshape(Bsz, N_KV, Q_BLOCK, n_keys)
        okk = jnp.broadcast_to(okb[..., None], okb.shape + (SLC_LEN,)).reshape(Bsz, N_KV, Q_BLOCK, n_keys)
        smask = (okk & (kpos <= tb[:, None]))[:, :, None]
        s_s = jnp.einsum("bgnqd,bgqmd->bgnqm", qb, kg) * scale
        p_s = masked_softmax(s_s, smask)
        o_s = jnp.einsum("bgnqm,bgqmd->bgnqd", p_s.astype(vg.dtype), vg)
        kw = lax.dynamic_slice_in_dim(k_win_pad, start, WINDOW + Q_BLOCK, axis=2)
        vw = lax.dynamic_slice_in_dim(v_win_pad, start, WINDOW + Q_BLOCK, axis=2)
        wpos = start - WINDOW + jnp.arange(WINDOW + Q_BLOCK)
        diff = tb[:, None] - wpos[None, :]
        wmask = (wpos[None, :] >= 0) & (diff >= 0) & (diff < WINDOW)
        s_w = jnp.einsum("bgnqd,bgkd->bgnqk", qb, kw) * scale
        p_w = masked_softmax(s_w, wmask)
        o_w = jnp.einsum("bgnqk,bgkd->bgnqd", p_w.astype(vw.dtype), vw)
        return (o_s, o_w)

    o_s, o_w = lax.map(block_step, (q_blocks, idx_blocks, ok_blocks, jnp.arange(n_qb)))
    o_s = jnp.moveaxis(o_s, 0, 3).reshape(Bsz, N_KV, GQA, T, HEAD_DIM)
    o_w = jnp.moveaxis(o_w, 0, 3).reshape(Bsz, N_KV, GQA, T, HEAD_DIM)

    g = jax.nn.sigmoid(gate_logits.astype(jnp.float32)).astype(q.dtype)
    g = g.reshape(Bsz, T, 3, N_KV, GQA).transpose(2, 0, 3, 4, 1)[..., None]
    o = g[0] * o_c + g[1] * o_s + g[2] * o_w
    return o.transpose(0, 3, 1, 2, 4).reshape(Bsz, T, N_HEADS * HEAD_DIM)


def conv_nsa_layer(h, w_in, conv_w, ck_pos, ck_w1, ck_b1, ck_w2,
                   cv_pos, cv_w1, cv_b1, cv_w2, w_out):
    z = h @ w_in
    (cb, cc, ch, cg, q, kc, vc, ks, vs, kw, vw, gl, ng) = split_cols(z, L0_SIZES)
    y_conv = cb * short_conv(cc * ch, conv_w) * jax.nn.silu(cg)
    y_nsa = nsa_mixer(q, kc, vc, ks, vs, kw, vw, gl,
                      ck_pos, ck_w1, ck_b1, ck_w2, cv_pos, cv_w1, cv_b1, cv_w2) * jax.nn.silu(ng)
    return jnp.concatenate([y_conv, y_nsa], axis=-1) @ w_out


def chunked_gmlp_layer(h, w_in, ln_g, ln_b, w_s, b_s, w_out):
    Bsz, T = h.shape[0], h.shape[1]
    u, v, zg = jnp.split(h @ w_in, 3, axis=-1)
    v = layer_norm(v, ln_g, ln_b)
    v = v.reshape(Bsz, T // CHUNK, CHUNK, N_GROUPS, GROUP_W)
    tri = jnp.tril(jnp.ones((CHUNK, CHUNK), dtype=bool))
    ws = jnp.where(tri, w_s, 0.0)
    mix = jnp.einsum("hts,bcshd->bcthd", ws, v) + b_s.T[None, None, :, :, None]
    mix = mix.reshape(Bsz, T, SGU_W)
    return (u * mix * jax.nn.silu(zg)) @ w_out


def setup_inputs(seed: int = 0) -> dict:
    key = jax.random.key(seed)
    ks = jax.random.split(key, 24)
    f32 = jnp.float32
    ne, no = N_EVEN, N_ODD

    def nrm(k, shape, scale):
        return jax.random.normal(k, shape, f32) * scale

    return {
        "x": nrm(ks[0], (BATCH, SEQ, D_MODEL), 1.0),
        "norm_even": 1.0 + nrm(ks[1], (ne, D_MODEL), 0.02),
        "w_in_even": nrm(ks[2], (ne, D_MODEL, L0_IN), D_MODEL ** -0.5),
        "conv_w": nrm(ks[3], (ne, CONV_K, CONV_W), CONV_K ** -0.5),
        "cmp_k_pos": nrm(ks[4], (ne, CMP_LEN, HEAD_DIM), 0.1),
        "cmp_k_w1": nrm(ks[5], (ne, CMP_LEN * HEAD_DIM, HEAD_DIM), (CMP_LEN * HEAD_DIM) ** -0.5),
        "cmp_k_b1": nrm(ks[6], (ne, HEAD_DIM), 0.01),
        "cmp_k_w2": nrm(ks[7], (ne, HEAD_DIM, HEAD_DIM), HEAD_DIM ** -0.5),
        "cmp_v_pos": nrm(ks[8], (ne, CMP_LEN, HEAD_DIM), 0.1),
        "cmp_v_w1": nrm(ks[9], (ne, CMP_LEN * HEAD_DIM, HEAD_DIM), (CMP_LEN * HEAD_DIM) ** -0.5),
        "cmp_v_b1": nrm(ks[10], (ne, HEAD_DIM), 0.01),
        "cmp_v_w2": nrm(ks[11], (ne, HEAD_DIM, HEAD_DIM), HEAD_DIM ** -0.5),
        "w_out_even": nrm(ks[12], (ne, MIX, D_MODEL), MIX ** -0.5),
        "norm_odd": 1.0 + nrm(ks[13], (no, D_MODEL), 0.02),
        "w_in_odd": nrm(ks[14], (no, D_MODEL, 3 * SGU_W), D_MODEL ** -0.5),
        "sgu_ln_g": 1.0 + nrm(ks[15], (no, SGU_W), 0.02),
        "sgu_ln_b": nrm(ks[16], (no, SGU_W), 0.01),
        "sgu_w_s": nrm(ks[17], (no, N_GROUPS, CHUNK, CHUNK), CHUNK ** -0.5),
        "sgu_b_s": 1.0 + nrm(ks[18], (no, N_GROUPS, CHUNK), 0.02),
        "w_out_odd": nrm(ks[19], (no, SGU_W, D_MODEL), SGU_W ** -0.5),
        "norm_final": 1.0 + nrm(ks[20], (D_MODEL,), 0.02),
    }


def reference(x, norm_even, w_in_even, conv_w, cmp_k_pos, cmp_k_w1, cmp_k_b1, cmp_k_w2,
              cmp_v_pos, cmp_v_w1, cmp_v_b1, cmp_v_w2, w_out_even,
              norm_odd, w_in_odd, sgu_ln_g, sgu_ln_b, sgu_w_s, sgu_b_s, w_out_odd,
              norm_final):
    for layer in range(DEPTH):
        j = layer // 2
        if layer % 2 == 0:
            h = rms_norm(x, norm_even[j])
            x = x + conv_nsa_layer(h, w_in_even[j], conv_w[j],
                                   cmp_k_pos[j], cmp_k_w1[j], cmp_k_b1[j], cmp_k_w2[j],
                                   cmp_v_pos[j], cmp_v_w1[j], cmp_v_b1[j], cmp_v_w2[j],
                                   w_out_even[j])
        else:
            h = rms_norm(x, norm_odd[j])
            x = x + chunked_gmlp_layer(h, w_in_odd[j], sgu_ln_g[j], sgu_ln_b[j],
                                       sgu_w_s[j], sgu_b_s[j], w_out_odd[j])
    return rms_norm(x, norm_final)
```

```cpp
#include <hip/hip_runtime.h>
#include <hip/hip_cooperative_groups.h>
#include <cstdio>
#include <cstdint>
namespace cg = cooperative_groups;

#define LAS __attribute__((address_space(3)))
typedef unsigned short bf16_t;
typedef short bf16x8 __attribute__((ext_vector_type(8)));
typedef float f32x4 __attribute__((ext_vector_type(4)));
typedef float f32x2 __attribute__((ext_vector_type(2)));
typedef unsigned u32x4 __attribute__((ext_vector_type(4)));
typedef unsigned u32x2 __attribute__((ext_vector_type(2)));

constexpr int DM = 2048, NB = 4, SEQ = 2048, MTOK = NB * SEQ;
constexpr int N0 = 15616, N0_SRC = 15408;
constexpr int N1 = 12288, MIXW = 4096;
constexpr int ZC_LD = 8192;
constexpr float EPS = 1e-6f;
constexpr int NKV = 4, HD = 128, NH = 16;
constexpr int NCMP = 127;

constexpr size_t MiB = 1u << 20;
constexpr size_t WS_RSTD0 = 1 * MiB, WS_SS1 = WS_RSTD0 + 32768, WS_LNS = WS_SS1 + 32768, WS_COS = WS_LNS + 65536, WS_SIN = WS_COS + 131072;
constexpr size_t WS_KC = 2 * MiB, WS_VC = 3 * MiB;
constexpr size_t WS_GL = 4 * MiB;
constexpr size_t WS_WT0 = 6 * MiB, WS_WTO0 = 67 * MiB, WS_WT1 = 83 * MiB, WS_WTO1 = 131 * MiB;
constexpr size_t WS_XB = 147 * MiB;
constexpr size_t WS_NG = 179 * MiB;
constexpr size_t WS_ZC = 211 * MiB;
constexpr size_t WS_Q = 339 * MiB;
constexpr size_t WS_KV = 371 * MiB;
constexpr size_t KV_ELEMS = (size_t)MTOK * 512;
constexpr size_t WS_END = 419 * MiB;
constexpr size_t WS_Z1 = WS_ZC;
static_assert(WS_Z1 + (size_t)MTOK * N1 * 2 <= WS_END, "z1 overlay");

constexpr int NWAVES = 8, NTHREADS = 512;
constexpr int LDS_BYTES = 147456;

struct Args { const float* in[21]; float* out; unsigned char* ws; int ph_lo, ph_hi; };

__device__ __forceinline__ float bf_lo(unsigned u) { return __uint_as_float(u << 16); }
__device__ __forceinline__ float bf_hi(unsigned u) { return __uint_as_float(u & 0xffff0000u); }
__device__ __forceinline__ float bf2f(bf16_t b) { return __uint_as_float((unsigned)b << 16); }
__device__ __forceinline__ unsigned f2bf(float f) { unsigned u = __float_as_uint(f); return (u + 0x7fffu + ((u >> 16) & 1u)) >> 16; }
__device__ __forceinline__ unsigned pk2(float lo, float hi) { return f2bf(lo) | (f2bf(hi) << 16); }
__device__ __forceinline__ unsigned cvt_pk_bf16(float lo, float hi) { unsigned r; asm volatile("v_cvt_pk_bf16_f32 %0, %1, %2" : "=v"(r) : "v"(lo), "v"(hi)); return r; }
__device__ __forceinline__ float silu_f(float x) { return x / (1.f + __expf(-x)); }
__device__ __forceinline__ float sigmoid_f(float x) { return 1.f / (1.f + __expf(-x)); }
__device__ __forceinline__ float wave_sum(float v) {
#pragma unroll
    for (int o = 1; o < 64; o <<= 1) v += __shfl_xor(v, o);
    return v;
}
__device__ __forceinline__ float wave_max(float v) {
#pragma unroll
    for (int o = 1; o < 64; o <<= 1) v = fmaxf(v, __shfl_xor(v, o));
    return v;
}
__device__ __forceinline__ int colmap0(int nd) { return nd < 13312 ? nd : (nd < 15360 ? nd + 48 : (nd < 15408 ? nd - 2048 : -1)); }

namespace pg8 {
#define PG8_LAS __attribute__((address_space(3)))
constexpr int BM = 256, BK = 64, HALF = 128, HTB = HALF * BK * 2  , STAGE_BYTES = 8 * HTB, NXCD = 8, WGM = 8;

__host__ __device__ __forceinline__ int lds_byte(int r, int c) { const int st = (r >> 4) * 2 + (c >> 5), rr = r & 15, cc = c & 31, ob = rr * 64 + cc * 2; return st * 1024 + (ob ^ (((ob >> 9) & 1) << 5)); }
__host__ __device__ __forceinline__ void stage_rc(int b, int& R, int& C) { const int st = b / 1024, sb = b % 1024, swz = sb ^ (((sb >> 9) & 1) << 5); R = (st >> 1) * 16 + swz / 64; C = (st & 1) * 32 + (swz % 64) / 2; }
__host__ __device__ __forceinline__ int perm32(int rho) { const int n = rho >> 4, i = rho & 15; return 8 * (i >> 2) + 4 * n + (i & 3); }

struct Unit { int pm, pn; };
struct Gemm { const bf16_t* A; const bf16_t* Bt; int M, N, K, lda; };

struct StaticOrder {
    int nM, nN, nwg, G, c;
    __host__ __device__ void init(int M, int N, int G_, int c_) { nM = M / BM; nN = N / BM; nwg = nM * nN; G = G_; c = c_; }
    __host__ __device__ bool next(int i, Unit& u) const {
        const long L = (long)i * G + c; if (L >= nwg) return false;
        int wgid = (int)L; { const int q = nwg / NXCD, r = nwg % NXCD, xcd = wgid % NXCD, off = wgid / NXCD; wgid = (xcd < r ? xcd * (q + 1) : r * (q + 1) + (xcd - r) * q) + off; }
        const int nig = WGM * nN, gid = wgid / nig, fm = gid * WGM, gsz = (nM - fm) < WGM ? (nM - fm) : WGM;
        u.pm = fm + ((wgid % nig) % gsz); u.pn = (wgid % nig) / gsz; return true;
    }
    __device__ __forceinline__ void a_ready(const Unit&) const {}
    __device__ __forceinline__ void done(const Unit&) const {}
};


struct Epi0 {
    static constexpr bool PERM = true, AFTER_DRAIN = false;
    const float* rstd; bf16_t* ZC; bf16_t* Q; bf16_t* KV; bf16_t* NG; float* GL; const float* COS; const float* SIN;
    __device__ __forceinline__ void operator()(const f32x4 (&acc)[2][2][4][2], const Unit& u, int wr, int wc, int fr, int fq) const {
        const int pn = u.pn;
        const int rowb = u.pm * BM + wr * 64 + fr;
        const int cl = wc * 32 + 8 * fq;
        const bool rot = (pn == 44 || pn == 45 || pn == 48 || pn == 49) && (wc == 0);
#pragma unroll
        for (int ai = 0; ai < 2; ++ai)
#pragma unroll
            for (int m = 0; m < 4; ++m) {
                const int row = rowb + ai * HALF + m * 16;
                const float rs = rstd[row];
                const int t = row & (SEQ - 1), b = row >> 11;
                f32x4 cs0, cs1, sn0, sn1;
                if (rot) { const float* cp = COS + t * 16 + 8 * (fq & 1); const float* sp = SIN + t * 16 + 8 * (fq & 1);
                    cs0 = *(const f32x4*)cp; cs1 = *(const f32x4*)(cp + 4); sn0 = *(const f32x4*)sp; sn1 = *(const f32x4*)(sp + 4); }
#pragma unroll
                for (int bj = 0; bj < 2; ++bj) {
                    f32x4 v0 = acc[ai][bj][m][0] * rs, v1 = acc[ai][bj][m][1] * rs;
                    if (rot) {
                        f32x4 p0, p1;
#pragma unroll
                        for (int j = 0; j < 4; ++j) { p0[j] = __shfl_xor(v0[j], 32); p1[j] = __shfl_xor(v1[j], 32); }
                        if (fq < 2) { v0 = v0 * cs0 - p0 * sn0; v1 = v1 * cs1 - p1 * sn1; }
                        else        { v0 = v0 * cs0 + p0 * sn0; v1 = v1 * cs1 + p1 * sn1; }
                    }
                    const int c = cl + bj * HALF;
                    if (pn == 60) {
                        if (c < 48) { float* gp = GL + (size_t)row * 48 + c; *(f32x4*)gp = v0; *(f32x4*)(gp + 4) = v1; }
                    } else {
                        u32x4 w; w.x = cvt_pk_bf16(v0[0], v0[1]); w.y = cvt_pk_bf16(v0[2], v0[3]); w.z = cvt_pk_bf16(v1[0], v1[1]); w.w = cvt_pk_bf16(v1[2], v1[3]);
                        bf16_t* dst;
                        if (pn < 32) dst = ZC + (size_t)row * ZC_LD + pn * BM + c;
                        else if (pn < 40) dst = Q + (size_t)row * DM + (pn - 32) * BM + c;
                        else if (pn < 52) { const int which = (pn - 40) >> 1, g = ((pn - 40) & 1) * 2 + bj;
                            dst = KV + (size_t)which * KV_ELEMS + ((size_t)((b * NKV + g) * SEQ + t)) * HD + cl; }
                        else dst = NG + (size_t)row * DM + (pn - 52) * BM + c;
                        *(u32x4*)dst = w;
                    }
                }
            }
    }
};

struct EpiOut0 {
    static constexpr bool PERM = false, AFTER_DRAIN = false;
    const float* X; float* X1; bf16_t* X1B; float* SS;
    __device__ __forceinline__ void operator()(const f32x4 (&acc)[2][2][4][2], const Unit& u, int wr, int wc, int fr, int fq) const {
        const int rowb = u.pm * BM + wr * 64 + fr, colb = u.pn * BM + wc * 32 + 4 * fq;
#pragma unroll
        for (int ai = 0; ai < 2; ++ai)
#pragma unroll
            for (int m = 0; m < 4; ++m) {
                const int row = rowb + ai * HALF + m * 16; float ss = 0.f;
#pragma unroll
                for (int bj = 0; bj < 2; ++bj)
#pragma unroll
                    for (int n = 0; n < 2; ++n) {
                        const size_t off = (size_t)row * DM + colb + bj * HALF + n * 16;
                        const f32x4 x1 = *(const f32x4*)(X + off) + acc[ai][bj][m][n];
                        *(f32x4*)(X1 + off) = x1;
                        u32x2 w; w.x = cvt_pk_bf16(x1[0], x1[1]); w.y = cvt_pk_bf16(x1[2], x1[3]); *(u32x2*)(X1B + off) = w;
                        ss += (x1[0] * x1[0] + x1[1] * x1[1]) + (x1[2] * x1[2] + x1[3] * x1[3]);
                    }
                ss += __shfl_xor(ss, 16); ss += __shfl_xor(ss, 32);
                if (fq == 0) atomicAdd(SS + row, ss);
            }
    }
};

struct Epi1 {
    static constexpr bool PERM = true, AFTER_DRAIN = false;
    const float* SS; bf16_t* Z1; float* LNS;
    __device__ __forceinline__ void operator()(const f32x4 (&acc)[2][2][4][2], const Unit& u, int wr, int wc, int fr, int fq) const {
        const int rowb = u.pm * BM + wr * 64 + fr, colb = u.pn * BM + wc * 32 + 8 * fq;
        const bool isv = (u.pn >= 16 && u.pn < 32);
#pragma unroll
        for (int ai = 0; ai < 2; ++ai)
#pragma unroll
            for (int m = 0; m < 4; ++m) {
                const int row = rowb + ai * HALF + m * 16;
                const float rs = __builtin_amdgcn_rsqf(SS[row] * (1.0f / DM) + EPS);
                float s1 = 0.f, s2 = 0.f;
#pragma unroll
                for (int bj = 0; bj < 2; ++bj) {
                    const f32x4 v0 = acc[ai][bj][m][0] * rs, v1 = acc[ai][bj][m][1] * rs;
                    u32x4 w; w.x = cvt_pk_bf16(v0[0], v0[1]); w.y = cvt_pk_bf16(v0[2], v0[3]); w.z = cvt_pk_bf16(v1[0], v1[1]); w.w = cvt_pk_bf16(v1[2], v1[3]);
                    *(u32x4*)(Z1 + (size_t)row * N1 + colb + bj * HALF) = w;
                    s1 += (v0[0] + v0[1]) + (v0[2] + v0[3]) + (v1[0] + v1[1]) + (v1[2] + v1[3]);
                    s2 += (v0[0] * v0[0] + v0[1] * v0[1]) + (v0[2] * v0[2] + v0[3] * v0[3]) + (v1[0] * v1[0] + v1[1] * v1[1]) + (v1[2] * v1[2] + v1[3] * v1[3]);
                }
                if (isv) {
                    s1 += __shfl_xor(s1, 16); s1 += __shfl_xor(s1, 32); s2 += __shfl_xor(s2, 16); s2 += __shfl_xor(s2, 32);
                    if (fq == 0) { atomicAdd(LNS + 2 * row, s1); atomicAdd(LNS + 2 * row + 1, s2); }
                }
            }
    }
};

struct EpiOut1 {
    static constexpr bool PERM = false, AFTER_DRAIN = false;
    float* OUT;
    __device__ __forceinline__ void operator()(const f32x4 (&acc)[2][2][4][2], const Unit& u, int wr, int wc, int fr, int fq) const {
        const int rowb = u.pm * BM + wr * 64 + fr, colb = u.pn * BM + wc * 32 + 4 * fq;
#pragma unroll
        for (int ai = 0; ai < 2; ++ai)
#pragma unroll
            for (int m = 0; m < 4; ++m) {
                const int row = rowb + ai * HALF + m * 16;
#pragma unroll
                for (int bj = 0; bj < 2; ++bj)
#pragma unroll
                    for (int n = 0; n < 2; ++n) {
                        float* p = OUT + (size_t)row * DM + colb + bj * HALF + n * 16;
                        *(f32x4*)p = *(const f32x4*)p + acc[ai][bj][m][n];
                    }
            }
    }
};

template <class Epi, class Sched, bool ALIGN_EPI = false, bool SP2 = false>
__device__ __forceinline__ void gemm_phase(PG8_LAS unsigned char* lds, const Gemm g, const Sched& S, const Epi& E) {
    const int tid = threadIdx.x, wid = __builtin_amdgcn_readfirstlane(tid >> 6), lane = tid & 63, wr = wid >> 2, wc = wid & 3, fr = lane & 15, fq = lane >> 4;
    const int K = g.K, nt = K / BK;
    unsigned voffA[2], voffB[2];
#pragma unroll
    for (int i = 0; i < 2; ++i) { int R, C; stage_rc(tid * 16 + i * 8192, R, C); const int Rb = Epi::PERM ? ((R & ~31) + perm32(R & 31)) : R;
        voffA[i] = (unsigned)(R * g.lda + C) * 2u; voffB[i] = (unsigned)(Rb * K + C) * 2u; }
    const size_t kstep = (size_t)(BK * 2);
    const size_t hstepA = (size_t)HALF * g.lda * 2, hstepB = (size_t)HALF * K * 2;
    const size_t tstepA = 2 * hstepA, tstepB = 2 * hstepB;
    const unsigned ldsw = (unsigned)wid * 1024u;
    const int aoff = lds_byte(wr * 64 + fr, fq * 8), boff = lds_byte(wc * 32 + fr, fq * 8);
#define PG8_SA(b, h) (((b) * 2 + (h)) * HTB)
#define PG8_SB(b, h) ((4 + (b) * 2 + (h)) * HTB)
#define PG8_STAGE(bufoff, gbase, voff) do { _Pragma("unroll") for (int _i = 0; _i < 2; ++_i) \
        __builtin_amdgcn_global_load_lds((const unsigned*)((const char*)(gbase) + (voff)[_i]), (PG8_LAS unsigned*)(lds + (bufoff) + ldsw + _i * 8192), 16, 0, 0); } while (0)
#define PG8_LDA(dst, b, h) do { _Pragma("unroll") for (int m = 0; m < 4; ++m) _Pragma("unroll") for (int k = 0; k < 2; ++k) dst[m][k] = *(const PG8_LAS bf16x8*)(lds + PG8_SA(b, h) + aoff + m * 2048 + k * 1024); } while (0)
#define PG8_LDB(dst, b, h) do { _Pragma("unroll") for (int n = 0; n < 2; ++n) _Pragma("unroll") for (int k = 0; k < 2; ++k) dst[n][k] = *(const PG8_LAS bf16x8*)(lds + PG8_SB(b, h) + boff + n * 2048 + k * 1024); } while (0)
#define PG8_MMA(ai, bj, At, Bt) do { __builtin_amdgcn_s_setprio(1); _Pragma("unroll") for (int m = 0; m < 4; ++m) _Pragma("unroll") for (int n = 0; n < 2; ++n) _Pragma("unroll") for (int k = 0; k < 2; ++k) \
        acc[ai][bj][m][n] = __builtin_amdgcn_mfma_f32_16x16x32_bf16(Bt[n][k], At[m][k], acc[ai][bj][m][n], 0, 0, 0); __builtin_amdgcn_s_setprio(0); } while (0)
#define PG8_WAIT_V(n) asm volatile("s_waitcnt vmcnt(" #n ")" ::: "memory")
#define PG8_WAIT_L(n) asm volatile("s_waitcnt lgkmcnt(" #n ")" ::: "memory")
#define PG8_BAR __builtin_amdgcn_s_barrier()
#define PG8_SCHED __builtin_amdgcn_sched_barrier(0)
    Unit cur, nxt; int ui = 0;
    if (!S.next(0, cur)) return;
    f32x4 acc[2][2][4][2];
#pragma unroll
    for (int a = 0; a < 2; ++a)
#pragma unroll
        for (int b = 0; b < 2; ++b)
#pragma unroll
            for (int m = 0; m < 4; ++m)
#pragma unroll
                for (int n = 0; n < 2; ++n) acc[a][b][m][n] = (f32x4){0.f, 0.f, 0.f, 0.f};
    bf16x8 At[4][2], B0[2][2], B1[2][2];
    const char* cA = (const char*)g.A + (size_t)cur.pm * tstepA; const char* cB = (const char*)g.Bt + (size_t)cur.pn * tstepB;
    S.a_ready(cur);
    if constexpr (SP2) {
        PG8_STAGE(PG8_SB(0, 0), cB, voffB); PG8_STAGE(PG8_SB(0, 1), cB + hstepB, voffB); PG8_STAGE(PG8_SA(0, 0), cA, voffA); PG8_STAGE(PG8_SA(0, 1), cA + hstepA, voffA);
        if (wr == 1) PG8_BAR;
        PG8_WAIT_V(2); PG8_BAR;
        PG8_STAGE(PG8_SB(1, 0), cB + kstep, voffB); PG8_STAGE(PG8_SA(1, 0), cA + kstep, voffA); PG8_STAGE(PG8_SB(1, 1), cB + hstepB + kstep, voffB);
        PG8_WAIT_V(6); PG8_BAR;
    } else {
        PG8_STAGE(PG8_SB(0, 0), cB, voffB); PG8_STAGE(PG8_SA(0, 0), cA, voffA); PG8_STAGE(PG8_SB(0, 1), cB + hstepB, voffB); PG8_STAGE(PG8_SA(0, 1), cA + hstepA, voffA);
        if (wr == 1) PG8_BAR;
        PG8_WAIT_V(4); PG8_BAR;
        PG8_STAGE(PG8_SB(1, 0), cB + kstep, voffB); PG8_STAGE(PG8_SA(1, 0), cA + kstep, voffA); PG8_STAGE(PG8_SB(1, 1), cB + hstepB + kstep, voffB);
        PG8_WAIT_V(6); PG8_BAR;
    }
    for (;;) {
        const bool has_next = S.next(ui + 1, nxt);
        const char* nA = has_next ? (const char*)g.A + (size_t)nxt.pm * tstepA : cA; const char* nB = has_next ? (const char*)g.Bt + (size_t)nxt.pn * tstepB : cB;
        for (int t = 0; t < nt; t += 2) {
            const bool last = (t == nt - 2);
            const char* a1 = cA + (size_t)(t + 1) * kstep;
            const char* a2 = last ? nA : cA + (size_t)(t + 2) * kstep; const char* b2 = last ? nB : cB + (size_t)(t + 2) * kstep;
            const char* a3 = a2 + kstep; const char* b3 = b2 + kstep;
            if (last && has_next) S.a_ready(nxt);
            if constexpr (SP2) {
            PG8_LDB(B0, 0, 0); PG8_LDB(B1, 0, 1); PG8_SCHED; PG8_LDA(At, 0, 0); PG8_STAGE(PG8_SA(1, 1), a1 + hstepA, voffA);
            PG8_WAIT_V(8); PG8_WAIT_L(0); PG8_BAR; PG8_MMA(0, 0, At, B0); PG8_MMA(0, 1, At, B1); PG8_BAR; PG8_SCHED;
            PG8_LDA(At, 0, 1); PG8_STAGE(PG8_SB(0, 0), b2, voffB); PG8_STAGE(PG8_SB(0, 1), b2 + hstepB, voffB); PG8_STAGE(PG8_SA(0, 0), a2, voffA);
            PG8_WAIT_V(8); PG8_WAIT_L(0); PG8_BAR; PG8_MMA(1, 0, At, B0); PG8_MMA(1, 1, At, B1); PG8_BAR; PG8_SCHED;
            PG8_LDB(B0, 1, 0); PG8_LDB(B1, 1, 1); PG8_SCHED; PG8_LDA(At, 1, 0); PG8_STAGE(PG8_SA(0, 1), a2 + hstepA, voffA);
            PG8_WAIT_V(8); PG8_WAIT_L(0); PG8_BAR; PG8_MMA(0, 0, At, B0); PG8_MMA(0, 1, At, B1); PG8_BAR; PG8_SCHED;
            PG8_LDA(At, 1, 1); PG8_STAGE(PG8_SB(1, 0), b3, voffB); PG8_STAGE(PG8_SB(1, 1), b3 + hstepB, voffB); PG8_STAGE(PG8_SA(1, 0), a3, voffA);
            PG8_WAIT_V(8); PG8_WAIT_L(0); PG8_BAR; PG8_MMA(1, 0, At, B0); PG8_MMA(1, 1, At, B1); PG8_BAR; PG8_SCHED;
            } else {
            PG8_LDB(B0, 0, 0); PG8_SCHED; PG8_LDA(At, 0, 0); PG8_STAGE(PG8_SA(1, 1), a1 + hstepA, voffA);
            PG8_WAIT_L(8); PG8_BAR; PG8_WAIT_L(0); PG8_MMA(0, 0, At, B0); PG8_BAR; PG8_SCHED;
            PG8_LDB(B1, 0, 1); PG8_STAGE(PG8_SB(0, 0), b2, voffB);
            PG8_BAR; PG8_WAIT_L(0); PG8_MMA(0, 1, At, B1); PG8_BAR;
            PG8_LDA(At, 0, 1); PG8_STAGE(PG8_SA(0, 0), a2, voffA);
            PG8_BAR; PG8_WAIT_L(0); PG8_MMA(1, 0, At, B0); PG8_BAR; PG8_SCHED;
            PG8_STAGE(PG8_SB(0, 1), b2 + hstepB, voffB);
            PG8_WAIT_V(6); PG8_BAR; PG8_MMA(1, 1, At, B1); PG8_BAR;
            PG8_LDB(B0, 1, 0); PG8_SCHED; PG8_LDA(At, 1, 0); PG8_STAGE(PG8_SA(0, 1), a2 + hstepA, voffA);
            PG8_WAIT_L(8); PG8_BAR; PG8_WAIT_L(0); PG8_MMA(0, 0, At, B0); PG8_BAR; PG8_SCHED;
            PG8_LDB(B1, 1, 1); PG8_STAGE(PG8_SB(1, 0), b3, voffB);
            PG8_BAR; PG8_WAIT_L(0); PG8_MMA(0, 1, At, B1); PG8_BAR;
            PG8_LDA(At, 1, 1); PG8_STAGE(PG8_SA(1, 0), a3, voffA);
            PG8_BAR; PG8_WAIT_L(0); PG8_MMA(1, 0, At, B0); PG8_BAR; PG8_SCHED;
            PG8_STAGE(PG8_SB(1, 1), b3 + hstepB, voffB);
            PG8_WAIT_V(6); PG8_BAR; PG8_MMA(1, 1, At, B1); PG8_BAR;
            }
        }
        if constexpr (ALIGN_EPI) { if (wr == 0) PG8_BAR; }
        if constexpr (!Epi::AFTER_DRAIN) { E(acc, cur, wr, wc, fr, fq); S.done(cur); }
        if (!has_next) break;
#pragma unroll
        for (int a = 0; a < 2; ++a)
#pragma unroll
            for (int b = 0; b < 2; ++b)
#pragma unroll
                for (int m = 0; m < 4; ++m)
#pragma unroll
                    for (int n = 0; n < 2; ++n) acc[a][b][m][n] = (f32x4){0.f, 0.f, 0.f, 0.f};
        cur = nxt; cA = nA; cB = nB; ++ui;
        if constexpr (ALIGN_EPI) { if (wr == 1) PG8_BAR; }
    }
    PG8_WAIT_V(0);
    if constexpr (!ALIGN_EPI) { if (wr == 0) PG8_BAR; }
    PG8_BAR;
    if constexpr (Epi::AFTER_DRAIN) { E.fused(acc, cur, wr, wc, fr, fq, lds, wid, lane); S.done(cur); }
#undef PG8_SA
#undef PG8_SB
#undef PG8_STAGE
#undef PG8_LDA
#undef PG8_LDB
#undef PG8_MMA
#undef PG8_WAIT_V
#undef PG8_WAIT_L
#undef PG8_BAR
#undef PG8_SCHED
}
}

template <int MODE>
__device__ __forceinline__ void p0_transpose_item(const float* W, int K, int Nsrc, int nblk, bf16_t* WT, const float* gvec, LAS float* scr, int item, int lane) {
    const int kb = item / nblk, nb = item % nblk, k0 = 64 * kb, n0 = 32 * nb;
    const int nd = n0 + (lane & 31);
    const int col = (MODE == 0) ? colmap0(nd) : nd;
#pragma unroll 8
    for (int i = 0; i < 32; ++i) { const int kk = 2 * i + (lane >> 5);
        float v = (col >= 0) ? W[(size_t)(k0 + kk) * Nsrc + col] : 0.f;
        if (MODE != 1) v *= gvec[k0 + kk];
        scr[kk * 33 + (lane & 31)] = v; }
    asm volatile("s_waitcnt lgkmcnt(0)" ::: "memory");
    const int c = lane & 7;
#pragma unroll
    for (int j = 0; j < 4; ++j) { const int n = (lane >> 3) + 8 * j; const LAS float* s = scr + (8 * c) * 33 + n;
        u32x4 o; o.x = pk2(s[0 * 33], s[1 * 33]); o.y = pk2(s[2 * 33], s[3 * 33]); o.z = pk2(s[4 * 33], s[5 * 33]); o.w = pk2(s[6 * 33], s[7 * 33]);
        *(u32x4*)(WT + (size_t)(n0 + n) * K + k0 + 8 * c) = o; }
    asm volatile("s_waitcnt lgkmcnt(0)" ::: "memory");
}

__device__ __forceinline__ void p0_prologue(const Args& a, LAS unsigned char* lds, int vcu, int G, int wave, int lane) {
    unsigned char* ws = a.ws;
    LAS float* scr = (LAS float*)(lds + wave * 16384);
    const int gw = vcu * NWAVES + wave, NGW = G * NWAVES;
    constexpr int I0 = (DM / 64) * (N0 / 32), IO = (MIXW / 64) * (DM / 32), I1 = (DM / 64) * (N1 / 32);
    constexpr int NITEMS = I0 + IO + I1 + IO;
    for (int it = gw; it < NITEMS; it += NGW) {
        int r = it;
        if (r < I0) { p0_transpose_item<0>(a.in[2], DM, N0_SRC, N0 / 32, (bf16_t*)(ws + WS_WT0), a.in[1], scr, r, lane); continue; } r -= I0;
        if (r < IO) { p0_transpose_item<1>(a.in[12], MIXW, DM, DM / 32, (bf16_t*)(ws + WS_WTO0), nullptr, scr, r, lane); continue; } r -= IO;
        if (r < I1) { p0_transpose_item<2>(a.in[14], DM, N1, N1 / 32, (bf16_t*)(ws + WS_WT1), a.in[13], scr, r, lane); continue; } r -= I1;
        p0_transpose_item<1>(a.in[19], MIXW, DM, DM / 32, (bf16_t*)(ws + WS_WTO1), nullptr, scr, r, lane);
    }
    const float* x = a.in[0]; bf16_t* XB = (bf16_t*)(ws + WS_XB); float* rstd0 = (float*)(ws + WS_RSTD0);
    for (int m = gw; m < MTOK; m += NGW) {
        const f32x4* xr = (const f32x4*)(x + (size_t)m * DM) + lane;
        u32x2* o8 = (u32x2*)(XB + (size_t)m * DM) + lane;
        float s = 0.f;
#pragma unroll
        for (int j = 0; j < 8; ++j) { const f32x4 v = xr[64 * j]; s += (v.x * v.x + v.y * v.y) + (v.z * v.z + v.w * v.w);
            u32x2 w; w.x = pk2(v.x, v.y); w.y = pk2(v.z, v.w); o8[64 * j] = w; }
        s = wave_sum(s);
        if (lane == 0) rstd0[m] = 1.0f / sqrtf(s * (1.0f / DM) + EPS);
    }
    const int gt = gw * 64 + lane, NGT = NGW * 64;
    float* SS1 = (float*)(ws + WS_SS1); float* LNS = (float*)(ws + WS_LNS);
    for (int i = gt; i < MTOK; i += NGT) { SS1[i] = 0.f; LNS[2 * i] = 0.f; LNS[2 * i + 1] = 0.f; }
    float* COS = (float*)(ws + WS_COS); float* SIN = (float*)(ws + WS_SIN);
    for (int i = gt; i < SEQ * 16; i += NGT) { const int t = i >> 4, f = i & 15;
        const float inv = powf(500000.0f, -((float)f * 2.0f) / 32.0f); const float ang = (float)t * inv;
        COS[i] = cosf(ang); SIN[i] = sinf(ang); }
}

__device__ __forceinline__ void p2_conv(const Args& a, int gt, int NGT) {
    bf16_t* ZC = (bf16_t*)(a.ws + WS_ZC); const float* cw = a.in[3];
    for (int idx = gt; idx < MTOK * 256; idx += NGT) {
        const int row = idx >> 8, c8 = (idx & 255) * 8, t = row & (SEQ - 1);
        bf16_t* base = ZC + (size_t)row * ZC_LD + c8;
        const u32x4 cb = *(const u32x4*)base, cg = *(const u32x4*)(base + 6144);
        const u32x4 cc0 = *(const u32x4*)(base + 2048), ch0 = *(const u32x4*)(base + 4096);
        u32x4 cc1 = {0, 0, 0, 0}, ch1 = {0, 0, 0, 0}, cc2 = {0, 0, 0, 0}, ch2 = {0, 0, 0, 0};
        if (t >= 1) { cc1 = *(const u32x4*)(base - ZC_LD + 2048); ch1 = *(const u32x4*)(base - ZC_LD + 4096); }
        if (t >= 2) { cc2 = *(const u32x4*)(base - 2 * ZC_LD + 2048); ch2 = *(const u32x4*)(base - 2 * ZC_LD + 4096); }
        float w0[8], w1[8], w2[8];
#pragma unroll
        for (int j = 0; j < 8; ++j) { w0[j] = cw[c8 + j]; w1[j] = cw[DM + c8 + j]; w2[j] = cw[2 * DM + c8 + j]; }
        u32x4 o;
#pragma unroll
        for (int q = 0; q < 4; ++q) {
            float r[2];
#pragma unroll
            for (int hh = 0; hh < 2; ++hh) {
                const int j = 2 * q + hh;
                const float p0 = hh ? bf_hi(cc0[q]) * bf_hi(ch0[q]) : bf_lo(cc0[q]) * bf_lo(ch0[q]);
                const float p1 = hh ? bf_hi(cc1[q]) * bf_hi(ch1[q]) : bf_lo(cc1[q]) * bf_lo(ch1[q]);
                const float p2 = hh ? bf_hi(cc2[q]) * bf_hi(ch2[q]) : bf_lo(cc2[q]) * bf_lo(ch2[q]);
                const float conv = w0[j] * p2 + w1[j] * p1 + w2[j] * p0;
                const float b = hh ? bf_hi(cb[q]) : bf_lo(cb[q]); const float g = hh ? bf_hi(cg[q]) : bf_lo(cg[q]);
                r[hh] = b * conv * silu_f(g);
            }
            o[q] = pk2(r[0], r[1]);
        }
        *(u32x4*)base = o;
    }
}

__device__ __forceinline__ void p2_compress(const Args& a, LAS unsigned char* lds, int blk, int G, int tid) {
    LAS float* tok = (LAS float*)lds;
    LAS float* pos = (LAS float*)(lds + 73728);
    LAS float* red = (LAS float*)(lds + 73728 + 16384);
    LAS float* hid = (LAS float*)(lds + 73728 + 32768);
    const int j = tid & 127, iq = tid >> 7;
    for (int unit = blk; unit < 2 * 16 * 16; unit += G) {
        const int kv = unit >> 8, bg = (unit >> 4) & 15, cg8 = unit & 15;
        const bf16_t* src = (const bf16_t*)(a.ws + WS_KV) + (size_t)kv * KV_ELEMS + ((size_t)bg * SEQ + 128 * cg8) * HD;
        const float* posg = a.in[kv ? 8 : 4]; const float* w1 = a.in[kv ? 9 : 5]; const float* b1 = a.in[kv ? 10 : 6]; const float* w2 = a.in[kv ? 11 : 7];
        const int ntok = (cg8 == 15) ? 128 : 144;
        __syncthreads();
        for (int i = tid; i < ntok * 128; i += NTHREADS) tok[i] = bf2f(src[i]);
        for (int i = tid; i < 4096; i += NTHREADS) pos[i] = posg[i];
        __syncthreads();
        float acc[8];
#pragma unroll
        for (int cc = 0; cc < 8; ++cc) acc[cc] = 0.f;
        const int ncc = (cg8 == 15) ? 7 : 8;
        for (int i = iq * 1024; i < iq * 1024 + 1024; ++i) {
            const float w = w1[(size_t)i * 128 + j]; const float p = pos[i];
#pragma unroll
            for (int cc = 0; cc < 8; ++cc) if (cc < ncc) acc[cc] += (tok[cc * 2048 + i] + p) * w;
        }
#pragma unroll
        for (int cc = 0; cc < 8; ++cc) red[(iq * 8 + cc) * 128 + j] = acc[cc];
        __syncthreads();
        for (int i = tid; i < 8 * 128; i += NTHREADS) { const int jj = i & 127;
            const float h = red[i] + red[1024 + i] + red[2048 + i] + red[3072 + i] + b1[jj]; hid[i] = silu_f(h); }
        __syncthreads();
        bf16_t* dst = (bf16_t*)(a.ws + (kv ? WS_VC : WS_KC)) + (size_t)bg * 128 * 128;
        for (int o = tid; o < 8 * 128; o += NTHREADS) { const int cc = o >> 7, d = o & 127;
            if (cc < ncc) { float s = 0.f;
                for (int jj = 0; jj < 128; ++jj) s += hid[cc * 128 + jj] * w2[jj * 128 + d];
                dst[(size_t)(8 * cg8 + cc) * 128 + d] = (bf16_t)f2bf(s); } }
    }
    __syncthreads();
}

__device__ __forceinline__ void attn_batch(const bf16_t* Kb, const bf16_t* Vb, int first, int lo, int hi, bool valid, const LAS float* qs,
                                           float (&m)[4], float (&l)[4], float (&o)[4][2], int lane) {
    int kr = first + lane; kr = kr < lo ? lo : (kr > hi ? hi : kr);
    const u32x4* kp = (const u32x4*)(Kb + (size_t)kr * HD);
    float s[4] = {0.f, 0.f, 0.f, 0.f};
#pragma unroll 4
    for (int c = 0; c < 16; ++c) { const u32x4 kv = kp[c];
        float kf[8]; kf[0] = bf_lo(kv.x); kf[1] = bf_hi(kv.x); kf[2] = bf_lo(kv.y); kf[3] = bf_hi(kv.y); kf[4] = bf_lo(kv.z); kf[5] = bf_hi(kv.z); kf[6] = bf_lo(kv.w); kf[7] = bf_hi(kv.w);
#pragma unroll
        for (int h = 0; h < 4; ++h) { const LAS f32x4* q4 = (const LAS f32x4*)(qs + h * HD + c * 8); const f32x4 qa = q4[0], qb = q4[1];
            s[h] += (qa[0] * kf[0] + qa[1] * kf[1]) + (qa[2] * kf[2] + qa[3] * kf[3]) + (qb[0] * kf[4] + qb[1] * kf[5]) + (qb[2] * kf[6] + qb[3] * kf[7]); }
    }
    float ps[4];
#pragma unroll
    for (int h = 0; h < 4; ++h) {
        const float sv = valid ? s[h] : -INFINITY;
        const float bm = wave_max(sv); const float mn = fmaxf(m[h], bm);
        float p = 0.f, alpha = 1.f;
        if (mn > -INFINITY) { p = valid ? __expf(sv - mn) : 0.f; alpha = (m[h] > -INFINITY) ? __expf(m[h] - mn) : 0.f; }
        l[h] = l[h] * alpha + wave_sum(p); o[h][0] *= alpha; o[h][1] *= alpha; m[h] = mn; ps[h] = p;
    }
    for (int jj = 0; jj < 64; ++jj) {
        int vr = first + jj; vr = vr < lo ? lo : (vr > hi ? hi : vr);
        const unsigned vv = *(const unsigned*)(Vb + (size_t)vr * HD + 2 * lane);
        const float v0 = bf_lo(vv), v1 = bf_hi(vv);
#pragma unroll
        for (int h = 0; h < 4; ++h) { const float pj = __shfl(ps[h], jj); o[h][0] += pj * v0; o[h][1] += pj * v1; }
    }
}

__device__ __forceinline__ void p3_nsa_naive(const Args& a, LAS unsigned char* lds, int gw, int NGW, int wave, int lane) {
    unsigned char* ws = a.ws;
    LAS float* qs = (LAS float*)(lds + wave * 8192);
    LAS float* qr = qs + 512;
    LAS float* Pc = qr + 512;
    const bf16_t* Q = (const bf16_t*)(ws + WS_Q); const bf16_t* KVb = (const bf16_t*)(ws + WS_KV);
    const bf16_t* KC = (const bf16_t*)(ws + WS_KC); const bf16_t* VC = (const bf16_t*)(ws + WS_VC);
    const float* GL = (const float*)(ws + WS_GL); const bf16_t* NG = (const bf16_t*)(ws + WS_NG);
    const float* COS = (const float*)(ws + WS_COS); const float* SIN = (const float*)(ws + WS_SIN);
    bf16_t* ZC = (bf16_t*)(ws + WS_ZC);
    const float scale = 0.08838834764831845f;
    for (int task = gw; task < NB * NKV * SEQ; task += NGW) {
        const int t = task & (SEQ - 1), bg = task >> 11, b = bg >> 2, g = bg & 3;
        const int row = b * SEQ + t;
        { const u32x4 qv = *(const u32x4*)(Q + (size_t)row * DM + g * 512 + lane * 8);
          float f[8]; f[0] = bf_lo(qv.x); f[1] = bf_hi(qv.x); f[2] = bf_lo(qv.y); f[3] = bf_hi(qv.y); f[4] = bf_lo(qv.z); f[5] = bf_hi(qv.z); f[6] = bf_lo(qv.w); f[7] = bf_hi(qv.w);
#pragma unroll
          for (int j = 0; j < 8; ++j) { qs[lane * 8 + j] = f[j] * scale; qr[lane * 8 + j] = f[j] * scale; } }
        asm volatile("s_waitcnt lgkmcnt(0)" ::: "memory");
        { const int h = lane >> 4, i = lane & 15; const float x1 = qs[h * HD + i], x2 = qs[h * HD + 16 + i]; const float c = COS[t * 16 + i], s = SIN[t * 16 + i];
          qr[h * HD + i] = x1 * c - x2 * s; qr[h * HD + 16 + i] = x2 * c + x1 * s; }
        asm volatile("s_waitcnt lgkmcnt(0)" ::: "memory");
        float oc[4][2], Pl0 = 0.f, Pl1 = 0.f;
        {
            const bf16_t* Kc = KC + (size_t)bg * 128 * 128; const bf16_t* Vc = VC + (size_t)bg * 128 * 128;
            const int c0 = lane, c1 = 64 + lane;
            const bool v0 = (16 * c0 + 31 <= t), v1 = (c1 < NCMP) && (16 * c1 + 31 <= t);
            const int r1 = c1 < NCMP ? c1 : NCMP - 1;
            float s0[4] = {0.f, 0.f, 0.f, 0.f}, s1[4] = {0.f, 0.f, 0.f, 0.f};
            const u32x4* k0p = (const u32x4*)(Kc + (size_t)c0 * HD); const u32x4* k1p = (const u32x4*)(Kc + (size_t)r1 * HD);
#pragma unroll 2
            for (int c = 0; c < 16; ++c) { const u32x4 ka = k0p[c], kb = k1p[c];
                float fa[8], fb[8];
                fa[0] = bf_lo(ka.x); fa[1] = bf_hi(ka.x); fa[2] = bf_lo(ka.y); fa[3] = bf_hi(ka.y); fa[4] = bf_lo(ka.z); fa[5] = bf_hi(ka.z); fa[6] = bf_lo(ka.w); fa[7] = bf_hi(ka.w);
                fb[0] = bf_lo(kb.x); fb[1] = bf_hi(kb.x); fb[2] = bf_lo(kb.y); fb[3] = bf_hi(kb.y); fb[4] = bf_lo(kb.z); fb[5] = bf_hi(kb.z); fb[6] = bf_lo(kb.w); fb[7] = bf_hi(kb.w);
#pragma unroll
                for (int h = 0; h < 4; ++h)
#pragma unroll
                    for (int jj = 0; jj < 8; ++jj) { const float qv = qs[h * HD + c * 8 + jj]; s0[h] += qv * fa[jj]; s1[h] += qv * fb[jj]; } }
            float p0[4], p1[4];
#pragma unroll
            for (int h = 0; h < 4; ++h) {
                const float a0 = v0 ? s0[h] : -INFINITY, a1 = v1 ? s1[h] : -INFINITY;
                const float mx = wave_max(fmaxf(a0, a1));
                float e0 = 0.f, e1 = 0.f;
                if (mx > -INFINITY) { e0 = v0 ? __expf(a0 - mx) : 0.f; e1 = v1 ? __expf(a1 - mx) : 0.f; }
                const float den = wave_sum(e0 + e1); const float inv = den > 0.f ? 1.0f / den : 1.0f;
                p0[h] = e0 * inv; p1[h] = e1 * inv; Pl0 += p0[h]; Pl1 += p1[h];
                oc[h][0] = 0.f; oc[h][1] = 0.f;
            }
            for (int jj = 0; jj < 64; ++jj) {
                const unsigned va = *(const unsigned*)(Vc + (size_t)jj * HD + 2 * lane);
                const int rr = (64 + jj) < NCMP ? (64 + jj) : NCMP - 1;
                const unsigned vb = *(const unsigned*)(Vc + (size_t)rr * HD + 2 * lane);
#pragma unroll
                for (int h = 0; h < 4; ++h) { const float pa = __shfl(p0[h], jj), pb = __shfl(p1[h], jj);
                    oc[h][0] += pa * bf_lo(va) + pb * bf_lo(vb); oc[h][1] += pa * bf_hi(va) + pb * bf_hi(vb); }
            }
            Pc[lane] = Pl0; Pc[64 + lane] = Pl1;
        }
        asm volatile("s_waitcnt lgkmcnt(0)" ::: "memory");
        unsigned selmask = 0u;
        {
            const int cur = t >> 6;
            float val = -INFINITY;
            if (lane < 32) {
                if (lane == 0 || lane == cur) val = INFINITY;
                else if (64 * lane <= t) { float s = 0.f;
                    for (int c = 4 * lane - 1; c <= 4 * lane + 3; ++c) if (c >= 0 && c < NCMP) s += Pc[c];
                    val = s; }
            }
            bool taken = (lane >= 32);
            for (int r = 0; r < 8; ++r) {
                const float cand = taken ? -INFINITY : val;
                const float mx = wave_max(cand);
                if (!(mx > -INFINITY)) break;
                const unsigned long long bal = __ballot(!taken && cand == mx);
                const int idx = __ffsll((long long)bal) - 1;
                selmask |= 1u << idx;
                if (lane == idx) taken = true;
            }
        }
        float os[4][2], ms[4], ls[4];
#pragma unroll
        for (int h = 0; h < 4; ++h) { os[h][0] = 0.f; os[h][1] = 0.f; ms[h] = -INFINITY; ls[h] = 0.f; }
        {
            const bf16_t* Ks = KVb + 2 * KV_ELEMS + (size_t)bg * SEQ * HD; const bf16_t* Vs = KVb + 3 * KV_ELEMS + (size_t)bg * SEQ * HD;
            unsigned mk = selmask;
            while (mk) { const int jb = __ffs((int)mk) - 1; mk &= mk - 1;
                attn_batch(Ks, Vs, 64 * jb, 0, SEQ - 1, (64 * jb + lane) <= t, qr, ms, ls, os, lane); }
        }
        float ow[4][2], mw[4], lw[4];
#pragma unroll
        for (int h = 0; h < 4; ++h) { ow[h][0] = 0.f; ow[h][1] = 0.f; mw[h] = -INFINITY; lw[h] = 0.f; }
        {
            const bf16_t* Kw = KVb + 4 * KV_ELEMS + (size_t)bg * SEQ * HD; const bf16_t* Vw = KVb + 5 * KV_ELEMS + (size_t)bg * SEQ * HD;
            const int first = t - 511;
            for (int b8 = 0; b8 < 8; ++b8) { const int f0 = first + 64 * b8;
                if (f0 + 63 < 0) continue;
                attn_batch(Kw, Vw, f0, 0, SEQ - 1, (f0 + lane) >= 0, qr, mw, lw, ow, lane); }
        }
#pragma unroll
        for (int h = 0; h < 4; ++h) {
            const int hh = g * 4 + h;
            const float g0 = sigmoid_f(GL[(size_t)row * 48 + hh]), g1 = sigmoid_f(GL[(size_t)row * 48 + 16 + hh]), g2 = sigmoid_f(GL[(size_t)row * 48 + 32 + hh]);
            const float is = ls[h] > 0.f ? 1.0f / ls[h] : 0.f, iw = lw[h] > 0.f ? 1.0f / lw[h] : 0.f;
            const unsigned ngv = *(const unsigned*)(NG + (size_t)row * DM + hh * HD + 2 * lane);
            const float y0 = (g0 * oc[h][0] + g1 * os[h][0] * is + g2 * ow[h][0] * iw) * silu_f(bf_lo(ngv));
            const float y1 = (g0 * oc[h][1] + g1 * os[h][1] * is + g2 * ow[h][1] * iw) * silu_f(bf_hi(ngv));
            *(unsigned*)(ZC + (size_t)row * ZC_LD + 2048 + hh * HD + 2 * lane) = pk2(y0, y1);
        }
    }
}

__device__ __forceinline__ void p6_sgu_naive(const Args& a, LAS unsigned char* lds, int blk, int G, int tid) {
    LAS float* vn = (LAS float*)lds;
    LAS float* Wt = (LAS float*)(lds + 65536);
    bf16_t* Z1 = (bf16_t*)(a.ws + WS_Z1); const float* LNS = (const float*)(a.ws + WS_LNS);
    const float* lng = a.in[15]; const float* lnb = a.in[16]; const float* wsp = a.in[17]; const float* bsp = a.in[18];
    const int d = tid & 127, tq = tid >> 7;
    for (int unit = blk; unit < 64 * 16 * 2; unit += G) {
        const int dh = unit & 1, h = (unit >> 1) & 15, ch = unit >> 5;
        const int row0 = ch * 128, col = h * 256 + dh * 128;
        __syncthreads();
        for (int i = tid; i < 128 * 128; i += NTHREADS) { const int s = i >> 7, dd = i & 127; const int row = row0 + s;
            const float sum = LNS[2 * row], sq = LNS[2 * row + 1]; const float mu = sum * (1.0f / MIXW); const float var = sq * (1.0f / MIXW) - mu * mu;
            const float rstd = 1.0f / sqrtf(fmaxf(var, 0.f) + EPS);
            const float v = bf2f(Z1[(size_t)row * N1 + MIXW + col + dd]);
            vn[i] = (v - mu) * rstd * lng[col + dd] + lnb[col + dd];
            Wt[i] = wsp[(size_t)h * 16384 + i]; }
        __syncthreads();
        for (int tt = 0; tt < 32; ++tt) {
            const int t = tq + 4 * tt;
            float mix = 0.f;
            for (int s = 0; s <= t; ++s) mix += Wt[t * 128 + s] * vn[s * 128 + d];
            mix += bsp[h * 128 + t];
            const size_t off = (size_t)(row0 + t) * N1 + col + d;
            const float u = bf2f(Z1[off]), zg = bf2f(Z1[off + 2 * MIXW]);
            Z1[off] = (bf16_t)f2bf(u * mix * silu_f(zg));
        }
    }
    __syncthreads();
}

__device__ __forceinline__ void p8_final(const Args& a, int gw, int NGW, int lane) {
    const float* gf = a.in[20];
    for (int m = gw; m < MTOK; m += NGW) {
        f32x4* xr = (f32x4*)(a.out + (size_t)m * DM) + lane;
        f32x4 v[8]; float s = 0.f;
#pragma unroll
        for (int j = 0; j < 8; ++j) { v[j] = xr[64 * j]; s += (v[j].x * v[j].x + v[j].y * v[j].y) + (v[j].z * v[j].z + v[j].w * v[j].w); }
        s = wave_sum(s);
        const float rs = 1.0f / sqrtf(s * (1.0f / DM) + EPS);
#pragma unroll
        for (int j = 0; j < 8; ++j) { const f32x4 gg = *((const f32x4*)gf + lane + 64 * j); xr[64 * j] = v[j] * rs * gg; }
    }
}

constexpr int NPHASE = 9;
template <bool COOP>
__global__ void __launch_bounds__(NTHREADS, 2) fwd_kernel(Args args) {
    extern __shared__ __attribute__((aligned(16))) unsigned char lds_raw[];
    LAS unsigned char* lds = (LAS unsigned char*)lds_raw;
    const int tid = threadIdx.x, lane = tid & 63, wave = __builtin_amdgcn_readfirstlane(tid >> 6);
    const int G = gridDim.x, bx = blockIdx.x;
    const int vcu = (G % 8 == 0) ? (bx % 8) * (G / 8) + bx / 8 : bx;
    const int gw = vcu * NWAVES + wave, NGW = G * NWAVES, gt = gw * 64 + lane, NGT = NGW * 64;
    const int lo = args.ph_lo, hi = args.ph_hi;
    unsigned char* ws = args.ws;
#define IN(k) (lo <= (k) && (k) < hi)
#define SEAM(k) do { if (COOP) { if (IN(k) && IN((k) + 1)) { __threadfence(); cg::this_grid().sync(); __threadfence(); } } } while (0)

    if (IN(0)) { p0_prologue(args, lds, vcu, G, wave, lane); }
    SEAM(0);
    if (IN(1)) {
        pg8::Gemm g{(const bf16_t*)(ws + WS_XB), (const bf16_t*)(ws + WS_WT0), MTOK, N0, DM, DM};
        pg8::StaticOrder S; S.init(MTOK, N0, G, bx);
        pg8::Epi0 E{(const float*)(ws + WS_RSTD0), (bf16_t*)(ws + WS_ZC), (bf16_t*)(ws + WS_Q), (bf16_t*)(ws + WS_KV), (bf16_t*)(ws + WS_NG), (float*)(ws + WS_GL),
                    (const float*)(ws + WS_COS), (const float*)(ws + WS_SIN)};
        pg8::gemm_phase<pg8::Epi0, pg8::StaticOrder, true, true>(lds, g, S, E);
    }
    SEAM(1);
    if (IN(2)) { p2_compress(args, lds, vcu, G, tid); p2_conv(args, gt, NGT); }
    SEAM(2);
    if (IN(3)) { p3_nsa_naive(args, lds, gw, NGW, wave, lane); }
    SEAM(3);
    if (IN(4)) {
        pg8::Gemm g{(const bf16_t*)(ws + WS_ZC), (const bf16_t*)(ws + WS_WTO0), MTOK, DM, MIXW, ZC_LD};
        pg8::StaticOrder S; S.init(MTOK, DM, G, bx);
        pg8::EpiOut0 E{args.in[0], args.out, (bf16_t*)(ws + WS_XB), (float*)(ws + WS_SS1)};
        pg8::gemm_phase<pg8::EpiOut0, pg8::StaticOrder, true, true>(lds, g, S, E);
    }
    SEAM(4);
    if (IN(5)) {
        pg8::Gemm g{(const bf16_t*)(ws + WS_XB), (const bf16_t*)(ws + WS_WT1), MTOK, N1, DM, DM};
        pg8::StaticOrder S; S.init(MTOK, N1, G, bx);
        pg8::Epi1 E{(const float*)(ws + WS_SS1), (bf16_t*)(ws + WS_Z1), (float*)(ws + WS_LNS)};
        pg8::gemm_phase<pg8::Epi1, pg8::StaticOrder, true, true>(lds, g, S, E);
    }
    SEAM(5);
    if (IN(6)) { p6_sgu_naive(args, lds, vcu, G, tid); }
    SEAM(6);
    if (IN(7)) {
        pg8::Gemm g{(const bf16_t*)(ws + WS_Z1), (const bf16_t*)(ws + WS_WTO1), MTOK, DM, MIXW, N1};
        pg8::StaticOrder S; S.init(MTOK, DM, G, bx);
        pg8::EpiOut1 E{args.out};
        pg8::gemm_phase<pg8::EpiOut1, pg8::StaticOrder, true, true>(lds, g, S, E);
    }
    SEAM(7);
    if (IN(8)) { p8_final(args, gw, NGW, lane); }
#undef IN
#undef SEAM
}

#ifndef MK_COOP
#define MK_COOP 0
#endif

extern "C" void kernel_launch(void* const* d_in, const int* in_sizes, int n_in, void* d_out, int out_size, void* d_ws, size_t ws_size, hipStream_t stream) {
    static int grid = 0;
    if (grid == 0) {
        if (n_in != 21 || out_size != MTOK * DM || ws_size < WS_END) { fprintf(stderr, "kernel_launch: unexpected shapes (n_in %d out %d ws %zu)\n", n_in, out_size, ws_size); grid = -1; return; }
        int dev = 0, cus = 0, per_cu = 0;
        (void)hipGetDevice(&dev); (void)hipDeviceGetAttribute(&cus, hipDeviceAttributeMultiprocessorCount, dev);
        (void)hipFuncSetAttribute((const void*)fwd_kernel<true>, hipFuncAttributeMaxDynamicSharedMemorySize, LDS_BYTES);
        (void)hipFuncSetAttribute((const void*)fwd_kernel<false>, hipFuncAttributeMaxDynamicSharedMemorySize, LDS_BYTES);
        (void)hipOccupancyMaxActiveBlocksPerMultiprocessor(&per_cu, (const void*)fwd_kernel<true>, NTHREADS, LDS_BYTES);
        if (per_cu < 1) { fprintf(stderr, "kernel_launch: occupancy query says %d blocks per CU\n", per_cu); per_cu = 1; }
        (void)hipGetLastError();
        grid = cus;
        fprintf(stderr, "kernel_launch: grid %d (per_cu %d)\n", grid, per_cu);
    }
    if (grid < 0) return;
    Args a{};
    for (int i = 0; i < 21; ++i) a.in[i] = (const float*)d_in[i];
    a.out = (float*)d_out; a.ws = (unsigned char*)d_ws;
#if MK_COOP
    a.ph_lo = 0; a.ph_hi = NPHASE;
    void* kargs[] = {&a};
    hipError_t e = hipLaunchCooperativeKernel((const void*)fwd_kernel<true>, dim3(grid), dim3(NTHREADS), kargs, LDS_BYTES, stream);
    if (e != hipSuccess) fprintf(stderr, "cooperative launch failed: %s (grid %d)\n", hipGetErrorString(e), grid);
#else
    for (int p = 0; p < NPHASE; ++p) {
        a.ph_lo = p; a.ph_hi = p + 1;
        hipLaunchKernelGGL(fwd_kernel<false>, dim3(grid), dim3(NTHREADS), LDS_BYTES, stream, a);
    }
#endif
}
```

```cpp
#include <hip/hip_runtime.h>
#include <hip/hip_cooperative_groups.h>
#include <cstdio>
#include <cstdint>
namespace cg = cooperative_groups;

#define LAS __attribute__((address_space(3)))
typedef unsigned short bf16_t;
typedef short bf16x8 __attribute__((ext_vector_type(8)));
typedef float f32x4 __attribute__((ext_vector_type(4)));
typedef float f32x2 __attribute__((ext_vector_type(2)));
typedef unsigned u32x4 __attribute__((ext_vector_type(4)));
typedef unsigned u32x2 __attribute__((ext_vector_type(2)));

constexpr int DM = 2048, NB = 4, SEQ = 2048, MTOK = NB * SEQ;
constexpr int N0 = 15616, N0_SRC = 15408;
constexpr int N1 = 12288, MIXW = 4096;
constexpr int ZC_LD = 8192;
constexpr float EPS = 1e-6f;
constexpr int NKV = 4, HD = 128, NH = 16;
constexpr int NCMP = 127;

constexpr size_t MiB = 1u << 20;
constexpr size_t WS_RSTD0 = 1 * MiB, WS_SS1 = WS_RSTD0 + 32768, WS_LNS = WS_SS1 + 32768, WS_COS = WS_LNS + 65536, WS_SIN = WS_COS + 131072;
constexpr size_t WS_KC = 2 * MiB, WS_VC = 3 * MiB;
constexpr size_t WS_GL = 4 * MiB;
constexpr size_t WS_WT0 = 6 * MiB, WS_WTO0 = 67 * MiB, WS_WT1 = 83 * MiB, WS_WTO1 = 131 * MiB;
constexpr size_t WS_XB = 147 * MiB;
constexpr size_t WS_NG = 179 * MiB;
constexpr size_t WS_ZC = 211 * MiB;
constexpr size_t WS_Q = 339 * MiB;
constexpr size_t WS_KV = 371 * MiB;
constexpr size_t KV_ELEMS = (size_t)MTOK * 512;
constexpr size_t WS_END = 419 * MiB;
constexpr size_t WS_Z1 = WS_ZC;
static_assert(WS_Z1 + (size_t)MTOK * N1 * 2 <= WS_END, "z1 overlay");

constexpr int NWAVES = 8, NTHREADS = 512;
constexpr int LDS_BYTES = 147456;

struct Args { const float* in[21]; float* out; unsigned char* ws; int ph_lo, ph_hi; };

__device__ __forceinline__ float bf_lo(unsigned u) { return __uint_as_float(u << 16); }
__device__ __forceinline__ float bf_hi(unsigned u) { return __uint_as_float(u & 0xffff0000u); }
__device__ __forceinline__ float bf2f(bf16_t b) { return __uint_as_float((unsigned)b << 16); }
__device__ __forceinline__ unsigned f2bf(float f) { unsigned u = __float_as_uint(f); return (u + 0x7fffu + ((u >> 16) & 1u)) >> 16; }
__device__ __forceinline__ unsigned pk2(float lo, float hi) { return f2bf(lo) | (f2bf(hi) << 16); }
__device__ __forceinline__ unsigned cvt_pk_bf16(float lo, float hi) { unsigned r; asm volatile("v_cvt_pk_bf16_f32 %0, %1, %2" : "=v"(r) : "v"(lo), "v"(hi)); return r; }
__device__ __forceinline__ float silu_f(float x) { return x / (1.f + __expf(-x)); }
__device__ __forceinline__ float sigmoid_f(float x) { return 1.f / (1.f + __expf(-x)); }
__device__ __forceinline__ float wave_sum(float v) {
#pragma unroll
    for (int o = 1; o < 64; o <<= 1) v += __shfl_xor(v, o);
    return v;
}
__device__ __forceinline__ float wave_max(float v) {
#pragma unroll
    for (int o = 1; o < 64; o <<= 1) v = fmaxf(v, __shfl_xor(v, o));
    return v;
}
__device__ __forceinline__ int colmap0(int nd) { return nd < 13312 ? nd : (nd < 15360 ? nd + 48 : (nd < 15408 ? nd - 2048 : -1)); }

namespace pg8 {
#define PG8_LAS __attribute__((address_space(3)))
constexpr int BM = 256, BK = 64, HALF = 128, HTB = HALF * BK * 2  , STAGE_BYTES = 8 * HTB, NXCD = 8, WGM = 8;

__host__ __device__ __forceinline__ int lds_byte(int r, int c) { const int st = (r >> 4) * 2 + (c >> 5), rr = r & 15, cc = c & 31, ob = rr * 64 + cc * 2; return st * 1024 + (ob ^ (((ob >> 9) & 1) << 5)); }
__host__ __device__ __forceinline__ void stage_rc(int b, int& R, int& C) { const int st = b / 1024, sb = b % 1024, swz = sb ^ (((sb >> 9) & 1) << 5); R = (st >> 1) * 16 + swz / 64; C = (st & 1) * 32 + (swz % 64) / 2; }
__host__ __device__ __forceinline__ int perm32(int rho) { const int n = rho >> 4, i = rho & 15; return 8 * (i >> 2) + 4 * n + (i & 3); }

struct Unit { int pm, pn; };
struct Gemm { const bf16_t* A; const bf16_t* Bt; int M, N, K, lda; };

struct StaticOrder {
    int nM, nN, nwg, G, c;
    __host__ __device__ void init(int M, int N, int G_, int c_) { nM = M / BM; nN = N / BM; nwg = nM * nN; G = G_; c = c_; }
    __host__ __device__ bool next(int i, Unit& u) const {
        const long L = (long)i * G + c; if (L >= nwg) return false;
        int wgid = (int)L; { const int q = nwg / NXCD, r = nwg % NXCD, xcd = wgid % NXCD, off = wgid / NXCD; wgid = (xcd < r ? xcd * (q + 1) : r * (q + 1) + (xcd - r) * q) + off; }
        const int nig = WGM * nN, gid = wgid / nig, fm = gid * WGM, gsz = (nM - fm) < WGM ? (nM - fm) : WGM;
        u.pm = fm + ((wgid % nig) % gsz); u.pn = (wgid % nig) / gsz; return true;
    }
    __device__ __forceinline__ void a_ready(const Unit&) const {}
    __device__ __forceinline__ void done(const Unit&) const {}
};


struct Epi0 {
    static constexpr bool PERM = true, AFTER_DRAIN = false;
    const float* rstd; bf16_t* ZC; bf16_t* Q; bf16_t* KV; bf16_t* NG; float* GL; const float* COS; const float* SIN;
    __device__ __forceinline__ void operator()(const f32x4 (&acc)[2][2][4][2], const Unit& u, int wr, int wc, int fr, int fq) const {
        const int pn = u.pn;
        const int rowb = u.pm * BM + wr * 64 + fr;
        const int cl = wc * 32 + 8 * fq;
        const bool rot = (pn == 44 || pn == 45 || pn == 48 || pn == 49) && (wc == 0);
#pragma unroll
        for (int ai = 0; ai < 2; ++ai)
#pragma unroll
            for (int m = 0; m < 4; ++m) {
                const int row = rowb + ai * HALF + m * 16;
                const float rs = rstd[row];
                const int t = row & (SEQ - 1), b = row >> 11;
                f32x4 cs0, cs1, sn0, sn1;
                if (rot) { const float* cp = COS + t * 16 + 8 * (fq & 1); const float* sp = SIN + t * 16 + 8 * (fq & 1);
                    cs0 = *(const f32x4*)cp; cs1 = *(const f32x4*)(cp + 4); sn0 = *(const f32x4*)sp; sn1 = *(const f32x4*)(sp + 4); }
#pragma unroll
                for (int bj = 0; bj < 2; ++bj) {
                    f32x4 v0 = acc[ai][bj][m][0] * rs, v1 = acc[ai][bj][m][1] * rs;
                    if (rot) {
                        f32x4 p0, p1;
#pragma unroll
                        for (int j = 0; j < 4; ++j) { p0[j] = __shfl_xor(v0[j], 32); p1[j] = __shfl_xor(v1[j], 32); }
                        if (fq < 2) { v0 = v0 * cs0 - p0 * sn0; v1 = v1 * cs1 - p1 * sn1; }
                        else        { v0 = v0 * cs0 + p0 * sn0; v1 = v1 * cs1 + p1 * sn1; }
                    }
                    const int c = cl + bj * HALF;
                    if (pn == 60) {
                        if (c < 48) { float* gp = GL + (size_t)row * 48 + c; *(f32x4*)gp = v0; *(f32x4*)(gp + 4) = v1; }
                    } else {
                        u32x4 w; w.x = cvt_pk_bf16(v0[0], v0[1]); w.y = cvt_pk_bf16(v0[2], v0[3]); w.z = cvt_pk_bf16(v1[0], v1[1]); w.w = cvt_pk_bf16(v1[2], v1[3]);
                        bf16_t* dst;
                        if (pn < 32) dst = ZC + (size_t)row * ZC_LD + pn * BM + c;
                        else if (pn < 40) dst = Q + (size_t)row * DM + (pn - 32) * BM + c;
                        else if (pn < 52) { const int which = (pn - 40) >> 1, g = ((pn - 40) & 1) * 2 + bj;
                            dst = KV + (size_t)which * KV_ELEMS + ((size_t)((b * NKV + g) * SEQ + t)) * HD + cl; }
                        else dst = NG + (size_t)row * DM + (pn - 52) * BM + c;
                        *(u32x4*)dst = w;
                    }
                }
            }
    }
};

struct EpiOut0 {
    static constexpr bool PERM = false, AFTER_DRAIN = false;
    const float* X; float* X1; bf16_t* X1B; float* SS;
    __device__ __forceinline__ void operator()(const f32x4 (&acc)[2][2][4][2], const Unit& u, int wr, int wc, int fr, int fq) const {
        const int rowb = u.pm * BM + wr * 64 + fr, colb = u.pn * BM + wc * 32 + 4 * fq;
#pragma unroll
        for (int ai = 0; ai < 2; ++ai)
#pragma unroll
            for (int m = 0; m < 4; ++m) {
                const int row = rowb + ai * HALF + m * 16; float ss = 0.f;
#pragma unroll
                for (int bj = 0; bj < 2; ++bj)
#pragma unroll
                    for (int n = 0; n < 2; ++n) {
                        const size_t off = (size_t)row * DM + colb + bj * HALF + n * 16;
                        const f32x4 x1 = *(const f32x4*)(X + off) + acc[ai][bj][m][n];
                        *(f32x4*)(X1 + off) = x1;
                        u32x2 w; w.x = cvt_pk_bf16(x1[0], x1[1]); w.y = cvt_pk_bf16(x1[2], x1[3]); *(u32x2*)(X1B + off) = w;
                        ss += (x1[0] * x1[0] + x1[1] * x1[1]) + (x1[2] * x1[2] + x1[3] * x1[3]);
                    }
                ss += __shfl_xor(ss, 16); ss += __shfl_xor(ss, 32);
                if (fq == 0) atomicAdd(SS + row, ss);
            }
    }
};

struct Epi1 {
    static constexpr bool PERM = true, AFTER_DRAIN = false;
    const float* SS; bf16_t* Z1; float* LNS;
    __device__ __forceinline__ void operator()(const f32x4 (&acc)[2][2][4][2], const Unit& u, int wr, int wc, int fr, int fq) const {
        const int rowb = u.pm * BM + wr * 64 + fr, colb = u.pn * BM + wc * 32 + 8 * fq;
        const bool isv = (u.pn >= 16 && u.pn < 32);
#pragma unroll
        for (int ai = 0; ai < 2; ++ai)
#pragma unroll
            for (int m = 0; m < 4; ++m) {
                const int row = rowb + ai * HALF + m * 16;
                const float rs = __builtin_amdgcn_rsqf(SS[row] * (1.0f / DM) + EPS);
                float s1 = 0.f, s2 = 0.f;
#pragma unroll
                for (int bj = 0; bj < 2; ++bj) {
                    const f32x4 v0 = acc[ai][bj][m][0] * rs, v1 = acc[ai][bj][m][1] * rs;
                    u32x4 w; w.x = cvt_pk_bf16(v0[0], v0[1]); w.y = cvt_pk_bf16(v0[2], v0[3]); w.z = cvt_pk_bf16(v1[0], v1[1]); w.w = cvt_pk_bf16(v1[2], v1[3]);
                    *(u32x4*)(Z1 + (size_t)row * N1 + colb + bj * HALF) = w;
                    s1 += (v0[0] + v0[1]) + (v0[2] + v0[3]) + (v1[0] + v1[1]) + (v1[2] + v1[3]);
                    s2 += (v0[0] * v0[0] + v0[1] * v0[1]) + (v0[2] * v0[2] + v0[3] * v0[3]) + (v1[0] * v1[0] + v1[1] * v1[1]) + (v1[2] * v1[2] + v1[3] * v1[3]);
                }
                if (isv) {
                    s1 += __shfl_xor(s1, 16); s1 += __shfl_xor(s1, 32); s2 += __shfl_xor(s2, 16); s2 += __shfl_xor(s2, 32);
                    if (fq == 0) { atomicAdd(LNS + 2 * row, s1); atomicAdd(LNS + 2 * row + 1, s2); }
                }
            }
    }
};

struct EpiOut1 {
    static constexpr bool PERM = false, AFTER_DRAIN = false;
    float* OUT;
    __device__ __forceinline__ void operator()(const f32x4 (&acc)[2][2][4][2], const Unit& u, int wr, int wc, int fr, int fq) const {
        const int rowb = u.pm * BM + wr * 64 + fr, colb = u.pn * BM + wc * 32 + 4 * fq;
#pragma unroll
        for (int ai = 0; ai < 2; ++ai)
#pragma unroll
            for (int m = 0; m < 4; ++m) {
                const int row = rowb + ai * HALF + m * 16;
#pragma unroll
                for (int bj = 0; bj < 2; ++bj)
#pragma unroll
                    for (int n = 0; n < 2; ++n) {
                        float* p = OUT + (size_t)row * DM + colb + bj * HALF + n * 16;
                        *(f32x4*)p = *(const f32x4*)p + acc[ai][bj][m][n];
                    }
            }
    }
};

template <class Epi, class Sched, bool ALIGN_EPI = false, bool SP2 = false>
__device__ __forceinline__ void gemm_phase(PG8_LAS unsigned char* lds, const Gemm g, const Sched& S, const Epi& E) {
    const int tid = threadIdx.x, wid = __builtin_amdgcn_readfirstlane(tid >> 6), lane = tid & 63, wr = wid >> 2, wc = wid & 3, fr = lane & 15, fq = lane >> 4;
    const int K = g.K, nt = K / BK;
    unsigned voffA[2], voffB[2];
#pragma unroll
    for (int i = 0; i < 2; ++i) { int R, C; stage_rc(tid * 16 + i * 8192, R, C); const int Rb = Epi::PERM ? ((R & ~31) + perm32(R & 31)) : R;
        voffA[i] = (unsigned)(R * g.lda + C) * 2u; voffB[i] = (unsigned)(Rb * K + C) * 2u; }
    const size_t kstep = (size_t)(BK * 2);
    const size_t hstepA = (size_t)HALF * g.lda * 2, hstepB = (size_t)HALF * K * 2;
    const size_t tstepA = 2 * hstepA, tstepB = 2 * hstepB;
    const unsigned ldsw = (unsigned)wid * 1024u;
    const int aoff = lds_byte(wr * 64 + fr, fq * 8), boff = lds_byte(wc * 32 + fr, fq * 8);
#define PG8_SA(b, h) (((b) * 2 + (h)) * HTB)
#define PG8_SB(b, h) ((4 + (b) * 2 + (h)) * HTB)
#define PG8_STAGE(bufoff, gbase, voff) do { _Pragma("unroll") for (int _i = 0; _i < 2; ++_i) \
        __builtin_amdgcn_global_load_lds((const unsigned*)((const char*)(gbase) + (voff)[_i]), (PG8_LAS unsigned*)(lds + (bufoff) + ldsw + _i * 8192), 16, 0, 0); } while (0)
#define PG8_LDA(dst, b, h) do { _Pragma("unroll") for (int m = 0; m < 4; ++m) _Pragma("unroll") for (int k = 0; k < 2; ++k) dst[m][k] = *(const PG8_LAS bf16x8*)(lds + PG8_SA(b, h) + aoff + m * 2048 + k * 1024); } while (0)
#define PG8_LDB(dst, b, h) do { _Pragma("unroll") for (int n = 0; n < 2; ++n) _Pragma("unroll") for (int k = 0; k < 2; ++k) dst[n][k] = *(const PG8_LAS bf16x8*)(lds + PG8_SB(b, h) + boff + n * 2048 + k * 1024); } while (0)
#define PG8_MMA(ai, bj, At, Bt) do { __builtin_amdgcn_s_setprio(1); _Pragma("unroll") for (int m = 0; m < 4; ++m) _Pragma("unroll") for (int n = 0; n < 2; ++n) _Pragma("unroll") for (int k = 0; k < 2; ++k) \
        acc[ai][bj][m][n] = __builtin_amdgcn_mfma_f32_16x16x32_bf16(Bt[n][k], At[m][k], acc[ai][bj][m][n], 0, 0, 0); __builtin_amdgcn_s_setprio(0); } while (0)
#define PG8_WAIT_V(n) asm volatile("s_waitcnt vmcnt(" #n ")" ::: "memory")
#define PG8_WAIT_L(n) asm volatile("s_waitcnt lgkmcnt(" #n ")" ::: "memory")
#define PG8_BAR __builtin_amdgcn_s_barrier()
#define PG8_SCHED __builtin_amdgcn_sched_barrier(0)
    Unit cur, nxt; int ui = 0;
    if (!S.next(0, cur)) return;
    f32x4 acc[2][2][4][2];
#pragma unroll
    for (int a = 0; a < 2; ++a)
#pragma unroll
        for (int b = 0; b < 2; ++b)
#pragma unroll
            for (int m = 0; m < 4; ++m)
#pragma unroll
                for (int n = 0; n < 2; ++n) acc[a][b][m][n] = (f32x4){0.f, 0.f, 0.f, 0.f};
    bf16x8 At[4][2], B0[2][2], B1[2][2];
    const char* cA = (const char*)g.A + (size_t)cur.pm * tstepA; const char* cB = (const char*)g.Bt + (size_t)cur.pn * tstepB;
    S.a_ready(cur);
    if constexpr (SP2) {
        PG8_STAGE(PG8_SB(0, 0), cB, voffB); PG8_STAGE(PG8_SB(0, 1), cB + hstepB, voffB); PG8_STAGE(PG8_SA(0, 0), cA, voffA); PG8_STAGE(PG8_SA(0, 1), cA + hstepA, voffA);
        if (wr == 1) PG8_BAR;
        PG8_WAIT_V(2); PG8_BAR;
        PG8_STAGE(PG8_SB(1, 0), cB + kstep, voffB); PG8_STAGE(PG8_SA(1, 0), cA + kstep, voffA); PG8_STAGE(PG8_SB(1, 1), cB + hstepB + kstep, voffB);
        PG8_WAIT_V(6); PG8_BAR;
    } else {
        PG8_STAGE(PG8_SB(0, 0), cB, voffB); PG8_STAGE(PG8_SA(0, 0), cA, voffA); PG8_STAGE(PG8_SB(0, 1), cB + hstepB, voffB); PG8_STAGE(PG8_SA(0, 1), cA + hstepA, voffA);
        if (wr == 1) PG8_BAR;
        PG8_WAIT_V(4); PG8_BAR;
        PG8_STAGE(PG8_SB(1, 0), cB + kstep, voffB); PG8_STAGE(PG8_SA(1, 0), cA + kstep, voffA); PG8_STAGE(PG8_SB(1, 1), cB + hstepB + kstep, voffB);
        PG8_WAIT_V(6); PG8_BAR;
    }
    for (;;) {
        const bool has_next = S.next(ui + 1, nxt);
        const char* nA = has_next ? (const char*)g.A + (size_t)nxt.pm * tstepA : cA; const char* nB = has_next ? (const char*)g.Bt + (size_t)nxt.pn * tstepB : cB;
        for (int t = 0; t < nt; t += 2) {
            const bool last = (t == nt - 2);
            const char* a1 = cA + (size_t)(t + 1) * kstep;
            const char* a2 = last ? nA : cA + (size_t)(t + 2) * kstep; const char* b2 = last ? nB : cB + (size_t)(t + 2) * kstep;
            const char* a3 = a2 + kstep; const char* b3 = b2 + kstep;
            if (last && has_next) S.a_ready(nxt);
            if constexpr (SP2) {
            PG8_LDB(B0, 0, 0); PG8_LDB(B1, 0, 1); PG8_SCHED; PG8_LDA(At, 0, 0); PG8_STAGE(PG8_SA(1, 1), a1 + hstepA, voffA);
            PG8_WAIT_V(8); PG8_WAIT_L(0); PG8_BAR; PG8_MMA(0, 0, At, B0); PG8_MMA(0, 1, At, B1); PG8_BAR; PG8_SCHED;
            PG8_LDA(At, 0, 1); PG8_STAGE(PG8_SB(0, 0), b2, voffB); PG8_STAGE(PG8_SB(0, 1), b2 + hstepB, voffB); PG8_STAGE(PG8_SA(0, 0), a2, voffA);
            PG8_WAIT_V(8); PG8_WAIT_L(0); PG8_BAR; PG8_MMA(1, 0, At, B0); PG8_MMA(1, 1, At, B1); PG8_BAR; PG8_SCHED;
            PG8_LDB(B0, 1, 0); PG8_LDB(B1, 1, 1); PG8_SCHED; PG8_LDA(At, 1, 0); PG8_STAGE(PG8_SA(0, 1), a2 + hstepA, voffA);
            PG8_WAIT_V(8); PG8_WAIT_L(0); PG8_BAR; PG8_MMA(0, 0, At, B0); PG8_MMA(0, 1, At, B1); PG8_BAR; PG8_SCHED;
            PG8_LDA(At, 1, 1); PG8_STAGE(PG8_SB(1, 0), b3, voffB); PG8_STAGE(PG8_SB(1, 1), b3 + hstepB, voffB); PG8_STAGE(PG8_SA(1, 0), a3, voffA);
            PG8_WAIT_V(8); PG8_WAIT_L(0); PG8_BAR; PG8_MMA(1, 0, At, B0); PG8_MMA(1, 1, At, B1); PG8_BAR; PG8_SCHED;
            } else {
            PG8_LDB(B0, 0, 0); PG8_SCHED; PG8_LDA(At, 0, 0); PG8_STAGE(PG8_SA(1, 1), a1 + hstepA, voffA);
            PG8_WAIT_L(8); PG8_BAR; PG8_WAIT_L(0); PG8_MMA(0, 0, At, B0); PG8_BAR; PG8_SCHED;
            PG8_LDB(B1, 0, 1); PG8_STAGE(PG8_SB(0, 0), b2, voffB);
            PG8_BAR; PG8_WAIT_L(0); PG8_MMA(0, 1, At, B1); PG8_BAR;
            PG8_LDA(At, 0, 1); PG8_STAGE(PG8_SA(0, 0), a2, voffA);
            PG8_BAR; PG8_WAIT_L(0); PG8_MMA(1, 0, At, B0); PG8_BAR; PG8_SCHED;
            PG8_STAGE(PG8_SB(0, 1), b2 + hstepB, voffB);
            PG8_WAIT_V(6); PG8_BAR; PG8_MMA(1, 1, At, B1); PG8_BAR;
            PG8_LDB(B0, 1, 0); PG8_SCHED; PG8_LDA(At, 1, 0); PG8_STAGE(PG8_SA(0, 1), a2 + hstepA, voffA);
            PG8_WAIT_L(8); PG8_BAR; PG8_WAIT_L(0); PG8_MMA(0, 0, At, B0); PG8_BAR; PG8_SCHED;
            PG8_LDB(B1, 1, 1); PG8_STAGE(PG8_SB(1, 0), b3, voffB);
            PG8_BAR; PG8_WAIT_L(0); PG8_MMA(0, 1, At, B1); PG8_BAR;
            PG8_LDA(At, 1, 1); PG8_STAGE(PG8_SA(1, 0), a3, voffA);
            PG8_BAR; PG8_WAIT_L(0); PG8_MMA(1, 0, At, B0); PG8_BAR; PG8_SCHED;
            PG8_STAGE(PG8_SB(1, 1), b3 + hstepB, voffB);
            PG8_WAIT_V(6); PG8_BAR; PG8_MMA(1, 1, At, B1); PG8_BAR;
            }
        }
        if constexpr (ALIGN_EPI) { if (wr == 0) PG8_BAR; }
        if constexpr (!Epi::AFTER_DRAIN) { E(acc, cur, wr, wc, fr, fq); S.done(cur); }
        if (!has_next) break;
#pragma unroll
        for (int a = 0; a < 2; ++a)
#pragma unroll
            for (int b = 0; b < 2; ++b)
#pragma unroll
                for (int m = 0; m < 4; ++m)
#pragma unroll
                    for (int n = 0; n < 2; ++n) acc[a][b][m][n] = (f32x4){0.f, 0.f, 0.f, 0.f};
        cur = nxt; cA = nA; cB = nB; ++ui;
        if constexpr (ALIGN_EPI) { if (wr == 1) PG8_BAR; }
    }
    PG8_WAIT_V(0);
    if constexpr (!ALIGN_EPI) { if (wr == 0) PG8_BAR; }
    PG8_BAR;
    if constexpr (Epi::AFTER_DRAIN) { E.fused(acc, cur, wr, wc, fr, fq, lds, wid, lane); S.done(cur); }
#undef PG8_SA
#undef PG8_SB
#undef PG8_STAGE
#undef PG8_LDA
#undef PG8_LDB
#undef PG8_MMA
#undef PG8_WAIT_V
#undef PG8_WAIT_L
#undef PG8_BAR
#undef PG8_SCHED
}
}

template <int MODE>
__device__ __forceinline__ void p0_transpose_item(const float* W, int K, int Nsrc, int nblk, bf16_t* WT, const float* gvec, LAS float* scr, int item, int lane) {
    const int kb = item / nblk, nb = item % nblk, k0 = 64 * kb, n0 = 32 * nb;
    const int nd = n0 + (lane & 31);
    const int col = (MODE == 0) ? colmap0(nd) : nd;
#pragma unroll 8
    for (int i = 0; i < 32; ++i) { const int kk = 2 * i + (lane >> 5);
        float v = (col >= 0) ? W[(size_t)(k0 + kk) * Nsrc + col] : 0.f;
        if (MODE != 1) v *= gvec[k0 + kk];
        scr[kk * 33 + (lane & 31)] = v; }
    asm volatile("s_waitcnt lgkmcnt(0)" ::: "memory");
    const int c = lane & 7;
#pragma unroll
    for (int j = 0; j < 4; ++j) { const int n = (lane >> 3) + 8 * j; const LAS float* s = scr + (8 * c) * 33 + n;
        u32x4 o; o.x = pk2(s[0 * 33], s[1 * 33]); o.y = pk2(s[2 * 33], s[3 * 33]); o.z = pk2(s[4 * 33], s[5 * 33]); o.w = pk2(s[6 * 33], s[7 * 33]);
        *(u32x4*)(WT + (size_t)(n0 + n) * K + k0 + 8 * c) = o; }
    asm volatile("s_waitcnt lgkmcnt(0)" ::: "memory");
}

__device__ __forceinline__ void p0_prologue(const Args& a, LAS unsigned char* lds, int vcu, int G, int wave, int lane) {
    unsigned char* ws = a.ws;
    LAS float* scr = (LAS float*)(lds + wave * 16384);
    const int gw = vcu * NWAVES + wave, NGW = G * NWAVES;
    constexpr int I0 = (DM / 64) * (N0 / 32), IO = (MIXW / 64) * (DM / 32), I1 = (DM / 64) * (N1 / 32);
    constexpr int NITEMS = I0 + IO + I1 + IO;
    for (int it = gw; it < NITEMS; it += NGW) {
        int r = it;
        if (r < I0) { p0_transpose_item<0>(a.in[2], DM, N0_SRC, N0 / 32, (bf16_t*)(ws + WS_WT0), a.in[1], scr, r, lane); continue; } r -= I0;
        if (r < IO) { p0_transpose_item<1>(a.in[12], MIXW, DM, DM / 32, (bf16_t*)(ws + WS_WTO0), nullptr, scr, r, lane); continue; } r -= IO;
        if (r < I1) { p0_transpose_item<2>(a.in[14], DM, N1, N1 / 32, (bf16_t*)(ws + WS_WT1), a.in[13], scr, r, lane); continue; } r -= I1;
        p0_transpose_item<1>(a.in[19], MIXW, DM, DM / 32, (bf16_t*)(ws + WS_WTO1), nullptr, scr, r, lane);
    }
    const float* x = a.in[0]; bf16_t* XB = (bf16_t*)(ws + WS_XB); float* rstd0 = (float*)(ws + WS_RSTD0);
    for (int m = gw; m < MTOK; m += NGW) {
        const f32x4* xr = (const f32x4*)(x + (size_t)m * DM) + lane;
        u32x2* o8 = (u32x2*)(XB + (size_t)m * DM) + lane;
        float s = 0.f;
#pragma unroll
        for (int j = 0; j < 8; ++j) { const f32x4 v = xr[64 * j]; s += (v.x * v.x + v.y * v.y) + (v.z * v.z + v.w * v.w);
            u32x2 w; w.x = pk2(v.x, v.y); w.y = pk2(v.z, v.w); o8[64 * j] = w; }
        s = wave_sum(s);
        if (lane == 0) rstd0[m] = 1.0f / sqrtf(s * (1.0f / DM) + EPS);
    }
    const int gt = gw * 64 + lane, NGT = NGW * 64;
    float* SS1 = (float*)(ws + WS_SS1); float* LNS = (float*)(ws + WS_LNS);
    for (int i = gt; i < MTOK; i += NGT) { SS1[i] = 0.f; LNS[2 * i] = 0.f; LNS[2 * i + 1] = 0.f; }
    float* COS = (float*)(ws + WS_COS); float* SIN = (float*)(ws + WS_SIN);
    for (int i = gt; i < SEQ * 16; i += NGT) { const int t = i >> 4, f = i & 15;
        const float inv = powf(500000.0f, -((float)f * 2.0f) / 32.0f); const float ang = (float)t * inv;
        COS[i] = cosf(ang); SIN[i] = sinf(ang); }
}

__device__ __forceinline__ void p2_conv(const Args& a, int gt, int NGT) {
    bf16_t* ZC = (bf16_t*)(a.ws + WS_ZC); const float* cw = a.in[3];
    for (int idx = gt; idx < MTOK * 256; idx += NGT) {
        const int row = idx >> 8, c8 = (idx & 255) * 8, t = row & (SEQ - 1);
        bf16_t* base = ZC + (size_t)row * ZC_LD + c8;
        const u32x4 cb = *(const u32x4*)base, cg = *(const u32x4*)(base + 6144);
        const u32x4 cc0 = *(const u32x4*)(base + 2048), ch0 = *(const u32x4*)(base + 4096);
        u32x4 cc1 = {0, 0, 0, 0}, ch1 = {0, 0, 0, 0}, cc2 = {0, 0, 0, 0}, ch2 = {0, 0, 0, 0};
        if (t >= 1) { cc1 = *(const u32x4*)(base - ZC_LD + 2048); ch1 = *(const u32x4*)(base - ZC_LD + 4096); }
        if (t >= 2) { cc2 = *(const u32x4*)(base - 2 * ZC_LD + 2048); ch2 = *(const u32x4*)(base - 2 * ZC_LD + 4096); }
        float w0[8], w1[8], w2[8];
#pragma unroll
        for (int j = 0; j < 8; ++j) { w0[j] = cw[c8 + j]; w1[j] = cw[DM + c8 + j]; w2[j] = cw[2 * DM + c8 + j]; }
        u32x4 o;
#pragma unroll
        for (int q = 0; q < 4; ++q) {
            float r[2];
#pragma unroll
            for (int hh = 0; hh < 2; ++hh) {
                const int j = 2 * q + hh;
                const float p0 = hh ? bf_hi(cc0[q]) * bf_hi(ch0[q]) : bf_lo(cc0[q]) * bf_lo(ch0[q]);
                const float p1 = hh ? bf_hi(cc1[q]) * bf_hi(ch1[q]) : bf_lo(cc1[q]) * bf_lo(ch1[q]);
                const float p2 = hh ? bf_hi(cc2[q]) * bf_hi(ch2[q]) : bf_lo(cc2[q]) * bf_lo(ch2[q]);
                const float conv = w0[j] * p2 + w1[j] * p1 + w2[j] * p0;
                const float b = hh ? bf_hi(cb[q]) : bf_lo(cb[q]); const float g = hh ? bf_hi(cg[q]) : bf_lo(cg[q]);
                r[hh] = b * conv * silu_f(g);
            }
            o[q] = pk2(r[0], r[1]);
        }
        *(u32x4*)base = o;
    }
}

__device__ __forceinline__ void p2_compress(const Args& a, LAS unsigned char* lds, int blk, int G, int tid) {
    LAS float* tok = (LAS float*)lds;
    LAS float* pos = (LAS float*)(lds + 73728);
    LAS float* red = (LAS float*)(lds + 73728 + 16384);
    LAS float* hid = (LAS float*)(lds + 73728 + 32768);
    const int j = tid & 127, iq = tid >> 7;
    for (int unit = blk; unit < 2 * 16 * 16; unit += G) {
        const int kv = unit >> 8, bg = (unit >> 4) & 15, cg8 = unit & 15;
        const bf16_t* src = (const bf16_t*)(a.ws + WS_KV) + (size_t)kv * KV_ELEMS + ((size_t)bg * SEQ + 128 * cg8) * HD;
        const float* posg = a.in[kv ? 8 : 4]; const float* w1 = a.in[kv ? 9 : 5]; const float* b1 = a.in[kv ? 10 : 6]; const float* w2 = a.in[kv ? 11 : 7];
        const int ntok = (cg8 == 15) ? 128 : 144;
        __syncthreads();
        for (int i = tid; i < ntok * 128; i += NTHREADS) tok[i] = bf2f(src[i]);
        for (int i = tid; i < 4096; i += NTHREADS) pos[i] = posg[i];
        __syncthreads();
        float acc[8];
#pragma unroll
        for (int cc = 0; cc < 8; ++cc) acc[cc] = 0.f;
        const int ncc = (cg8 == 15) ? 7 : 8;
        for (int i = iq * 1024; i < iq * 1024 + 1024; ++i) {
            const float w = w1[(size_t)i * 128 + j]; const float p = pos[i];
#pragma unroll
            for (int cc = 0; cc < 8; ++cc) if (cc < ncc) acc[cc] += (tok[cc * 2048 + i] + p) * w;
        }
#pragma unroll
        for (int cc = 0; cc < 8; ++cc) red[(iq * 8 + cc) * 128 + j] = acc[cc];
        __syncthreads();
        for (int i = tid; i < 8 * 128; i += NTHREADS) { const int jj = i & 127;
            const float h = red[i] + red[1024 + i] + red[2048 + i] + red[3072 + i] + b1[jj]; hid[i] = silu_f(h); }
        __syncthreads();
        bf16_t* dst = (bf16_t*)(a.ws + (kv ? WS_VC : WS_KC)) + (size_t)bg * 128 * 128;
        for (int o = tid; o < 8 * 128; o += NTHREADS) { const int cc = o >> 7, d = o & 127;
            if (cc < ncc) { float s = 0.f;
                for (int jj = 0; jj < 128; ++jj) s += hid[cc * 128 + jj] * w2[jj * 128 + d];
                dst[(size_t)(8 * cg8 + cc) * 128 + d] = (bf16_t)f2bf(s); } }
    }
    __syncthreads();
}

__device__ __forceinline__ void attn_batch(const bf16_t* Kb, const bf16_t* Vb, int first, int lo, int hi, bool valid, const LAS float* qs,
                                           float (&m)[4], float (&l)[4], float (&o)[4][2], int lane) {
    int kr = first + lane; kr = kr < lo ? lo : (kr > hi ? hi : kr);
    const u32x4* kp = (const u32x4*)(Kb + (size_t)kr * HD);
    float s[4] = {0.f, 0.f, 0.f, 0.f};
#pragma unroll 4
    for (int c = 0; c < 16; ++c) { const u32x4 kv = kp[c];
        float kf[8]; kf[0] = bf_lo(kv.x); kf[1] = bf_hi(kv.x); kf[2] = bf_lo(kv.y); kf[3] = bf_hi(kv.y); kf[4] = bf_lo(kv.z); kf[5] = bf_hi(kv.z); kf[6] = bf_lo(kv.w); kf[7] = bf_hi(kv.w);
#pragma unroll
        for (int h = 0; h < 4; ++h) { const LAS f32x4* q4 = (const LAS f32x4*)(qs + h * HD + c * 8); const f32x4 qa = q4[0], qb = q4[1];
            s[h] += (qa[0] * kf[0] + qa[1] * kf[1]) + (qa[2] * kf[2] + qa[3] * kf[3]) + (qb[0] * kf[4] + qb[1] * kf[5]) + (qb[2] * kf[6] + qb[3] * kf[7]); }
    }
    float ps[4];
#pragma unroll
    for (int h = 0; h < 4; ++h) {
        const float sv = valid ? s[h] : -INFINITY;
        const float bm = wave_max(sv); const float mn = fmaxf(m[h], bm);
        float p = 0.f, alpha = 1.f;
        if (mn > -INFINITY) { p = valid ? __expf(sv - mn) : 0.f; alpha = (m[h] > -INFINITY) ? __expf(m[h] - mn) : 0.f; }
        l[h] = l[h] * alpha + wave_sum(p); o[h][0] *= alpha; o[h][1] *= alpha; m[h] = mn; ps[h] = p;
    }
    for (int jj = 0; jj < 64; ++jj) {
        int vr = first + jj; vr = vr < lo ? lo : (vr > hi ? hi : vr);
        const unsigned vv = *(const unsigned*)(Vb + (size_t)vr * HD + 2 * lane);
        const float v0 = bf_lo(vv), v1 = bf_hi(vv);
#pragma unroll
        for (int h = 0; h < 4; ++h) { const float pj = __shfl(ps[h], jj); o[h][0] += pj * v0; o[h][1] += pj * v1; }
    }
}

__device__ __forceinline__ void p3_nsa_naive(const Args& a, LAS unsigned char* lds, int gw, int NGW, int wave, int lane) {
    unsigned char* ws = a.ws;
    LAS float* qs = (LAS float*)(lds + wave * 8192);
    LAS float* qr = qs + 512;
    LAS float* Pc = qr + 512;
    const bf16_t* Q = (const bf16_t*)(ws + WS_Q); const bf16_t* KVb = (const bf16_t*)(ws + WS_KV);
    const bf16_t* KC = (const bf16_t*)(ws + WS_KC); const bf16_t* VC = (const bf16_t*)(ws + WS_VC);
    const float* GL = (const float*)(ws + WS_GL); const bf16_t* NG = (const bf16_t*)(ws + WS_NG);
    const float* COS = (const float*)(ws + WS_COS); const float* SIN = (const float*)(ws + WS_SIN);
    bf16_t* ZC = (bf16_t*)(ws + WS_ZC);
    const float scale = 0.08838834764831845f;
    for (int task = gw; task < NB * NKV * SEQ; task += NGW) {
        const int t = task & (SEQ - 1), bg = task >> 11, b = bg >> 2, g = bg & 3;
        const int row = b * SEQ + t;
        { const u32x4 qv = *(const u32x4*)(Q + (size_t)row * DM + g * 512 + lane * 8);
          float f[8]; f[0] = bf_lo(qv.x); f[1] = bf_hi(qv.x); f[2] = bf_lo(qv.y); f[3] = bf_hi(qv.y); f[4] = bf_lo(qv.z); f[5] = bf_hi(qv.z); f[6] = bf_lo(qv.w); f[7] = bf_hi(qv.w);
#pragma unroll
          for (int j = 0; j < 8; ++j) { qs[lane * 8 + j] = f[j] * scale; qr[lane * 8 + j] = f[j] * scale; } }
        asm volatile("s_waitcnt lgkmcnt(0)" ::: "memory");
        { const int h = lane >> 4, i = lane & 15; const float x1 = qs[h * HD + i], x2 = qs[h * HD + 16 + i]; const float c = COS[t * 16 + i], s = SIN[t * 16 + i];
          qr[h * HD + i] = x1 * c - x2 * s; qr[h * HD + 16 + i] = x2 * c + x1 * s; }
        asm volatile("s_waitcnt lgkmcnt(0)" ::: "memory");
        float oc[4][2], Pl0 = 0.f, Pl1 = 0.f;
        {
            const bf16_t* Kc = KC + (size_t)bg * 128 * 128; const bf16_t* Vc = VC + (size_t)bg * 128 * 128;
            const int c0 = lane, c1 = 64 + lane;
            const bool v0 = (16 * c0 + 31 <= t), v1 = (c1 < NCMP) && (16 * c1 + 31 <= t);
            const int r1 = c1 < NCMP ? c1 : NCMP - 1;
            float s0[4] = {0.f, 0.f, 0.f, 0.f}, s1[4] = {0.f, 0.f, 0.f, 0.f};
            const u32x4* k0p = (const u32x4*)(Kc + (size_t)c0 * HD); const u32x4* k1p = (const u32x4*)(Kc + (size_t)r1 * HD);
#pragma unroll 2
            for (int c = 0; c < 16; ++c) { const u32x4 ka = k0p[c], kb = k1p[c];
                float fa[8], fb[8];
                fa[0] = bf_lo(ka.x); fa[1] = bf_hi(ka.x); fa[2] = bf_lo(ka.y); fa[3] = bf_hi(ka.y); fa[4] = bf_lo(ka.z); fa[5] = bf_hi(ka.z); fa[6] = bf_lo(ka.w); fa[7] = bf_hi(ka.w);
                fb[0] = bf_lo(kb.x); fb[1] = bf_hi(kb.x); fb[2] = bf_lo(kb.y); fb[3] = bf_hi(kb.y); fb[4] = bf_lo(kb.z); fb[5] = bf_hi(kb.z); fb[6] = bf_lo(kb.w); fb[7] = bf_hi(kb.w);
#pragma unroll
                for (int h = 0; h < 4; ++h)
#pragma unroll
                    for (int jj = 0; jj < 8; ++jj) { const float qv = qs[h * HD + c * 8 + jj]; s0[h] += qv * fa[jj]; s1[h] += qv * fb[jj]; } }
            float p0[4], p1[4];
#pragma unroll
            for (int h = 0; h < 4; ++h) {
                const float a0 = v0 ? s0[h] : -INFINITY, a1 = v1 ? s1[h] : -INFINITY;
                const float mx = wave_max(fmaxf(a0, a1));
                float e0 = 0.f, e1 = 0.f;
                if (mx > -INFINITY) { e0 = v0 ? __expf(a0 - mx) : 0.f; e1 = v1 ? __expf(a1 - mx) : 0.f; }
                const float den = wave_sum(e0 + e1); const float inv = den > 0.f ? 1.0f / den : 1.0f;
                p0[h] = e0 * inv; p1[h] = e1 * inv; Pl0 += p0[h]; Pl1 += p1[h];
                oc[h][0] = 0.f; oc[h][1] = 0.f;
            }
            for (int jj = 0; jj < 64; ++jj) {
                const unsigned va = *(const unsigned*)(Vc + (size_t)jj * HD + 2 * lane);
                const int rr = (64 + jj) < NCMP ? (64 + jj) : NCMP - 1;
                const unsigned vb = *(const unsigned*)(Vc + (size_t)rr * HD + 2 * lane);
#pragma unroll
                for (int h = 0; h < 4; ++h) { const float pa = __shfl(p0[h], jj), pb = __shfl(p1[h], jj);
                    oc[h][0] += pa * bf_lo(va) + pb * bf_lo(vb); oc[h][1] += pa * bf_hi(va) + pb * bf_hi(vb); }
            }
            Pc[lane] = Pl0; Pc[64 + lane] = Pl1;
        }
        asm volatile("s_waitcnt lgkmcnt(0)" ::: "memory");
        unsigned selmask = 0u;
        {
            const int cur = t >> 6;
            float val = -INFINITY;
            if (lane < 32) {
                if (lane == 0 || lane == cur) val = INFINITY;
                else if (64 * lane <= t) { float s = 0.f;
                    for (int c = 4 * lane - 1; c <= 4 * lane + 3; ++c) if (c >= 0 && c < NCMP) s += Pc[c];
                    val = s; }
            }
            bool taken = (lane >= 32);
            for (int r = 0; r < 8; ++r) {
                const float cand = taken ? -INFINITY : val;
                const float mx = wave_max(cand);
                if (!(mx > -INFINITY)) break;
                const unsigned long long bal = __ballot(!taken && cand == mx);
                const int idx = __ffsll((long long)bal) - 1;
                selmask |= 1u << idx;
                if (lane == idx) taken = true;
            }
        }
        float os[4][2], ms[4], ls[4];
#pragma unroll
        for (int h = 0; h < 4; ++h) { os[h][0] = 0.f; os[h][1] = 0.f; ms[h] = -INFINITY; ls[h] = 0.f; }
        {
            const bf16_t* Ks = KVb + 2 * KV_ELEMS + (size_t)bg * SEQ * HD; const bf16_t* Vs = KVb + 3 * KV_ELEMS + (size_t)bg * SEQ * HD;
            unsigned mk = selmask;
            while (mk) { const int jb = __ffs((int)mk) - 1; mk &= mk - 1;
                attn_batch(Ks, Vs, 64 * jb, 0, SEQ - 1, (64 * jb + lane) <= t, qr, ms, ls, os, lane); }
        }
        float ow[4][2], mw[4], lw[4];
#pragma unroll
        for (int h = 0; h < 4; ++h) { ow[h][0] = 0.f; ow[h][1] = 0.f; mw[h] = -INFINITY; lw[h] = 0.f; }
        {
            const bf16_t* Kw = KVb + 4 * KV_ELEMS + (size_t)bg * SEQ * HD; const bf16_t* Vw = KVb + 5 * KV_ELEMS + (size_t)bg * SEQ * HD;
            const int first = t - 511;
            for (int b8 = 0; b8 < 8; ++b8) { const int f0 = first + 64 * b8;
                if (f0 + 63 < 0) continue;
                attn_batch(Kw, Vw, f0, 0, SEQ - 1, (f0 + lane) >= 0, qr, mw, lw, ow, lane); }
        }
#pragma unroll
        for (int h = 0; h < 4; ++h) {
            const int hh = g * 4 + h;
            const float g0 = sigmoid_f(GL[(size_t)row * 48 + hh]), g1 = sigmoid_f(GL[(size_t)row * 48 + 16 + hh]), g2 = sigmoid_f(GL[(size_t)row * 48 + 32 + hh]);
            const float is = ls[h] > 0.f ? 1.0f / ls[h] : 0.f, iw = lw[h] > 0.f ? 1.0f / lw[h] : 0.f;
            const unsigned ngv = *(const unsigned*)(NG + (size_t)row * DM + hh * HD + 2 * lane);
            const float y0 = (g0 * oc[h][0] + g1 * os[h][0] * is + g2 * ow[h][0] * iw) * silu_f(bf_lo(ngv));
            const float y1 = (g0 * oc[h][1] + g1 * os[h][1] * is + g2 * ow[h][1] * iw) * silu_f(bf_hi(ngv));
            *(unsigned*)(ZC + (size_t)row * ZC_LD + 2048 + hh * HD + 2 * lane) = pk2(y0, y1);
        }
    }
}

__device__ __forceinline__ void p6_sgu_naive(const Args& a, LAS unsigned char* lds, int blk, int G, int tid) {
    LAS float* vn = (LAS float*)lds;
    LAS float* Wt = (LAS float*)(lds + 65536);
    bf16_t* Z1 = (bf16_t*)(a.ws + WS_Z1); const float* LNS = (const float*)(a.ws + WS_LNS);
    const float* lng = a.in[15]; const float* lnb = a.in[16]; const float* wsp = a.in[17]; const float* bsp = a.in[18];
    const int d = tid & 127, tq = tid >> 7;
    for (int unit = blk; unit < 64 * 16 * 2; unit += G) {
        const int dh = unit & 1, h = (unit >> 1) & 15, ch = unit >> 5;
        const int row0 = ch * 128, col = h * 256 + dh * 128;
        __syncthreads();
        for (int i = tid; i < 128 * 128; i += NTHREADS) { const int s = i >> 7, dd = i & 127; const int row = row0 + s;
            const float sum = LNS[2 * row], sq = LNS[2 * row + 1]; const float mu = sum * (1.0f / MIXW); const float var = sq * (1.0f / MIXW) - mu * mu;
            const float rstd = 1.0f / sqrtf(fmaxf(var, 0.f) + EPS);
            const float v = bf2f(Z1[(size_t)row * N1 + MIXW + col + dd]);
            vn[i] = (v - mu) * rstd * lng[col + dd] + lnb[col + dd];
            Wt[i] = wsp[(size_t)h * 16384 + i]; }
        __syncthreads();
        for (int tt = 0; tt < 32; ++tt) {
            const int t = tq + 4 * tt;
            float mix = 0.f;
            for (int s = 0; s <= t; ++s) mix += Wt[t * 128 + s] * vn[s * 128 + d];
            mix += bsp[h * 128 + t];
            const size_t off = (size_t)(row0 + t) * N1 + col + d;
            const float u = bf2f(Z1[off]), zg = bf2f(Z1[off + 2 * MIXW]);
            Z1[off] = (bf16_t)f2bf(u * mix * silu_f(zg));
        }
    }
    __syncthreads();
}

__device__ __forceinline__ void p8_final(const Args& a, int gw, int NGW, int lane) {
    const float* gf = a.in[20];
    for (int m = gw; m < MTOK; m += NGW) {
        f32x4* xr = (f32x4*)(a.out + (size_t)m * DM) + lane;
        f32x4 v[8]; float s = 0.f;
#pragma unroll
        for (int j = 0; j < 8; ++j) { v[j] = xr[64 * j]; s += (v[j].x * v[j].x + v[j].y * v[j].y) + (v[j].z * v[j].z + v[j].w * v[j].w); }
        s = wave_sum(s);
        const float rs = 1.0f / sqrtf(s * (1.0f / DM) + EPS);
#pragma unroll
        for (int j = 0; j < 8; ++j) { const f32x4 gg = *((const f32x4*)gf + lane + 64 * j); xr[64 * j] = v[j] * rs * gg; }
    }
}

constexpr int NPHASE = 9;
template <bool COOP>
__global__ void __launch_bounds__(NTHREADS, 2) fwd_kernel(Args args) {
    extern __shared__ __attribute__((aligned(16))) unsigned char lds_raw[];
    LAS unsigned char* lds = (LAS unsigned char*)lds_raw;
    const int tid = threadIdx.x, lane = tid & 63, wave = __builtin_amdgcn_readfirstlane(tid >> 6);
    const int G = gridDim.x, bx = blockIdx.x;
    const int vcu = (G % 8 == 0) ? (bx % 8) * (G / 8) + bx / 8 : bx;
    const int gw = vcu * NWAVES + wave, NGW = G * NWAVES, gt = gw * 64 + lane, NGT = NGW * 64;
    const int lo = args.ph_lo, hi = args.ph_hi;
    unsigned char* ws = args.ws;
#define IN(k) (lo <= (k) && (k) < hi)
#define SEAM(k) do { if (COOP) { if (IN(k) && IN((k) + 1)) { __threadfence(); cg::this_grid().sync(); __threadfence(); } } } while (0)

    if (IN(0)) { p0_prologue(args, lds, vcu, G, wave, lane); }
    SEAM(0);
    if (IN(1)) {
        pg8::Gemm g{(const bf16_t*)(ws + WS_XB), (const bf16_t*)(ws + WS_WT0), MTOK, N0, DM, DM};
        pg8::StaticOrder S; S.init(MTOK, N0, G, bx);
        pg8::Epi0 E{(const float*)(ws + WS_RSTD0), (bf16_t*)(ws + WS_ZC), (bf16_t*)(ws + WS_Q), (bf16_t*)(ws + WS_KV), (bf16_t*)(ws + WS_NG), (float*)(ws + WS_GL),
                    (const float*)(ws + WS_COS), (const float*)(ws + WS_SIN)};
        pg8::gemm_phase<pg8::Epi0, pg8::StaticOrder, true, true>(lds, g, S, E);
    }
    SEAM(1);
    if (IN(2)) { p2_compress(args, lds, vcu, G, tid); p2_conv(args, gt, NGT); }
    SEAM(2);
    if (IN(3)) { p3_nsa_naive(args, lds, gw, NGW, wave, lane); }
    SEAM(3);
    if (IN(4)) {
        pg8::Gemm g{(const bf16_t*)(ws + WS_ZC), (const bf16_t*)(ws + WS_WTO0), MTOK, DM, MIXW, ZC_LD};
        pg8::StaticOrder S; S.init(MTOK, DM, G, bx);
        pg8::EpiOut0 E{args.in[0], args.out, (bf16_t*)(ws + WS_XB), (float*)(ws + WS_SS1)};
        pg8::gemm_phase<pg8::EpiOut0, pg8::StaticOrder, true, true>(lds, g, S, E);
    }
    SEAM(4);
    if (IN(5)) {
        pg8::Gemm g{(const bf16_t*)(ws + WS_XB), (const bf16_t*)(ws + WS_WT1), MTOK, N1, DM, DM};
        pg8::StaticOrder S; S.init(MTOK, N1, G, bx);
        pg8::Epi1 E{(const float*)(ws + WS_SS1), (bf16_t*)(ws + WS_Z1), (float*)(ws + WS_LNS)};
        pg8::gemm_phase<pg8::Epi1, pg8::StaticOrder, true, true>(lds, g, S, E);
    }
    SEAM(5);
    if (IN(6)) { p6_sgu_naive(args, lds, vcu, G, tid); }
    SEAM(6);
    if (IN(7)) {
        pg8::Gemm g{(const bf16_t*)(ws + WS_Z1), (const bf16_t*)(ws + WS_WTO1), MTOK, DM, MIXW, N1};
        pg8::StaticOrder S; S.init(MTOK, DM, G, bx);
        pg8::EpiOut1 E{args.out};
        pg8::gemm_phase<pg8::EpiOut1, pg8::StaticOrder, true, true>(lds, g, S, E);
    }
    SEAM(7);
    if (IN(8)) { p8_final(args, gw, NGW, lane); }
#undef IN
#undef SEAM
}

#ifndef MK_COOP
#define MK_COOP 1
#endif

extern "C" void kernel_launch(void* const* d_in, const int* in_sizes, int n_in, void* d_out, int out_size, void* d_ws, size_t ws_size, hipStream_t stream) {
    static int grid = 0;
    if (grid == 0) {
        if (n_in != 21 || out_size != MTOK * DM || ws_size < WS_END) { fprintf(stderr, "kernel_launch: unexpected shapes (n_in %d out %d ws %zu)\n", n_in, out_size, ws_size); grid = -1; return; }
        int dev = 0, cus = 0, per_cu = 0;
        (void)hipGetDevice(&dev); (void)hipDeviceGetAttribute(&cus, hipDeviceAttributeMultiprocessorCount, dev);
        (void)hipFuncSetAttribute((const void*)fwd_kernel<true>, hipFuncAttributeMaxDynamicSharedMemorySize, LDS_BYTES);
        (void)hipFuncSetAttribute((const void*)fwd_kernel<false>, hipFuncAttributeMaxDynamicSharedMemorySize, LDS_BYTES);
        (void)hipOccupancyMaxActiveBlocksPerMultiprocessor(&per_cu, (const void*)fwd_kernel<true>, NTHREADS, LDS_BYTES);
        if (per_cu < 1) { fprintf(stderr, "kernel_launch: occupancy query says %d blocks per CU\n", per_cu); per_cu = 1; }
        (void)hipGetLastError();
        grid = cus;
        fprintf(stderr, "kernel_launch: grid %d (per_cu %d)\n", grid, per_cu);
    }
    if (grid < 0) return;
    Args a{};
    for (int i = 0; i < 21; ++i) a.in[i] = (const float*)d_in[i];
    a.out = (float*)d_out; a.ws = (unsigned char*)d_ws;
#if MK_COOP
    a.ph_lo = 0; a.ph_hi = NPHASE;
    void* kargs[] = {&a};
    hipError_t e = hipLaunchCooperativeKernel((const void*)fwd_kernel<true>, dim3(grid), dim3(NTHREADS), kargs, LDS_BYTES, stream);
    if (e != hipSuccess) fprintf(stderr, "cooperative launch failed: %s (grid %d)\n", hipGetErrorString(e), grid);
#else
    for (int p = 0; p < NPHASE; ++p) {
        a.ph_lo = p; a.ph_hi = p + 1;
        hipLaunchKernelGGL(fwd_kernel<false>, dim3(grid), dim3(NTHREADS), LDS_BYTES, stream, a);
    }
#endif
}
```

```cpp
#include <hip/hip_runtime.h>
#include <hip/hip_cooperative_groups.h>
#include <cstdio>
#include <cstdint>
namespace cg = cooperative_groups;

#define LAS __attribute__((address_space(3)))
typedef unsigned short bf16_t;
typedef short bf16x8 __attribute__((ext_vector_type(8)));
typedef float f32x4 __attribute__((ext_vector_type(4)));
typedef float f32x2 __attribute__((ext_vector_type(2)));
typedef unsigned u32x4 __attribute__((ext_vector_type(4)));
typedef unsigned u32x2 __attribute__((ext_vector_type(2)));

constexpr int DM = 2048, NB = 4, SEQ = 2048, MTOK = NB * SEQ;
constexpr int N0 = 15616, N0_SRC = 15408;
constexpr int N1 = 12288, MIXW = 4096;
constexpr int ZC_LD = 8192;
constexpr float EPS = 1e-6f;
constexpr int NKV = 4, HD = 128, NH = 16;
constexpr int NCMP = 127;

constexpr size_t MiB = 1u << 20;
constexpr size_t WS_BAR = 0;
constexpr size_t WS_RSTD0 = 1 * MiB, WS_SS1 = WS_RSTD0 + 32768, WS_LNS = WS_SS1 + 32768, WS_COS = WS_LNS + 65536, WS_SIN = WS_COS + 131072;
constexpr size_t WS_KC = 2 * MiB, WS_VC = 3 * MiB;
constexpr size_t WS_GL = 4 * MiB;
constexpr size_t WS_WT0 = 6 * MiB, WS_WTO0 = 67 * MiB, WS_WT1 = 83 * MiB, WS_WTO1 = 131 * MiB;
constexpr size_t WS_XB = 147 * MiB;
constexpr size_t WS_NG = 179 * MiB;
constexpr size_t WS_ZC = 211 * MiB;
constexpr size_t WS_Q = 339 * MiB;
constexpr size_t WS_KV = 371 * MiB;
constexpr size_t KV_ELEMS = (size_t)MTOK * 512;
constexpr size_t WS_END = 419 * MiB;
constexpr size_t WS_Z1 = WS_ZC;
static_assert(WS_Z1 + (size_t)MTOK * N1 * 2 <= WS_END, "z1 overlay");

constexpr int NWAVES = 8, NTHREADS = 512;
constexpr int LDS_BYTES = 147456;

struct Args { const float* in[21]; float* out; unsigned char* ws; int ph_lo, ph_hi; };

__device__ __forceinline__ float bf_lo(unsigned u) { return __uint_as_float(u << 16); }
__device__ __forceinline__ float bf_hi(unsigned u) { return __uint_as_float(u & 0xffff0000u); }
__device__ __forceinline__ float bf2f(bf16_t b) { return __uint_as_float((unsigned)b << 16); }
__device__ __forceinline__ unsigned f2bf(float f) { unsigned u = __float_as_uint(f); return (u + 0x7fffu + ((u >> 16) & 1u)) >> 16; }
__device__ __forceinline__ unsigned pk2(float lo, float hi) { return f2bf(lo) | (f2bf(hi) << 16); }
__device__ __forceinline__ unsigned cvt_pk_bf16(float lo, float hi) { unsigned r; asm volatile("v_cvt_pk_bf16_f32 %0, %1, %2" : "=v"(r) : "v"(lo), "v"(hi)); return r; }
__device__ __forceinline__ float silu_f(float x) { return x / (1.f + __expf(-x)); }
__device__ __forceinline__ float sigmoid_f(float x) { return 1.f / (1.f + __expf(-x)); }
__device__ __forceinline__ float wave_sum(float v) {
#pragma unroll
    for (int o = 1; o < 64; o <<= 1) v += __shfl_xor(v, o);
    return v;
}
__device__ __forceinline__ float wave_max(float v) {
#pragma unroll
    for (int o = 1; o < 64; o <<= 1) v = fmaxf(v, __shfl_xor(v, o));
    return v;
}
__device__ __forceinline__ int colmap0(int nd) { return nd < 13312 ? nd : (nd < 15360 ? nd + 48 : (nd < 15408 ? nd - 2048 : -1)); }

namespace pg8 {
#define PG8_LAS __attribute__((address_space(3)))
constexpr int BM = 256, BK = 64, HALF = 128, HTB = HALF * BK * 2  , STAGE_BYTES = 8 * HTB, NXCD = 8, WGM = 8;

__host__ __device__ __forceinline__ int lds_byte(int r, int c) { const int st = (r >> 4) * 2 + (c >> 5), rr = r & 15, cc = c & 31, ob = rr * 64 + cc * 2; return st * 1024 + (ob ^ (((ob >> 9) & 1) << 5)); }
__host__ __device__ __forceinline__ void stage_rc(int b, int& R, int& C) { const int st = b / 1024, sb = b % 1024, swz = sb ^ (((sb >> 9) & 1) << 5); R = (st >> 1) * 16 + swz / 64; C = (st & 1) * 32 + (swz % 64) / 2; }
__host__ __device__ __forceinline__ int perm32(int rho) { const int n = rho >> 4, i = rho & 15; return 8 * (i >> 2) + 4 * n + (i & 3); }

struct Unit { int pm, pn; };
struct Gemm { const bf16_t* A; const bf16_t* Bt; int M, N, K, lda; };

struct StaticOrder {
    int nM, nN, nwg, G, c;
    __host__ __device__ void init(int M, int N, int G_, int c_) { nM = M / BM; nN = N / BM; nwg = nM * nN; G = G_; c = c_; }
    __host__ __device__ bool next(int i, Unit& u) const {
        const long L = (long)i * G + c; if (L >= nwg) return false;
        int wgid = (int)L; { const int q = nwg / NXCD, r = nwg % NXCD, xcd = wgid % NXCD, off = wgid / NXCD; wgid = (xcd < r ? xcd * (q + 1) : r * (q + 1) + (xcd - r) * q) + off; }
        const int nig = WGM * nN, gid = wgid / nig, fm = gid * WGM, gsz = (nM - fm) < WGM ? (nM - fm) : WGM;
        u.pm = fm + ((wgid % nig) % gsz); u.pn = (wgid % nig) / gsz; return true;
    }
    __device__ __forceinline__ void a_ready(const Unit&) const {}
    __device__ __forceinline__ void done(const Unit&) const {}
};


struct Epi0 {
    static constexpr bool PERM = true, AFTER_DRAIN = false;
    const float* rstd; bf16_t* ZC; bf16_t* Q; bf16_t* KV; bf16_t* NG; float* GL; const float* COS; const float* SIN;
    __device__ __forceinline__ void operator()(const f32x4 (&acc)[2][2][4][2], const Unit& u, int wr, int wc, int fr, int fq) const {
        const int pn = u.pn;
        const int rowb = u.pm * BM + wr * 64 + fr;
        const int cl = wc * 32 + 8 * fq;
        const bool rot = (pn == 44 || pn == 45 || pn == 48 || pn == 49) && (wc == 0);
#pragma unroll
        for (int ai = 0; ai < 2; ++ai)
#pragma unroll
            for (int m = 0; m < 4; ++m) {
                const int row = rowb + ai * HALF + m * 16;
                const float rs = rstd[row];
                const int t = row & (SEQ - 1), b = row >> 11;
                f32x4 cs0, cs1, sn0, sn1;
                if (rot) { const float* cp = COS + t * 16 + 8 * (fq & 1); const float* sp = SIN + t * 16 + 8 * (fq & 1);
                    cs0 = *(const f32x4*)cp; cs1 = *(const f32x4*)(cp + 4); sn0 = *(const f32x4*)sp; sn1 = *(const f32x4*)(sp + 4); }
#pragma unroll
                for (int bj = 0; bj < 2; ++bj) {
                    f32x4 v0 = acc[ai][bj][m][0] * rs, v1 = acc[ai][bj][m][1] * rs;
                    if (rot) {
                        f32x4 p0, p1;
#pragma unroll
                        for (int j = 0; j < 4; ++j) { p0[j] = __shfl_xor(v0[j], 32); p1[j] = __shfl_xor(v1[j], 32); }
                        if (fq < 2) { v0 = v0 * cs0 - p0 * sn0; v1 = v1 * cs1 - p1 * sn1; }
                        else        { v0 = v0 * cs0 + p0 * sn0; v1 = v1 * cs1 + p1 * sn1; }
                    }
                    const int c = cl + bj * HALF;
                    if (pn == 60) {
                        if (c < 48) { float* gp = GL + (size_t)row * 48 + c; *(f32x4*)gp = v0; *(f32x4*)(gp + 4) = v1; }
                    } else {
                        u32x4 w; w.x = cvt_pk_bf16(v0[0], v0[1]); w.y = cvt_pk_bf16(v0[2], v0[3]); w.z = cvt_pk_bf16(v1[0], v1[1]); w.w = cvt_pk_bf16(v1[2], v1[3]);
                        bf16_t* dst;
                        if (pn < 32) dst = ZC + (size_t)row * ZC_LD + pn * BM + c;
                        else if (pn < 40) dst = Q + (size_t)row * DM + (pn - 32) * BM + c;
                        else if (pn < 52) { const int which = (pn - 40) >> 1, g = ((pn - 40) & 1) * 2 + bj;
                            dst = KV + (size_t)which * KV_ELEMS + ((size_t)((b * NKV + g) * SEQ + t)) * HD + cl; }
                        else dst = NG + (size_t)row * DM + (pn - 52) * BM + c;
                        *(u32x4*)dst = w;
                    }
                }
            }
    }
};

struct EpiOut0 {
    static constexpr bool PERM = false, AFTER_DRAIN = false;
    const float* X; float* X1; bf16_t* X1B; float* SS;
    __device__ __forceinline__ void operator()(const f32x4 (&acc)[2][2][4][2], const Unit& u, int wr, int wc, int fr, int fq) const {
        const int rowb = u.pm * BM + wr * 64 + fr, colb = u.pn * BM + wc * 32 + 4 * fq;
#pragma unroll
        for (int ai = 0; ai < 2; ++ai)
#pragma unroll
            for (int m = 0; m < 4; ++m) {
                const int row = rowb + ai * HALF + m * 16; float ss = 0.f;
#pragma unroll
                for (int bj = 0; bj < 2; ++bj)
#pragma unroll
                    for (int n = 0; n < 2; ++n) {
                        const size_t off = (size_t)row * DM + colb + bj * HALF + n * 16;
                        const f32x4 x1 = *(const f32x4*)(X + off) + acc[ai][bj][m][n];
                        *(f32x4*)(X1 + off) = x1;
                        u32x2 w; w.x = cvt_pk_bf16(x1[0], x1[1]); w.y = cvt_pk_bf16(x1[2], x1[3]); *(u32x2*)(X1B + off) = w;
                        ss += (x1[0] * x1[0] + x1[1] * x1[1]) + (x1[2] * x1[2] + x1[3] * x1[3]);
                    }
                ss += __shfl_xor(ss, 16); ss += __shfl_xor(ss, 32);
                if (fq == 0) atomicAdd(SS + row, ss);
            }
    }
};

struct Epi1 {
    static constexpr bool PERM = true, AFTER_DRAIN = false;
    const float* SS; bf16_t* Z1; float* LNS;
    __device__ __forceinline__ void operator()(const f32x4 (&acc)[2][2][4][2], const Unit& u, int wr, int wc, int fr, int fq) const {
        const int rowb = u.pm * BM + wr * 64 + fr, colb = u.pn * BM + wc * 32 + 8 * fq;
        const bool isv = (u.pn >= 16 && u.pn < 32);
#pragma unroll
        for (int ai = 0; ai < 2; ++ai)
#pragma unroll
            for (int m = 0; m < 4; ++m) {
                const int row = rowb + ai * HALF + m * 16;
                const float rs = __builtin_amdgcn_rsqf(SS[row] * (1.0f / DM) + EPS);
                float s1 = 0.f, s2 = 0.f;
#pragma unroll
                for (int bj = 0; bj < 2; ++bj) {
                    const f32x4 v0 = acc[ai][bj][m][0] * rs, v1 = acc[ai][bj][m][1] * rs;
                    u32x4 w; w.x = cvt_pk_bf16(v0[0], v0[1]); w.y = cvt_pk_bf16(v0[2], v0[3]); w.z = cvt_pk_bf16(v1[0], v1[1]); w.w = cvt_pk_bf16(v1[2], v1[3]);
                    *(u32x4*)(Z1 + (size_t)row * N1 + colb + bj * HALF) = w;
                    s1 += (v0[0] + v0[1]) + (v0[2] + v0[3]) + (v1[0] + v1[1]) + (v1[2] + v1[3]);
                    s2 += (v0[0] * v0[0] + v0[1] * v0[1]) + (v0[2] * v0[2] + v0[3] * v0[3]) + (v1[0] * v1[0] + v1[1] * v1[1]) + (v1[2] * v1[2] + v1[3] * v1[3]);
                }
                if (isv) {
                    s1 += __shfl_xor(s1, 16); s1 += __shfl_xor(s1, 32); s2 += __shfl_xor(s2, 16); s2 += __shfl_xor(s2, 32);
                    if (fq == 0) { atomicAdd(LNS + 2 * row, s1); atomicAdd(LNS + 2 * row + 1, s2); }
                }
            }
    }
};

struct EpiOut1 {
    static constexpr bool PERM = false, AFTER_DRAIN = false;
    float* OUT;
    __device__ __forceinline__ void operator()(const f32x4 (&acc)[2][2][4][2], const Unit& u, int wr, int wc, int fr, int fq) const {
        const int rowb = u.pm * BM + wr * 64 + fr, colb = u.pn * BM + wc * 32 + 4 * fq;
#pragma unroll
        for (int ai = 0; ai < 2; ++ai)
#pragma unroll
            for (int m = 0; m < 4; ++m) {
                const int row = rowb + ai * HALF + m * 16;
#pragma unroll
                for (int bj = 0; bj < 2; ++bj)
#pragma unroll
                    for (int n = 0; n < 2; ++n) {
                        float* p = OUT + (size_t)row * DM + colb + bj * HALF + n * 16;
                        *(f32x4*)p = *(const f32x4*)p + acc[ai][bj][m][n];
                    }
            }
    }
};

template <class Epi, class Sched, bool ALIGN_EPI = false, bool SP2 = false>
__device__ __forceinline__ void gemm_phase(PG8_LAS unsigned char* lds, const Gemm g, const Sched& S, const Epi& E) {
    const int tid = threadIdx.x, wid = __builtin_amdgcn_readfirstlane(tid >> 6), lane = tid & 63, wr = wid >> 2, wc = wid & 3, fr = lane & 15, fq = lane >> 4;
    const int K = g.K, nt = K / BK;
    unsigned voffA[2], voffB[2];
#pragma unroll
    for (int i = 0; i < 2; ++i) { int R, C; stage_rc(tid * 16 + i * 8192, R, C); const int Rb = Epi::PERM ? ((R & ~31) + perm32(R & 31)) : R;
        voffA[i] = (unsigned)(R * g.lda + C) * 2u; voffB[i] = (unsigned)(Rb * K + C) * 2u; }
    const size_t kstep = (size_t)(BK * 2);
    const size_t hstepA = (size_t)HALF * g.lda * 2, hstepB = (size_t)HALF * K * 2;
    const size_t tstepA = 2 * hstepA, tstepB = 2 * hstepB;
    const unsigned ldsw = (unsigned)wid * 1024u;
    const int aoff = lds_byte(wr * 64 + fr, fq * 8), boff = lds_byte(wc * 32 + fr, fq * 8);
#define PG8_SA(b, h) (((b) * 2 + (h)) * HTB)
#define PG8_SB(b, h) ((4 + (b) * 2 + (h)) * HTB)
#define PG8_STAGE(bufoff, gbase, voff) do { _Pragma("unroll") for (int _i = 0; _i < 2; ++_i) \
        __builtin_amdgcn_global_load_lds((const unsigned*)((const char*)(gbase) + (voff)[_i]), (PG8_LAS unsigned*)(lds + (bufoff) + ldsw + _i * 8192), 16, 0, 0); } while (0)
#define PG8_LDA(dst, b, h) do { _Pragma("unroll") for (int m = 0; m < 4; ++m) _Pragma("unroll") for (int k = 0; k < 2; ++k) dst[m][k] = *(const PG8_LAS bf16x8*)(lds + PG8_SA(b, h) + aoff + m * 2048 + k * 1024); } while (0)
#define PG8_LDB(dst, b, h) do { _Pragma("unroll") for (int n = 0; n < 2; ++n) _Pragma("unroll") for (int k = 0; k < 2; ++k) dst[n][k] = *(const PG8_LAS bf16x8*)(lds + PG8_SB(b, h) + boff + n * 2048 + k * 1024); } while (0)
#define PG8_MMA(ai, bj, At, Bt) do { __builtin_amdgcn_s_setprio(1); _Pragma("unroll") for (int m = 0; m < 4; ++m) _Pragma("unroll") for (int n = 0; n < 2; ++n) _Pragma("unroll") for (int k = 0; k < 2; ++k) \
        acc[ai][bj][m][n] = __builtin_amdgcn_mfma_f32_16x16x32_bf16(Bt[n][k], At[m][k], acc[ai][bj][m][n], 0, 0, 0); __builtin_amdgcn_s_setprio(0); } while (0)
#define PG8_WAIT_V(n) asm volatile("s_waitcnt vmcnt(" #n ")" ::: "memory")
#define PG8_WAIT_L(n) asm volatile("s_waitcnt lgkmcnt(" #n ")" ::: "memory")
#define PG8_BAR __builtin_amdgcn_s_barrier()
#define PG8_SCHED __builtin_amdgcn_sched_barrier(0)
    Unit cur, nxt; int ui = 0;
    if (!S.next(0, cur)) return;
    f32x4 acc[2][2][4][2];
#pragma unroll
    for (int a = 0; a < 2; ++a)
#pragma unroll
        for (int b = 0; b < 2; ++b)
#pragma unroll
            for (int m = 0; m < 4; ++m)
#pragma unroll
                for (int n = 0; n < 2; ++n) acc[a][b][m][n] = (f32x4){0.f, 0.f, 0.f, 0.f};
    bf16x8 At[4][2], B0[2][2], B1[2][2];
    const char* cA = (const char*)g.A + (size_t)cur.pm * tstepA; const char* cB = (const char*)g.Bt + (size_t)cur.pn * tstepB;
    S.a_ready(cur);
    if constexpr (SP2) {
        PG8_STAGE(PG8_SB(0, 0), cB, voffB); PG8_STAGE(PG8_SB(0, 1), cB + hstepB, voffB); PG8_STAGE(PG8_SA(0, 0), cA, voffA); PG8_STAGE(PG8_SA(0, 1), cA + hstepA, voffA);
        if (wr == 1) PG8_BAR;
        PG8_WAIT_V(2); PG8_BAR;
        PG8_STAGE(PG8_SB(1, 0), cB + kstep, voffB); PG8_STAGE(PG8_SA(1, 0), cA + kstep, voffA); PG8_STAGE(PG8_SB(1, 1), cB + hstepB + kstep, voffB);
        PG8_WAIT_V(6); PG8_BAR;
    } else {
        PG8_STAGE(PG8_SB(0, 0), cB, voffB); PG8_STAGE(PG8_SA(0, 0), cA, voffA); PG8_STAGE(PG8_SB(0, 1), cB + hstepB, voffB); PG8_STAGE(PG8_SA(0, 1), cA + hstepA, voffA);
        if (wr == 1) PG8_BAR;
        PG8_WAIT_V(4); PG8_BAR;
        PG8_STAGE(PG8_SB(1, 0), cB + kstep, voffB); PG8_STAGE(PG8_SA(1, 0), cA + kstep, voffA); PG8_STAGE(PG8_SB(1, 1), cB + hstepB + kstep, voffB);
        PG8_WAIT_V(6); PG8_BAR;
    }
    for (;;) {
        const bool has_next = S.next(ui + 1, nxt);
        const char* nA = has_next ? (const char*)g.A + (size_t)nxt.pm * tstepA : cA; const char* nB = has_next ? (const char*)g.Bt + (size_t)nxt.pn * tstepB : cB;
        for (int t = 0; t < nt; t += 2) {
            const bool last = (t == nt - 2);
            const char* a1 = cA + (size_t)(t + 1) * kstep;
            const char* a2 = last ? nA : cA + (size_t)(t + 2) * kstep; const char* b2 = last ? nB : cB + (size_t)(t + 2) * kstep;
            const char* a3 = a2 + kstep; const char* b3 = b2 + kstep;
            if (last && has_next) S.a_ready(nxt);
            if constexpr (SP2) {
            PG8_LDB(B0, 0, 0); PG8_LDB(B1, 0, 1); PG8_SCHED; PG8_LDA(At, 0, 0); PG8_STAGE(PG8_SA(1, 1), a1 + hstepA, voffA);
            PG8_WAIT_V(8); PG8_WAIT_L(0); PG8_BAR; PG8_MMA(0, 0, At, B0); PG8_MMA(0, 1, At, B1); PG8_BAR; PG8_SCHED;
            PG8_LDA(At, 0, 1); PG8_STAGE(PG8_SB(0, 0), b2, voffB); PG8_STAGE(PG8_SB(0, 1), b2 + hstepB, voffB); PG8_STAGE(PG8_SA(0, 0), a2, voffA);
            PG8_WAIT_V(8); PG8_WAIT_L(0); PG8_BAR; PG8_MMA(1, 0, At, B0); PG8_MMA(1, 1, At, B1); PG8_BAR; PG8_SCHED;
            PG8_LDB(B0, 1, 0); PG8_LDB(B1, 1, 1); PG8_SCHED; PG8_LDA(At, 1, 0); PG8_STAGE(PG8_SA(0, 1), a2 + hstepA, voffA);
            PG8_WAIT_V(8); PG8_WAIT_L(0); PG8_BAR; PG8_MMA(0, 0, At, B0); PG8_MMA(0, 1, At, B1); PG8_BAR; PG8_SCHED;
            PG8_LDA(At, 1, 1); PG8_STAGE(PG8_SB(1, 0), b3, voffB); PG8_STAGE(PG8_SB(1, 1), b3 + hstepB, voffB); PG8_STAGE(PG8_SA(1, 0), a3, voffA);
            PG8_WAIT_V(8); PG8_WAIT_L(0); PG8_BAR; PG8_MMA(1, 0, At, B0); PG8_MMA(1, 1, At, B1); PG8_BAR; PG8_SCHED;
            } else {
            PG8_LDB(B0, 0, 0); PG8_SCHED; PG8_LDA(At, 0, 0); PG8_STAGE(PG8_SA(1, 1), a1 + hstepA, voffA);
            PG8_WAIT_L(8); PG8_BAR; PG8_WAIT_L(0); PG8_MMA(0, 0, At, B0); PG8_BAR; PG8_SCHED;
            PG8_LDB(B1, 0, 1); PG8_STAGE(PG8_SB(0, 0), b2, voffB);
            PG8_BAR; PG8_WAIT_L(0); PG8_MMA(0, 1, At, B1); PG8_BAR;
            PG8_LDA(At, 0, 1); PG8_STAGE(PG8_SA(0, 0), a2, voffA);
            PG8_BAR; PG8_WAIT_L(0); PG8_MMA(1, 0, At, B0); PG8_BAR; PG8_SCHED;
            PG8_STAGE(PG8_SB(0, 1), b2 + hstepB, voffB);
            PG8_WAIT_V(6); PG8_BAR; PG8_MMA(1, 1, At, B1); PG8_BAR;
            PG8_LDB(B0, 1, 0); PG8_SCHED; PG8_LDA(At, 1, 0); PG8_STAGE(PG8_SA(0, 1), a2 + hstepA, voffA);
            PG8_WAIT_L(8); PG8_BAR; PG8_WAIT_L(0); PG8_MMA(0, 0, At, B0); PG8_BAR; PG8_SCHED;
            PG8_LDB(B1, 1, 1); PG8_STAGE(PG8_SB(1, 0), b3, voffB);
            PG8_BAR; PG8_WAIT_L(0); PG8_MMA(0, 1, At, B1); PG8_BAR;
            PG8_LDA(At, 1, 1); PG8_STAGE(PG8_SA(1, 0), a3, voffA);
            PG8_BAR; PG8_WAIT_L(0); PG8_MMA(1, 0, At, B0); PG8_BAR; PG8_SCHED;
            PG8_STAGE(PG8_SB(1, 1), b3 + hstepB, voffB);
            PG8_WAIT_V(6); PG8_BAR; PG8_MMA(1, 1, At, B1); PG8_BAR;
            }
        }
        if constexpr (ALIGN_EPI) { if (wr == 0) PG8_BAR; }
        if constexpr (!Epi::AFTER_DRAIN) { E(acc, cur, wr, wc, fr, fq); S.done(cur); }
        if (!has_next) break;
#pragma unroll
        for (int a = 0; a < 2; ++a)
#pragma unroll
            for (int b = 0; b < 2; ++b)
#pragma unroll
                for (int m = 0; m < 4; ++m)
#pragma unroll
                    for (int n = 0; n < 2; ++n) acc[a][b][m][n] = (f32x4){0.f, 0.f, 0.f, 0.f};
        cur = nxt; cA = nA; cB = nB; ++ui;
        if constexpr (ALIGN_EPI) { if (wr == 1) PG8_BAR; }
    }
    PG8_WAIT_V(0);
    if constexpr (!ALIGN_EPI) { if (wr == 0) PG8_BAR; }
    PG8_BAR;
    if constexpr (Epi::AFTER_DRAIN) { E.fused(acc, cur, wr, wc, fr, fq, lds, wid, lane); S.done(cur); }
#undef PG8_SA
#undef PG8_SB
#undef PG8_STAGE
#undef PG8_LDA
#undef PG8_LDB
#undef PG8_MMA
#undef PG8_WAIT_V
#undef PG8_WAIT_L
#undef PG8_BAR
#undef PG8_SCHED
}
}

template <int MODE>
__device__ __forceinline__ void p0_transpose_item(const float* W, int K, int Nsrc, int nblk, bf16_t* WT, const float* gvec, LAS float* scr, int item, int lane) {
    const int kb = item / nblk, nb = item % nblk, k0 = 64 * kb, n0 = 32 * nb;
    const int nd = n0 + (lane & 31);
    const int col = (MODE == 0) ? colmap0(nd) : nd;
#pragma unroll 8
    for (int i = 0; i < 32; ++i) { const int kk = 2 * i + (lane >> 5);
        float v = (col >= 0) ? W[(size_t)(k0 + kk) * Nsrc + col] : 0.f;
        if (MODE != 1) v *= gvec[k0 + kk];
        scr[kk * 33 + (lane & 31)] = v; }
    asm volatile("s_waitcnt lgkmcnt(0)" ::: "memory");
    const int c = lane & 7;
#pragma unroll
    for (int j = 0; j < 4; ++j) { const int n = (lane >> 3) + 8 * j; const LAS float* s = scr + (8 * c) * 33 + n;
        u32x4 o; o.x = pk2(s[0 * 33], s[1 * 33]); o.y = pk2(s[2 * 33], s[3 * 33]); o.z = pk2(s[4 * 33], s[5 * 33]); o.w = pk2(s[6 * 33], s[7 * 33]);
        *(u32x4*)(WT + (size_t)(n0 + n) * K + k0 + 8 * c) = o; }
    asm volatile("s_waitcnt lgkmcnt(0)" ::: "memory");
}

__device__ __forceinline__ void p0_prologue(const Args& a, LAS unsigned char* lds, int vcu, int G, int wave, int lane) {
    unsigned char* ws = a.ws;
    LAS float* scr = (LAS float*)(lds + wave * 16384);
    const int gw = vcu * NWAVES + wave, NGW = G * NWAVES;
    constexpr int I0 = (DM / 64) * (N0 / 32), IO = (MIXW / 64) * (DM / 32), I1 = (DM / 64) * (N1 / 32);
    constexpr int NITEMS = I0 + IO + I1 + IO;
    for (int it = gw; it < NITEMS; it += NGW) {
        int r = it;
        if (r < I0) { p0_transpose_item<0>(a.in[2], DM, N0_SRC, N0 / 32, (bf16_t*)(ws + WS_WT0), a.in[1], scr, r, lane); continue; } r -= I0;
        if (r < IO) { p0_transpose_item<1>(a.in[12], MIXW, DM, DM / 32, (bf16_t*)(ws + WS_WTO0), nullptr, scr, r, lane); continue; } r -= IO;
        if (r < I1) { p0_transpose_item<2>(a.in[14], DM, N1, N1 / 32, (bf16_t*)(ws + WS_WT1), a.in[13], scr, r, lane); continue; } r -= I1;
        p0_transpose_item<1>(a.in[19], MIXW, DM, DM / 32, (bf16_t*)(ws + WS_WTO1), nullptr, scr, r, lane);
    }
    const float* x = a.in[0]; bf16_t* XB = (bf16_t*)(ws + WS_XB); float* rstd0 = (float*)(ws + WS_RSTD0);
    for (int m = gw; m < MTOK; m += NGW) {
        const f32x4* xr = (const f32x4*)(x + (size_t)m * DM) + lane;
        u32x2* o8 = (u32x2*)(XB + (size_t)m * DM) + lane;
        float s = 0.f;
#pragma unroll
        for (int j = 0; j < 8; ++j) { const f32x4 v = xr[64 * j]; s += (v.x * v.x + v.y * v.y) + (v.z * v.z + v.w * v.w);
            u32x2 w; w.x = pk2(v.x, v.y); w.y = pk2(v.z, v.w); o8[64 * j] = w; }
        s = wave_sum(s);
        if (lane == 0) rstd0[m] = 1.0f / sqrtf(s * (1.0f / DM) + EPS);
    }
    const int gt = gw * 64 + lane, NGT = NGW * 64;
    float* SS1 = (float*)(ws + WS_SS1); float* LNS = (float*)(ws + WS_LNS);
    for (int i = gt; i < MTOK; i += NGT) { SS1[i] = 0.f; LNS[2 * i] = 0.f; LNS[2 * i + 1] = 0.f; }
    float* COS = (float*)(ws + WS_COS); float* SIN = (float*)(ws + WS_SIN);
    for (int i = gt; i < SEQ * 16; i += NGT) { const int t = i >> 4, f = i & 15;
        const float inv = powf(500000.0f, -((float)f * 2.0f) / 32.0f); const float ang = (float)t * inv;
        COS[i] = cosf(ang); SIN[i] = sinf(ang); }
}

__device__ __forceinline__ void p2_conv(const Args& a, int gt, int NGT) {
    bf16_t* ZC = (bf16_t*)(a.ws + WS_ZC); const float* cw = a.in[3];
    for (int idx = gt; idx < MTOK * 256; idx += NGT) {
        const int row = idx >> 8, c8 = (idx & 255) * 8, t = row & (SEQ - 1);
        bf16_t* base = ZC + (size_t)row * ZC_LD + c8;
        const u32x4 cb = *(const u32x4*)base, cg = *(const u32x4*)(base + 6144);
        const u32x4 cc0 = *(const u32x4*)(base + 2048), ch0 = *(const u32x4*)(base + 4096);
        u32x4 cc1 = {0, 0, 0, 0}, ch1 = {0, 0, 0, 0}, cc2 = {0, 0, 0, 0}, ch2 = {0, 0, 0, 0};
        if (t >= 1) { cc1 = *(const u32x4*)(base - ZC_LD + 2048); ch1 = *(const u32x4*)(base - ZC_LD + 4096); }
        if (t >= 2) { cc2 = *(const u32x4*)(base - 2 * ZC_LD + 2048); ch2 = *(const u32x4*)(base - 2 * ZC_LD + 4096); }
        float w0[8], w1[8], w2[8];
#pragma unroll
        for (int j = 0; j < 8; ++j) { w0[j] = cw[c8 + j]; w1[j] = cw[DM + c8 + j]; w2[j] = cw[2 * DM + c8 + j]; }
        u32x4 o;
#pragma unroll
        for (int q = 0; q < 4; ++q) {
            float r[2];
#pragma unroll
            for (int hh = 0; hh < 2; ++hh) {
                const int j = 2 * q + hh;
                const float p0 = hh ? bf_hi(cc0[q]) * bf_hi(ch0[q]) : bf_lo(cc0[q]) * bf_lo(ch0[q]);
                const float p1 = hh ? bf_hi(cc1[q]) * bf_hi(ch1[q]) : bf_lo(cc1[q]) * bf_lo(ch1[q]);
                const float p2 = hh ? bf_hi(cc2[q]) * bf_hi(ch2[q]) : bf_lo(cc2[q]) * bf_lo(ch2[q]);
                const float conv = w0[j] * p2 + w1[j] * p1 + w2[j] * p0;
                const float b = hh ? bf_hi(cb[q]) : bf_lo(cb[q]); const float g = hh ? bf_hi(cg[q]) : bf_lo(cg[q]);
                r[hh] = b * conv * silu_f(g);
            }
            o[q] = pk2(r[0], r[1]);
        }
        *(u32x4*)base = o;
    }
}

__device__ __forceinline__ void p2_compress(const Args& a, LAS unsigned char* lds, int blk, int G, int tid) {
    LAS float* tok = (LAS float*)lds;
    LAS float* pos = (LAS float*)(lds + 73728);
    LAS float* red = (LAS float*)(lds + 73728 + 16384);
    LAS float* hid = (LAS float*)(lds + 73728 + 32768);
    const int j = tid & 127, iq = tid >> 7;
    for (int unit = blk; unit < 2 * 16 * 16; unit += G) {
        const int kv = unit >> 8, bg = (unit >> 4) & 15, cg8 = unit & 15;
        const bf16_t* src = (const bf16_t*)(a.ws + WS_KV) + (size_t)kv * KV_ELEMS + ((size_t)bg * SEQ + 128 * cg8) * HD;
        const float* posg = a.in[kv ? 8 : 4]; const float* w1 = a.in[kv ? 9 : 5]; const float* b1 = a.in[kv ? 10 : 6]; const float* w2 = a.in[kv ? 11 : 7];
        const int ntok = (cg8 == 15) ? 128 : 144;
        __syncthreads();
        for (int i = tid; i < ntok * 128; i += NTHREADS) tok[i] = bf2f(src[i]);
        for (int i = tid; i < 4096; i += NTHREADS) pos[i] = posg[i];
        __syncthreads();
        float acc[8];
#pragma unroll
        for (int cc = 0; cc < 8; ++cc) acc[cc] = 0.f;
        const int ncc = (cg8 == 15) ? 7 : 8;
        for (int i = iq * 1024; i < iq * 1024 + 1024; ++i) {
            const float w = w1[(size_t)i * 128 + j]; const float p = pos[i];
#pragma unroll
            for (int cc = 0; cc < 8; ++cc) if (cc < ncc) acc[cc] += (tok[cc * 2048 + i] + p) * w;
        }
#pragma unroll
        for (int cc = 0; cc < 8; ++cc) red[(iq * 8 + cc) * 128 + j] = acc[cc];
        __syncthreads();
        for (int i = tid; i < 8 * 128; i += NTHREADS) { const int jj = i & 127;
            const float h = red[i] + red[1024 + i] + red[2048 + i] + red[3072 + i] + b1[jj]; hid[i] = silu_f(h); }
        __syncthreads();
        bf16_t* dst = (bf16_t*)(a.ws + (kv ? WS_VC : WS_KC)) + (size_t)bg * 128 * 128;
        for (int o = tid; o < 8 * 128; o += NTHREADS) { const int cc = o >> 7, d = o & 127;
            if (cc >= ncc) { if (cg8 == 15 && cc == 7) dst[(size_t)127 * 128 + d] = 0; }
            else { float s = 0.f;
                for (int jj = 0; jj < 128; ++jj) s += hid[cc * 128 + jj] * w2[jj * 128 + d];
                dst[(size_t)(8 * cg8 + cc) * 128 + d] = (bf16_t)f2bf(s); } }
    }
    __syncthreads();
}

__device__ __forceinline__ void attn_batch(const bf16_t* Kb, const bf16_t* Vb, int first, int lo, int hi, bool valid, const LAS float* qs,
                                           float (&m)[4], float (&l)[4], float (&o)[4][2], int lane) {
    int kr = first + lane; kr = kr < lo ? lo : (kr > hi ? hi : kr);
    const u32x4* kp = (const u32x4*)(Kb + (size_t)kr * HD);
    float s[4] = {0.f, 0.f, 0.f, 0.f};
#pragma unroll 4
    for (int c = 0; c < 16; ++c) { const u32x4 kv = kp[c];
        float kf[8]; kf[0] = bf_lo(kv.x); kf[1] = bf_hi(kv.x); kf[2] = bf_lo(kv.y); kf[3] = bf_hi(kv.y); kf[4] = bf_lo(kv.z); kf[5] = bf_hi(kv.z); kf[6] = bf_lo(kv.w); kf[7] = bf_hi(kv.w);
#pragma unroll
        for (int h = 0; h < 4; ++h) { const LAS f32x4* q4 = (const LAS f32x4*)(qs + h * HD + c * 8); const f32x4 qa = q4[0], qb = q4[1];
            s[h] += (qa[0] * kf[0] + qa[1] * kf[1]) + (qa[2] * kf[2] + qa[3] * kf[3]) + (qb[0] * kf[4] + qb[1] * kf[5]) + (qb[2] * kf[6] + qb[3] * kf[7]); }
    }
    float ps[4];
#pragma unroll
    for (int h = 0; h < 4; ++h) {
        const float sv = valid ? s[h] : -INFINITY;
        const float bm = wave_max(sv); const float mn = fmaxf(m[h], bm);
        float p = 0.f, alpha = 1.f;
        if (mn > -INFINITY) { p = valid ? __expf(sv - mn) : 0.f; alpha = (m[h] > -INFINITY) ? __expf(m[h] - mn) : 0.f; }
        l[h] = l[h] * alpha + wave_sum(p); o[h][0] *= alpha; o[h][1] *= alpha; m[h] = mn; ps[h] = p;
    }
    for (int jj = 0; jj < 64; ++jj) {
        int vr = first + jj; vr = vr < lo ? lo : (vr > hi ? hi : vr);
        const unsigned vv = *(const unsigned*)(Vb + (size_t)vr * HD + 2 * lane);
        const float v0 = bf_lo(vv), v1 = bf_hi(vv);
#pragma unroll
        for (int h = 0; h < 4; ++h) { const float pj = __shfl(ps[h], jj); o[h][0] += pj * v0; o[h][1] += pj * v1; }
    }
}

__device__ __forceinline__ void p3_nsa_naive(const Args& a, LAS unsigned char* lds, int gw, int NGW, int wave, int lane) {
    unsigned char* ws = a.ws;
    LAS float* qs = (LAS float*)(lds + wave * 8192);
    LAS float* qr = qs + 512;
    LAS float* Pc = qr + 512;
    const bf16_t* Q = (const bf16_t*)(ws + WS_Q); const bf16_t* KVb = (const bf16_t*)(ws + WS_KV);
    const bf16_t* KC = (const bf16_t*)(ws + WS_KC); const bf16_t* VC = (const bf16_t*)(ws + WS_VC);
    const float* GL = (const float*)(ws + WS_GL); const bf16_t* NG = (const bf16_t*)(ws + WS_NG);
    const float* COS = (const float*)(ws + WS_COS); const float* SIN = (const float*)(ws + WS_SIN);
    bf16_t* ZC = (bf16_t*)(ws + WS_ZC);
    const float scale = 0.08838834764831845f;
    for (int task = gw; task < NB * NKV * SEQ; task += NGW) {
        const int t = task & (SEQ - 1), bg = task >> 11, b = bg >> 2, g = bg & 3;
        const int row = b * SEQ + t;
        { const u32x4 qv = *(const u32x4*)(Q + (size_t)row * DM + g * 512 + lane * 8);
          float f[8]; f[0] = bf_lo(qv.x); f[1] = bf_hi(qv.x); f[2] = bf_lo(qv.y); f[3] = bf_hi(qv.y); f[4] = bf_lo(qv.z); f[5] = bf_hi(qv.z); f[6] = bf_lo(qv.w); f[7] = bf_hi(qv.w);
#pragma unroll
          for (int j = 0; j < 8; ++j) { qs[lane * 8 + j] = f[j] * scale; qr[lane * 8 + j] = f[j] * scale; } }
        asm volatile("s_waitcnt lgkmcnt(0)" ::: "memory");
        { const int h = lane >> 4, i = lane & 15; const float x1 = qs[h * HD + i], x2 = qs[h * HD + 16 + i]; const float c = COS[t * 16 + i], s = SIN[t * 16 + i];
          qr[h * HD + i] = x1 * c - x2 * s; qr[h * HD + 16 + i] = x2 * c + x1 * s; }
        asm volatile("s_waitcnt lgkmcnt(0)" ::: "memory");
        float oc[4][2], Pl0 = 0.f, Pl1 = 0.f;
        {
            const bf16_t* Kc = KC + (size_t)bg * 128 * 128; const bf16_t* Vc = VC + (size_t)bg * 128 * 128;
            const int c0 = lane, c1 = 64 + lane;
            const bool v0 = (16 * c0 + 31 <= t), v1 = (c1 < NCMP) && (16 * c1 + 31 <= t);
            const int r1 = c1 < NCMP ? c1 : NCMP - 1;
            float s0[4] = {0.f, 0.f, 0.f, 0.f}, s1[4] = {0.f, 0.f, 0.f, 0.f};
            const u32x4* k0p = (const u32x4*)(Kc + (size_t)c0 * HD); const u32x4* k1p = (const u32x4*)(Kc + (size_t)r1 * HD);
#pragma unroll 2
            for (int c = 0; c < 16; ++c) { const u32x4 ka = k0p[c], kb = k1p[c];
                float fa[8], fb[8];
                fa[0] = bf_lo(ka.x); fa[1] = bf_hi(ka.x); fa[2] = bf_lo(ka.y); fa[3] = bf_hi(ka.y); fa[4] = bf_lo(ka.z); fa[5] = bf_hi(ka.z); fa[6] = bf_lo(ka.w); fa[7] = bf_hi(ka.w);
                fb[0] = bf_lo(kb.x); fb[1] = bf_hi(kb.x); fb[2] = bf_lo(kb.y); fb[3] = bf_hi(kb.y); fb[4] = bf_lo(kb.z); fb[5] = bf_hi(kb.z); fb[6] = bf_lo(kb.w); fb[7] = bf_hi(kb.w);
#pragma unroll
                for (int h = 0; h < 4; ++h)
#pragma unroll
                    for (int jj = 0; jj < 8; ++jj) { const float qv = qs[h * HD + c * 8 + jj]; s0[h] += qv * fa[jj]; s1[h] += qv * fb[jj]; } }
            float p0[4], p1[4];
#pragma unroll
            for (int h = 0; h < 4; ++h) {
                const float a0 = v0 ? s0[h] : -INFINITY, a1 = v1 ? s1[h] : -INFINITY;
                const float mx = wave_max(fmaxf(a0, a1));
                float e0 = 0.f, e1 = 0.f;
                if (mx > -INFINITY) { e0 = v0 ? __expf(a0 - mx) : 0.f; e1 = v1 ? __expf(a1 - mx) : 0.f; }
                const float den = wave_sum(e0 + e1); const float inv = den > 0.f ? 1.0f / den : 1.0f;
                p0[h] = e0 * inv; p1[h] = e1 * inv; Pl0 += p0[h]; Pl1 += p1[h];
                oc[h][0] = 0.f; oc[h][1] = 0.f;
            }
            for (int jj = 0; jj < 64; ++jj) {
                const unsigned va = *(const unsigned*)(Vc + (size_t)jj * HD + 2 * lane);
                const int rr = (64 + jj) < NCMP ? (64 + jj) : NCMP - 1;
                const unsigned vb = *(const unsigned*)(Vc + (size_t)rr * HD + 2 * lane);
#pragma unroll
                for (int h = 0; h < 4; ++h) { const float pa = __shfl(p0[h], jj), pb = __shfl(p1[h], jj);
                    oc[h][0] += pa * bf_lo(va) + pb * bf_lo(vb); oc[h][1] += pa * bf_hi(va) + pb * bf_hi(vb); }
            }
            Pc[lane] = Pl0; Pc[64 + lane] = Pl1;
        }
        asm volatile("s_waitcnt lgkmcnt(0)" ::: "memory");
        unsigned selmask = 0u;
        {
            const int cur = t >> 6;
            float val = -INFINITY;
            if (lane < 32) {
                if (lane == 0 || lane == cur) val = INFINITY;
                else if (64 * lane <= t) { float s = 0.f;
                    for (int c = 4 * lane - 1; c <= 4 * lane + 3; ++c) if (c >= 0 && c < NCMP) s += Pc[c];
                    val = s; }
            }
            bool taken = (lane >= 32);
            for (int r = 0; r < 8; ++r) {
                const float cand = taken ? -INFINITY : val;
                const float mx = wave_max(cand);
                if (!(mx > -INFINITY)) break;
                const unsigned long long bal = __ballot(!taken && cand == mx);
                const int idx = __ffsll((long long)bal) - 1;
                selmask |= 1u << idx;
                if (lane == idx) taken = true;
            }
        }
        float os[4][2], ms[4], ls[4];
#pragma unroll
        for (int h = 0; h < 4; ++h) { os[h][0] = 0.f; os[h][1] = 0.f; ms[h] = -INFINITY; ls[h] = 0.f; }
        {
            const bf16_t* Ks = KVb + 2 * KV_ELEMS + (size_t)bg * SEQ * HD; const bf16_t* Vs = KVb + 3 * KV_ELEMS + (size_t)bg * SEQ * HD;
            unsigned mk = selmask;
            while (mk) { const int jb = __ffs((int)mk) - 1; mk &= mk - 1;
                attn_batch(Ks, Vs, 64 * jb, 0, SEQ - 1, (64 * jb + lane) <= t, qr, ms, ls, os, lane); }
        }
        float ow[4][2], mw[4], lw[4];
#pragma unroll
        for (int h = 0; h < 4; ++h) { ow[h][0] = 0.f; ow[h][1] = 0.f; mw[h] = -INFINITY; lw[h] = 0.f; }
        {
            const bf16_t* Kw = KVb + 4 * KV_ELEMS + (size_t)bg * SEQ * HD; const bf16_t* Vw = KVb + 5 * KV_ELEMS + (size_t)bg * SEQ * HD;
            const int first = t - 511;
            for (int b8 = 0; b8 < 8; ++b8) { const int f0 = first + 64 * b8;
                if (f0 + 63 < 0) continue;
                attn_batch(Kw, Vw, f0, 0, SEQ - 1, (f0 + lane) >= 0, qr, mw, lw, ow, lane); }
        }
#pragma unroll
        for (int h = 0; h < 4; ++h) {
            const int hh = g * 4 + h;
            const float g0 = sigmoid_f(GL[(size_t)row * 48 + hh]), g1 = sigmoid_f(GL[(size_t)row * 48 + 16 + hh]), g2 = sigmoid_f(GL[(size_t)row * 48 + 32 + hh]);
            const float is = ls[h] > 0.f ? 1.0f / ls[h] : 0.f, iw = lw[h] > 0.f ? 1.0f / lw[h] : 0.f;
            const unsigned ngv = *(const unsigned*)(NG + (size_t)row * DM + hh * HD + 2 * lane);
            const float y0 = (g0 * oc[h][0] + g1 * os[h][0] * is + g2 * ow[h][0] * iw) * silu_f(bf_lo(ngv));
            const float y1 = (g0 * oc[h][1] + g1 * os[h][1] * is + g2 * ow[h][1] * iw) * silu_f(bf_hi(ngv));
            *(unsigned*)(ZC + (size_t)row * ZC_LD + 2048 + hh * HD + 2 * lane) = pk2(y0, y1);
        }
    }
}


namespace nsa {
typedef float f32x16 __attribute__((ext_vector_type(16)));
typedef short s16x4 __attribute__((ext_vector_type(4)));
constexpr int KVBLK = 64, SHM = 16384;
constexpr float SCALE = 0.08838834764831845f, THR = 8.f;
constexpr int L_V = 0, L_K = 32768, L_WS = 65536, L_SEL = 67584, L_UNI = 67840, L_GS = 68608, L_LS = L_GS + 33792, L_IMP = L_LS + 33792, L_END = L_IMP + 8448;
static_assert(L_END <= LDS_BYTES, "nsa lds");
#define KSWZ(row, colB) ((row) * 256 + ((colB) ^ (((row) & 7) << 4)))
#define SBAR() __builtin_amdgcn_sched_barrier(0)
__device__ __forceinline__ int v_st(int k, int c) { const int kk = (k & ~0xC) | ((k & 4) << 1) | ((k & 8) >> 1); return ((kk >> 3) * 4 + (c >> 5)) * 512 + ((kk & 7) * 32 + (c & 31)) * 2; }
__device__ __forceinline__ int v_rd_base(int lane) { return ((lane & 3) << 3) | (((lane >> 2) & 3) << 6) | (((lane >> 4) & 1) << 5) | (((lane >> 5) & 1) << 8); }
constexpr int v_rd_off(int d0, int ks, int half) { return d0 * 512 + ks * 4096 + half * 2048; }
__device__ __forceinline__ int crow(int r, int hi) { return (r & 3) + 8 * (r >> 2) + 4 * hi; }
__device__ __forceinline__ bf16x8 pack8(f32x4 a, f32x4 b) {
    u32x4 w = {cvt_pk_bf16(a[0], a[1]), cvt_pk_bf16(a[2], a[3]), cvt_pk_bf16(b[0], b[1]), cvt_pk_bf16(b[2], b[3])};
    return *reinterpret_cast<bf16x8*>(&w);
}
__device__ __forceinline__ void mask_tile(f32x16& p0, f32x16& p1, int dq, unsigned W) {
    const float NEG = -__builtin_inff();
#pragma unroll
    for (int r = 0; r < 16; ++r) {
        const int c = (r & 3) + 8 * (r >> 2);
        if ((unsigned)(dq - c) >= W) p0[r] = NEG;
        if ((unsigned)(dq - c - 32) >= W) p1[r] = NEG;
    }
}
__device__ __forceinline__ void mask_all(f32x16& p0, f32x16& p1) {
    const float NEG = -__builtin_inff();
#pragma unroll
    for (int r = 0; r < 16; ++r) { p0[r] = NEG; p1[r] = NEG; }
}
__device__ __forceinline__ void partialSM(f32x16& p0, f32x16& p1, float& m_reg, float& mn, float& alpha) {
    float pmax = p0[0];
#pragma unroll
    for (int r = 1; r < 16; ++r) pmax = fmaxf(pmax, p0[r]);
#pragma unroll
    for (int r = 0; r < 16; ++r) pmax = fmaxf(pmax, p1[r]);
    { auto rr = __builtin_amdgcn_permlane32_swap(__float_as_uint(pmax), __float_as_uint(pmax), false, false);
      pmax = fmaxf(__uint_as_float(rr[0]), __uint_as_float(rr[1])); }
    constexpr float C2 = 1.4426950408889634f * SCALE;
    if (__builtin_expect(__all((pmax - m_reg) * SCALE <= THR), 1)) { mn = m_reg; alpha = 1.f; }
    else { mn = fmaxf(m_reg, pmax); alpha = __builtin_amdgcn_exp2f((m_reg - mn) * C2); m_reg = mn; }
    const float mnL = -mn * C2;
#pragma unroll
    for (int r = 0; r < 16; ++r) p0[r] = fmaf(p0[r], C2, mnL);
#pragma unroll
    for (int r = 0; r < 16; ++r) p1[r] = fmaf(p1[r], C2, mnL);
#pragma unroll
    for (int r = 0; r < 16; ++r) p0[r] = __builtin_amdgcn_exp2f(p0[r]);
}
#define NSA_PK4(P, B_, OUT) do { unsigned a0 = cvt_pk_bf16(P[B_+0], P[B_+1]), a1 = cvt_pk_bf16(P[B_+2], P[B_+3]);                 \
        unsigned b0 = cvt_pk_bf16(P[B_+4], P[B_+5]), b1 = cvt_pk_bf16(P[B_+6], P[B_+7]);                                         \
        auto r0 = __builtin_amdgcn_permlane32_swap(a0, b0, false, false); auto r1 = __builtin_amdgcn_permlane32_swap(a1, b1, false, false); \
        u32x4 w = {r0[0], r1[0], r0[1], r1[1]}; OUT = *reinterpret_cast<bf16x8*>(&w); } while (0)
__device__ __forceinline__ void pack_p(const f32x16& p0, const f32x16& p1, bf16x8& pa0, bf16x8& pa1, bf16x8& pa2, bf16x8& pa3) {
    NSA_PK4(p0, 0, pa0); NSA_PK4(p0, 8, pa1); NSA_PK4(p1, 0, pa2); NSA_PK4(p1, 8, pa3);
}
__device__ __forceinline__ void finishSM(f32x16& p0, f32x16& p1, float alpha, float& l_reg, bf16x8& pa0, bf16x8& pa1, bf16x8& pa2, bf16x8& pa3) {
#pragma unroll
    for (int r = 0; r < 16; ++r) p1[r] = __builtin_amdgcn_exp2f(p1[r]);
    float ps = 0;
#pragma unroll
    for (int r = 0; r < 16; ++r) ps += p0[r];
#pragma unroll
    for (int r = 0; r < 16; ++r) ps += p1[r];
    { auto rr = __builtin_amdgcn_permlane32_swap(__float_as_uint(ps), __float_as_uint(ps), false, false);
      ps = __uint_as_float(rr[0]) + __uint_as_float(rr[1]); }
    l_reg = l_reg * alpha + ps;
    pack_p(p0, p1, pa0, pa1, pa2, pa3);
}
template <int KB>
__device__ __forceinline__ void qkt(f32x16& p0, f32x16& p1, const LAS unsigned char* lds, int r32, int hi, const bf16x8* qr) {
    p0 = f32x16{}; p1 = f32x16{};
    const LAS unsigned char* kb[4];
#pragma unroll
    for (int dd = 0; dd < 4; ++dd) kb[dd] = lds + L_K + KB * SHM + KSWZ(r32, (dd * 16 + hi * 8) * 2);
#pragma unroll
    for (int d0 = 0; d0 < 8; ++d0) { const LAS unsigned char* a = kb[d0 & 3] + (d0 >> 2) * 128;
        const bf16x8 b0 = *reinterpret_cast<const LAS bf16x8*>(a);
        const bf16x8 b1 = *reinterpret_cast<const LAS bf16x8*>(a + 32 * 256);
        p0 = __builtin_amdgcn_mfma_f32_32x32x16_bf16(b0, qr[d0], p0, 0, 0, 0);
        p1 = __builtin_amdgcn_mfma_f32_32x32x16_bf16(b1, qr[d0], p1, 0, 0, 0); }
}
template <int VB>
__device__ __forceinline__ void pv_tile(f32x16* o, int vb0, bf16x8 pa0, bf16x8 pa1, bf16x8 pa2, bf16x8 pa3) {
#define TRRD(dst, off) asm volatile("ds_read_b64_tr_b16 %0, %1 offset:%2" : "=&v"(dst) : "v"(vb0), "i"(off) : "memory")
#define PV_D0(d0) do { s16x4 l0, l1, l2, l3, h0, h1, h2, h3; constexpr int b_ = L_V + VB * SHM + v_rd_off(d0, 0, 0); \
        TRRD(l0, b_); TRRD(h0, b_ + 2048); TRRD(l1, b_ + 4096); TRRD(h1, b_ + 6144); TRRD(l2, b_ + 8192); TRRD(h2, b_ + 10240); TRRD(l3, b_ + 12288); TRRD(h3, b_ + 14336); \
        asm volatile("s_waitcnt lgkmcnt(0)" ::: "memory"); SBAR();   \
        o[d0] = __builtin_amdgcn_mfma_f32_32x32x16_bf16(pa0, (bf16x8){l0[0], l0[1], l0[2], l0[3], h0[0], h0[1], h0[2], h0[3]}, o[d0], 0, 0, 0);   \
        o[d0] = __builtin_amdgcn_mfma_f32_32x32x16_bf16(pa1, (bf16x8){l1[0], l1[1], l1[2], l1[3], h1[0], h1[1], h1[2], h1[3]}, o[d0], 0, 0, 0);   \
        o[d0] = __builtin_amdgcn_mfma_f32_32x32x16_bf16(pa2, (bf16x8){l2[0], l2[1], l2[2], l2[3], h2[0], h2[1], h2[2], h2[3]}, o[d0], 0, 0, 0);   \
        o[d0] = __builtin_amdgcn_mfma_f32_32x32x16_bf16(pa3, (bf16x8){l3[0], l3[1], l3[2], l3[3], h3[0], h3[1], h3[2], h3[3]}, o[d0], 0, 0, 0); } while (0)
    PV_D0(0); PV_D0(1); PV_D0(2); PV_D0(3);
#undef PV_D0
#undef TRRD
}

struct Ctx {
    LAS unsigned char* lds; int tid, wid, lane, r32, hi, sr, sc, vst0, vst1, kws, vb0;
    LAS float* li_l; LAS float* al_l;
};
__device__ __forceinline__ Ctx make_ctx(LAS unsigned char* lds) {
    Ctx c; c.lds = lds; c.tid = threadIdx.x; asm volatile("" : "+v"(c.tid));
    c.wid = __builtin_amdgcn_readfirstlane(c.tid >> 6); c.lane = c.tid & 63; c.r32 = c.lane & 31; c.hi = c.lane >> 5;
    c.sr = c.tid >> 4; c.sc = (c.tid & 15) * 8; c.vst0 = v_st(c.sr, c.sc); c.vst1 = v_st(32 + c.sr, c.sc); c.kws = KSWZ(c.sr, c.sc * 2);
    c.vb0 = (int)(unsigned)(uintptr_t)lds + v_rd_base(c.lane);
    LAS float* wsf = (LAS float*)(lds + L_WS) + c.wid * 64; c.li_l = wsf; c.al_l = wsf + 32;
    return c;
}
struct Stage { bf16x8 k0, k1, v0, v1; };
__device__ __forceinline__ void sload(Stage& S, const bf16_t* Kh, const bf16_t* Vh, int k0, const Ctx& c) {
    S.v0 = *(const bf16x8*)(Vh + (size_t)(k0 + c.sr) * HD + c.sc); S.v1 = *(const bf16x8*)(Vh + (size_t)(k0 + 32 + c.sr) * HD + c.sc);
    S.k0 = *(const bf16x8*)(Kh + (size_t)(k0 + c.sr) * HD + c.sc); S.k1 = *(const bf16x8*)(Kh + (size_t)(k0 + 32 + c.sr) * HD + c.sc);
}
__device__ __forceinline__ void swrite(const Stage& S, int bf, const Ctx& c) {
    *(LAS bf16x8*)(c.lds + L_V + bf * SHM + c.vst0) = S.v0; *(LAS bf16x8*)(c.lds + L_V + bf * SHM + c.vst1) = S.v1;
    *(LAS bf16x8*)(c.lds + L_K + bf * SHM + c.kws) = S.k0; *(LAS bf16x8*)(c.lds + L_K + bf * SHM + c.kws + 32 * 256) = S.k1;
}
__device__ __forceinline__ void rescale_rows(f32x16 (&o)[4], float a, const Ctx& c) {
    if (c.hi == 0) c.al_l[c.r32] = a;
    asm volatile("s_waitcnt lgkmcnt(0)" ::: "memory");
    float s[16];
#pragma unroll
    for (int r = 0; r < 16; ++r) s[r] = c.al_l[crow(r, c.hi)];
#pragma unroll
    for (int d = 0; d < 4; ++d)
#pragma unroll
        for (int r = 0; r < 16; ++r) o[d][r] *= s[r];
    asm volatile("s_waitcnt lgkmcnt(0)" ::: "memory");
}
template <int BUF, int MK>
__device__ __forceinline__ void tile_step(f32x16 (&o)[4], float& m_reg, float& l_reg, const bf16x8* qf, const Ctx& c, int j, int tpos, unsigned sel, int jcur) {
    f32x16 p0, p1; float mn, alpha; bf16x8 pa0, pa1, pa2, pa3;
    if (MK == 1) { const bool act = __any((sel >> j) & 1u); if (!act) return; }
    qkt<BUF>(p0, p1, c.lds, c.r32, c.hi, qf);
    const int dq = tpos - KVBLK * j - 4 * c.hi;
    if (MK == 0) { if (j == jcur || j == jcur - 8) mask_tile(p0, p1, dq, 512u); }
    else { if (j == jcur) mask_tile(p0, p1, dq, 0x7fffffffu);
        const bool on = (sel >> j) & 1u; const float NEG = -__builtin_inff();
#pragma unroll
        for (int r = 0; r < 16; ++r) { p0[r] = on ? p0[r] : NEG; p1[r] = on ? p1[r] : NEG; } }
    partialSM(p0, p1, m_reg, mn, alpha);
    if (__any(alpha < 1.f)) rescale_rows(o, alpha, c);
    finishSM(p0, p1, alpha, l_reg, pa0, pa1, pa2, pa3); SBAR();
    pv_tile<BUF>(o, c.vb0, pa0, pa1, pa2, pa3);
}
template <int MK>
__device__ __forceinline__ void run_tiles(f32x16 (&o)[4], float& m_reg, float& l_reg, const bf16x8* qf, const Ctx& c, const bf16_t* Kh, const bf16_t* Vh,
                                          unsigned tiles, int tpos, unsigned sel, int jcur) {
    Stage S;
    int j = __ffs((int)tiles) - 1; tiles &= tiles - 1;
    sload(S, Kh, Vh, KVBLK * j, c); swrite(S, 0, c);
    __syncthreads();
    for (;;) {
        int jn = tiles ? __ffs((int)tiles) - 1 : -1; tiles &= tiles - 1;
        if (jn >= 0) sload(S, Kh, Vh, KVBLK * jn, c);
        tile_step<0, MK>(o, m_reg, l_reg, qf, c, j, tpos, sel, jcur);
        if (jn >= 0) swrite(S, 1, c);
        __syncthreads();
        if (jn < 0) break;
        j = jn; jn = tiles ? __ffs((int)tiles) - 1 : -1; tiles &= tiles - 1;
        if (jn >= 0) sload(S, Kh, Vh, KVBLK * jn, c);
        tile_step<1, MK>(o, m_reg, l_reg, qf, c, j, tpos, sel, jcur);
        if (jn >= 0) swrite(S, 0, c);
        __syncthreads();
        if (jn < 0) break;
        j = jn;
    }
}
__device__ __forceinline__ void load_q(bf16x8 (&qf)[8], const bf16_t* Q, int row, int h, int hi) {
    const bf16_t* qp = Q + (size_t)row * DM + h * HD + hi * 8;
#pragma unroll
    for (int d0 = 0; d0 < 8; ++d0) qf[d0] = *(const bf16x8*)(qp + d0 * 16);
}
__device__ __forceinline__ void rotate_q(bf16x8& q0, bf16x8& q1, const float* COS, const float* SIN, int t, int hi) {
    const f32x4 c0 = *(const f32x4*)(COS + t * 16 + hi * 8), c1 = *(const f32x4*)(COS + t * 16 + hi * 8 + 4);
    const f32x4 s0 = *(const f32x4*)(SIN + t * 16 + hi * 8), s1 = *(const f32x4*)(SIN + t * 16 + hi * 8 + 4);
    f32x4 a0, a1, b0, b1;
#pragma unroll
    for (int jj = 0; jj < 4; ++jj) { a0[jj] = bf2f((bf16_t)q0[jj]); a1[jj] = bf2f((bf16_t)q0[4 + jj]); b0[jj] = bf2f((bf16_t)q1[jj]); b1[jj] = bf2f((bf16_t)q1[4 + jj]); }
    q0 = pack8(a0 * c0 - b0 * s0, a1 * c1 - b1 * s1);
    q1 = pack8(b0 * c0 + a0 * s0, b1 * c1 + a1 * s1);
}

__device__ __forceinline__ void window_unit(const Args& a, LAS unsigned char* lds, int bg, int qb) {
    unsigned char* ws = a.ws;
    const Ctx c = make_ctx(lds);
    const int n = c.wid >> 1, th = c.wid & 1, tq = 32 * th + c.r32, t = 64 * qb + tq, b = bg >> 2, g = bg & 3, h = g * 4 + n, row = b * SEQ + t;
    bf16x8 qf[8];
    load_q(qf, (const bf16_t*)(ws + WS_Q), row, h, c.hi);
    rotate_q(qf[0], qf[1], (const float*)(ws + WS_COS), (const float*)(ws + WS_SIN), t, c.hi);
    const bf16_t* Kh = (const bf16_t*)(ws + WS_KV) + 4 * KV_ELEMS + (size_t)bg * SEQ * HD; const bf16_t* Vh = (const bf16_t*)(ws + WS_KV) + 5 * KV_ELEMS + (size_t)bg * SEQ * HD;
    f32x16 o[4] = {}; float m_reg = -1e30f, l_reg = 0.f;
    const int jlo = qb >= 8 ? qb - 8 : 0;
    const unsigned tiles = (qb == 31 ? 0xffffffffu : ((1u << (qb + 1)) - 1u)) & ~((1u << jlo) - 1u);
    run_tiles<0>(o, m_reg, l_reg, qf, c, Kh, Vh, tiles, t, 0u, qb);
    const float g2 = sigmoid_f(((const float*)(ws + WS_GL))[(size_t)row * 48 + 32 + h]);
    rescale_rows(o, l_reg > 0.f ? g2 / l_reg : 0.f, c);
    bf16_t* OW = (bf16_t*)(ws + WS_XB);
    const int rbase = b * SEQ + 64 * qb + 32 * th;
#pragma unroll
    for (int r = 0; r < 16; ++r) { const int orow = rbase + crow(r, c.hi);
#pragma unroll
        for (int d0 = 0; d0 < 4; ++d0) { const float v = o[d0][r]; const float vn = __shfl_xor(v, 1);
            if ((c.r32 & 1) == 0) *(unsigned*)(OW + (size_t)orow * DM + h * HD + d0 * 32 + c.r32) = cvt_pk_bf16(v, vn); } }
}

__device__ __forceinline__ void cmpsel_unit(const Args& a, LAS unsigned char* lds, int bg, int qb) {
    unsigned char* ws = a.ws;
    const Ctx c = make_ctx(lds);
    const int n = c.wid >> 1, th = c.wid & 1, tq = 32 * th + c.r32, t = 64 * qb + tq, b = bg >> 2, g = bg & 3, h = g * 4 + n, row = b * SEQ + t;
    const float* GL = (const float*)(ws + WS_GL);
    LAS float* GS = (LAS float*)(lds + L_GS); LAS float* LS = (LAS float*)(lds + L_LS);
    LAS unsigned* SEL = (LAS unsigned*)(lds + L_SEL); LAS unsigned* UNI = (LAS unsigned*)(lds + L_UNI);
    bf16x8 qf[8];
    load_q(qf, (const bf16_t*)(ws + WS_Q), row, h, c.hi);
    f32x16 o[4] = {};
    float l_c;
    {
        const bf16_t* Kc = (const bf16_t*)(ws + WS_KC) + (size_t)bg * 128 * HD; const bf16_t* Vc = (const bf16_t*)(ws + WS_VC) + (size_t)bg * 128 * HD;
        { Stage S0; sload(S0, Kc, Vc, 0, c); swrite(S0, 0, c); }
        { Stage S1; sload(S1, Kc, Vc, 64, c); swrite(S1, 1, c); }
        __syncthreads();
        f32x16 pA0, pA1, pB0, pB1;
        qkt<0>(pA0, pA1, c.lds, c.r32, c.hi, qf); qkt<1>(pB0, pB1, c.lds, c.r32, c.hi, qf);
        const int cmax = t >= 31 ? ((t - 31) >> 4) : -1;
        const float NEG = -__builtin_inff();
#pragma unroll
        for (int r = 0; r < 16; ++r) { const int cc = crow(r, c.hi);
            if (cc > cmax) pA0[r] = NEG; if (cc + 32 > cmax) pA1[r] = NEG; if (cc + 64 > cmax) pB0[r] = NEG; if (cc + 96 > cmax) pB1[r] = NEG; }
        float mx = -1e30f;
#pragma unroll
        for (int r = 0; r < 16; ++r) mx = fmaxf(fmaxf(mx, fmaxf(pA0[r], pA1[r])), fmaxf(pB0[r], pB1[r]));
        { auto rr = __builtin_amdgcn_permlane32_swap(__float_as_uint(mx), __float_as_uint(mx), false, false); mx = fmaxf(__uint_as_float(rr[0]), __uint_as_float(rr[1])); }
        constexpr float C2 = 1.4426950408889634f * SCALE;
        const float mnL = -mx * C2; float ps = 0.f;
#pragma unroll
        for (int r = 0; r < 16; ++r) { pA0[r] = __builtin_amdgcn_exp2f(fmaf(pA0[r], C2, mnL)); pA1[r] = __builtin_amdgcn_exp2f(fmaf(pA1[r], C2, mnL));
            pB0[r] = __builtin_amdgcn_exp2f(fmaf(pB0[r], C2, mnL)); pB1[r] = __builtin_amdgcn_exp2f(fmaf(pB1[r], C2, mnL)); ps += (pA0[r] + pA1[r]) + (pB0[r] + pB1[r]); }
        { auto rr = __builtin_amdgcn_permlane32_swap(__float_as_uint(ps), __float_as_uint(ps), false, false); ps = __uint_as_float(rr[0]) + __uint_as_float(rr[1]); }
        l_c = ps;
        const float inv = ps > 0.f ? 1.0f / ps : 0.f;
        LAS float* gsr = GS + (n * 64 + tq) * 33; LAS float* lsr = LS + (n * 64 + tq) * 33;
#pragma unroll
        for (int k = 0; k < 4; ++k) {
            const int jb = 2 * k + c.hi;
            gsr[jb]      = ((pA0[4 * k] + pA0[4 * k + 1]) + (pA0[4 * k + 2] + pA0[4 * k + 3])) * inv; lsr[jb]      = pA0[4 * k + 3] * inv;
            gsr[8 + jb]  = ((pA1[4 * k] + pA1[4 * k + 1]) + (pA1[4 * k + 2] + pA1[4 * k + 3])) * inv; lsr[8 + jb]  = pA1[4 * k + 3] * inv;
            gsr[16 + jb] = ((pB0[4 * k] + pB0[4 * k + 1]) + (pB0[4 * k + 2] + pB0[4 * k + 3])) * inv; lsr[16 + jb] = pB0[4 * k + 3] * inv;
            gsr[24 + jb] = ((pB1[4 * k] + pB1[4 * k + 1]) + (pB1[4 * k + 2] + pB1[4 * k + 3])) * inv; lsr[24 + jb] = pB1[4 * k + 3] * inv;
        }
        bf16x8 pa0, pa1, pa2, pa3;
        pack_p(pA0, pA1, pa0, pa1, pa2, pa3); SBAR(); pv_tile<0>(o, c.vb0, pa0, pa1, pa2, pa3);
        pack_p(pB0, pB1, pa0, pa1, pa2, pa3); SBAR(); pv_tile<1>(o, c.vb0, pa0, pa1, pa2, pa3);
    }
    __syncthreads();
    {
        LAS float* IMP = (LAS float*)(lds + L_IMP);
        const int tk = c.tid & 63, j0 = c.wid * 4;
        const LAS float* gb = GS + tk * 33 + j0; const LAS float* lb = LS + tk * 33 + j0 - 1;
#pragma unroll
        for (int jj = 0; jj < 4; ++jj) { float s = 0.f;
#pragma unroll
            for (int nn = 0; nn < 4; ++nn) { s += gb[nn * 2112 + jj]; const float lv = lb[nn * 2112 + jj]; s += (j0 + jj > 0) ? lv : 0.f; }
            IMP[tk * 33 + j0 + jj] = s; }
    }
    __syncthreads();
    if (c.wid == 0) {
        const LAS float* IMP = (const LAS float*)(lds + L_IMP);
        const int tk = c.lane;
        unsigned selm = 1u | (1u << qb);
        if (qb >= 2) {
            const int nfree = qb - 1;
            if (nfree <= 6) selm |= ((1u << qb) - 1u) & ~1u;
            else {
                float v[32];
#pragma unroll
                for (int jj = 1; jj < 31; ++jj) { const float s = IMP[tk * 33 + jj]; v[jj] = (jj < qb) ? s : -1.0f; }
                unsigned taken = 0u;
                for (int rnd = 0; rnd < 6; ++rnd) {
                    float best = -0.5f; int bi = -1;
#pragma unroll
                    for (int jj = 1; jj < 31; ++jj) { const bool ok = !((taken >> jj) & 1u) && v[jj] > best; best = ok ? v[jj] : best; bi = ok ? jj : bi; }
                    if (bi >= 0) taken |= 1u << bi;
                }
                selm |= taken;
            }
        }
        SEL[tk] = selm;
        unsigned u = selm;
#pragma unroll
        for (int off = 1; off < 64; off <<= 1) u |= (unsigned)__shfl_xor((int)u, off);
        if (c.lane == 0) UNI[0] = u;
    }
    bf16_t* ZC = (bf16_t*)(ws + WS_ZC);
    const int rbase = b * SEQ + 64 * qb + 32 * th;
    {
        const float g0 = sigmoid_f(GL[(size_t)row * 48 + h]);
        rescale_rows(o, l_c > 0.f ? g0 / l_c : 0.f, c);
#pragma unroll
        for (int r = 0; r < 16; ++r) { const int orow = rbase + crow(r, c.hi);
#pragma unroll
            for (int d0 = 0; d0 < 4; ++d0) ZC[(size_t)orow * ZC_LD + 2048 + h * HD + d0 * 32 + c.r32] = (bf16_t)(cvt_pk_bf16(o[d0][r], 0.f) & 0xffffu); }
#pragma unroll
        for (int d = 0; d < 4; ++d) o[d] = f32x16{};
    }
    __syncthreads();
    const unsigned sel = SEL[tq]; const unsigned uni = (unsigned)__builtin_amdgcn_readfirstlane((int)UNI[0]);
    rotate_q(qf[0], qf[1], (const float*)(ws + WS_COS), (const float*)(ws + WS_SIN), t, c.hi);
    float m_reg = -1e30f, l_reg = 0.f;
    {
        const bf16_t* Kh = (const bf16_t*)(ws + WS_KV) + 2 * KV_ELEMS + (size_t)bg * SEQ * HD; const bf16_t* Vh = (const bf16_t*)(ws + WS_KV) + 3 * KV_ELEMS + (size_t)bg * SEQ * HD;
        run_tiles<1>(o, m_reg, l_reg, qf, c, Kh, Vh, uni, t, sel, qb);
    }
    const float g1 = sigmoid_f(GL[(size_t)row * 48 + 16 + h]);
    rescale_rows(o, l_reg > 0.f ? g1 / l_reg : 0.f, c);
    const bf16_t* OW = (const bf16_t*)(ws + WS_XB); const bf16_t* NG = (const bf16_t*)(ws + WS_NG);
    int rbase2 = rbase; asm volatile("" : "+v"(rbase2));
#pragma unroll
    for (int r = 0; r < 16; ++r) { const int orow = rbase2 + crow(r, c.hi);
#pragma unroll
        for (int d0 = 0; d0 < 4; ++d0) {
            const size_t col = (size_t)h * HD + d0 * 32 + c.r32;
            bf16_t* yp = ZC + (size_t)orow * ZC_LD + 2048 + col;
            const float occ = bf2f(*yp);
            const float ow = bf2f(OW[(size_t)orow * DM + col]), ng = bf2f(NG[(size_t)orow * DM + col]);
            const float v = (occ + o[d0][r] + ow) * silu_f(ng);
            *yp = (bf16_t)(cvt_pk_bf16(v, 0.f) & 0xffffu); } }
    __syncthreads();
}
}

__device__ __forceinline__ void p6_sgu_naive(const Args& a, LAS unsigned char* lds, int blk, int G, int tid) {
    LAS float* vn = (LAS float*)lds;
    LAS float* Wt = (LAS float*)(lds + 65536);
    bf16_t* Z1 = (bf16_t*)(a.ws + WS_Z1); const float* LNS = (const float*)(a.ws + WS_LNS);
    const float* lng = a.in[15]; const float* lnb = a.in[16]; const float* wsp = a.in[17]; const float* bsp = a.in[18];
    const int d = tid & 127, tq = tid >> 7;
    for (int unit = blk; unit < 64 * 16 * 2; unit += G) {
        const int dh = unit & 1, h = (unit >> 1) & 15, ch = unit >> 5;
        const int row0 = ch * 128, col = h * 256 + dh * 128;
        __syncthreads();
        for (int i = tid; i < 128 * 128; i += NTHREADS) { const int s = i >> 7, dd = i & 127; const int row = row0 + s;
            const float sum = LNS[2 * row], sq = LNS[2 * row + 1]; const float mu = sum * (1.0f / MIXW); const float var = sq * (1.0f / MIXW) - mu * mu;
            const float rstd = 1.0f / sqrtf(fmaxf(var, 0.f) + EPS);
            const float v = bf2f(Z1[(size_t)row * N1 + MIXW + col + dd]);
            vn[i] = (v - mu) * rstd * lng[col + dd] + lnb[col + dd];
            Wt[i] = wsp[(size_t)h * 16384 + i]; }
        __syncthreads();
        for (int tt = 0; tt < 32; ++tt) {
            const int t = tq + 4 * tt;
            float mix = 0.f;
            for (int s = 0; s <= t; ++s) mix += Wt[t * 128 + s] * vn[s * 128 + d];
            mix += bsp[h * 128 + t];
            const size_t off = (size_t)(row0 + t) * N1 + col + d;
            const float u = bf2f(Z1[off]), zg = bf2f(Z1[off + 2 * MIXW]);
            Z1[off] = (bf16_t)f2bf(u * mix * silu_f(zg));
        }
    }
    __syncthreads();
}

__device__ __forceinline__ void p8_final(const Args& a, int gw, int NGW, int lane) {
    const float* gf = a.in[20];
    for (int m = gw; m < MTOK; m += NGW) {
        f32x4* xr = (f32x4*)(a.out + (size_t)m * DM) + lane;
        f32x4 v[8]; float s = 0.f;
#pragma unroll
        for (int j = 0; j < 8; ++j) { v[j] = xr[64 * j]; s += (v[j].x * v[j].x + v[j].y * v[j].y) + (v[j].z * v[j].z + v[j].w * v[j].w); }
        s = wave_sum(s);
        const float rs = 1.0f / sqrtf(s * (1.0f / DM) + EPS);
#pragma unroll
        for (int j = 0; j < 8; ++j) { const f32x4 gg = *((const f32x4*)gf + lane + 64 * j); xr[64 * j] = v[j] * rs * gg; }
    }
}

#define GAS __attribute__((address_space(1)))
typedef GAS unsigned gu32;
#define XB_TMO      128
#define XB_XCNT(j)  (256  + 64 * (j))
#define XB_XSUB(j)  (1280 + 64 * (j))
#define XB_XGEN(j)  (2304 + 64 * (j))
#define XB_TOP      3328
#define XB_TOPGEN   3392
#define XCD_BAR_WORDS 3456
#define XB_SPIN_CAP (1u << 18)

__device__ __forceinline__ unsigned xb_ld(unsigned* p)              { return __hip_atomic_load(p, __ATOMIC_RELAXED, __HIP_MEMORY_SCOPE_AGENT); }
__device__ __forceinline__ unsigned xb_add(unsigned* p, unsigned v) { return __hip_atomic_fetch_add(p, v, __ATOMIC_RELAXED, __HIP_MEMORY_SCOPE_AGENT); }
__device__ __forceinline__ unsigned xb_xcc_id() { return (unsigned)__builtin_amdgcn_s_getreg((3 << 11) | 20) & 0xFu; }
#define XB_SPIN(cond, bar) do { unsigned _sp = 0; while (cond) { __builtin_amdgcn_s_sleep(1); \
    if ((++_sp & 255u) == 0u) { if (xb_ld(&(bar)[XB_TMO])) break; if (_sp > XB_SPIN_CAP) { atomicAdd(&(bar)[XB_TMO], 1u); break; } } } } while (0)

struct XcdBarrier {
    unsigned* bar; unsigned x;
    volatile LAS unsigned* st;
};

__device__ __forceinline__ XcdBarrier xcd_barrier_post(unsigned* bar, volatile LAS unsigned* st) {
    XcdBarrier b; b.bar = bar; b.x = xb_xcc_id(); b.st = st;
    if (threadIdx.x == 0) (void)xb_add(&bar[XB_XCNT(b.x)], 1u);
    return b;
}
__device__ __forceinline__ void xcd_barrier_complete(unsigned* bar, unsigned x, unsigned& nloc, unsigned& nx) {
    const unsigned G = gridDim.x * gridDim.y * gridDim.z;
    unsigned sum, cnt, mine, sp = 0u;
    for (;;) {
        sum = 0u; cnt = 0u; mine = 0u;
#pragma unroll
        for (unsigned j = 0; j < 16; ++j) { const unsigned c = xb_ld(&bar[XB_XCNT(j)]); sum += c; cnt += (c > 0u) ? 1u : 0u; mine = (j == x) ? c : mine; }
        if (sum == G) break;
        __builtin_amdgcn_s_sleep(1);
        if ((++sp & 255u) == 0u) { if (xb_ld(&bar[XB_TMO])) break; if (sp > XB_SPIN_CAP) { atomicAdd(&bar[XB_TMO], 1u); break; } }
    }
    nloc = mine > 0u ? mine : 1u; nx = cnt > 0u ? cnt : 1u;
}

__device__ __forceinline__ void xcd_barrier(const XcdBarrier& b) {
    asm volatile("s_waitcnt vmcnt(0)" ::: "memory");
    __syncthreads();
    if (threadIdx.x == 0) {
        unsigned* bar = b.bar;
        __builtin_amdgcn_s_waitcnt(0);
        unsigned nloc = b.st[0], nx = b.st[1];
        if (nloc == 0u) { xcd_barrier_complete(bar, b.x, nloc, nx); b.st[0] = nloc; b.st[1] = nx; }
        const unsigned old = xb_add(&bar[XB_XSUB(b.x)], 1u);
        const unsigned gen = old / nloc;
        if (old + 1u == (gen + 1u) * nloc) {
            __builtin_amdgcn_fence(__ATOMIC_RELEASE, "agent");
            asm volatile("s_waitcnt vmcnt(0)" ::: "memory");
            const unsigned og = xb_add(&bar[XB_TOP], 1u);
            const unsigned tg = og / nx;
            if (og + 1u == (tg + 1u) * nx) xb_add(&bar[XB_TOPGEN], 1u);
            else XB_SPIN(xb_ld(&bar[XB_TOPGEN]) == tg, bar);
            __builtin_amdgcn_fence(__ATOMIC_ACQUIRE, "agent");
            xb_add(&bar[XB_XGEN(b.x)], 1u);
            asm volatile("s_waitcnt vmcnt(0)" ::: "memory");
        } else {
            XB_SPIN(xb_ld(&bar[XB_XGEN(b.x)]) == gen, bar);
            __builtin_amdgcn_fence(__ATOMIC_ACQUIRE, "agent");
            asm volatile("s_waitcnt vmcnt(0)" ::: "memory");
        }
    }
    __syncthreads();
}

constexpr int NPHASE = 9;
template <bool COOP>
__global__ void __launch_bounds__(NTHREADS, 2) fwd_kernel(Args args) {
    extern __shared__ __attribute__((aligned(16))) unsigned char lds_raw[];
    LAS unsigned char* lds = (LAS unsigned char*)lds_raw;
    const int tid = threadIdx.x, lane = tid & 63, wave = __builtin_amdgcn_readfirstlane(tid >> 6);
    const int G = gridDim.x, bx = blockIdx.x;
    const int vcu = (G % 8 == 0) ? (bx % 8) * (G / 8) + bx / 8 : bx;
    const int gw = vcu * NWAVES + wave, NGW = G * NWAVES, gt = gw * 64 + lane, NGT = NGW * 64;
    const int lo = args.ph_lo, hi = args.ph_hi;
    unsigned char* ws = args.ws;
#define IN(k) (lo <= (k) && (k) < hi)
    unsigned* barw = (unsigned*)(ws + WS_BAR);
    volatile LAS unsigned* bst = (volatile LAS unsigned*)(lds + LDS_BYTES - 64);
    XcdBarrier bar; bar.bar = barw; bar.x = 0; bar.st = bst;
#define SEAM(k) do { if (COOP) { if (IN(k) && IN((k) + 1)) { xcd_barrier(bar); } } } while (0)

    if (IN(0)) {
        if (COOP) { if (tid == 0) { bst[0] = 0u; bst[1] = 0u; }
            if (bx == 0) for (int i = tid; i < XCD_BAR_WORDS; i += NTHREADS) barw[i] = 0u; }
        p0_prologue(args, lds, vcu, G, wave, lane);
    }
    if (COOP) { if (IN(0) && IN(1)) { __threadfence(); cg::this_grid().sync(); __threadfence(); bar = xcd_barrier_post(barw, bst); } }
    if (IN(1)) {
        pg8::Gemm g{(const bf16_t*)(ws + WS_XB), (const bf16_t*)(ws + WS_WT0), MTOK, N0, DM, DM};
        pg8::StaticOrder S; S.init(MTOK, N0, G, bx);
        pg8::Epi0 E{(const float*)(ws + WS_RSTD0), (bf16_t*)(ws + WS_ZC), (bf16_t*)(ws + WS_Q), (bf16_t*)(ws + WS_KV), (bf16_t*)(ws + WS_NG), (float*)(ws + WS_GL),
                    (const float*)(ws + WS_COS), (const float*)(ws + WS_SIN)};
        pg8::gemm_phase<pg8::Epi0, pg8::StaticOrder, true, true>(lds, g, S, E);
    }
    SEAM(1);
    if (IN(2)) {
        p2_compress(args, lds, vcu, G, tid);
        for (int item = vcu; item < 256; item += G) { const int bg = item >> 4, p = item & 15;
#ifndef NO_WINDOW
            for (int k = 0; k < 2; ++k) nsa::window_unit(args, lds, bg, k ? 31 - p : p);
#endif
        }
        p2_conv(args, gt, NGT);
    }
    SEAM(2);
    if (IN(3)) {
        for (int item = vcu; item < 256; item += G) { const int bg = item >> 4, p = item & 15;
#ifndef NO_CMPSEL
            for (int k = 0; k < 2; ++k) nsa::cmpsel_unit(args, lds, bg, k ? 31 - p : p);
#endif
        }
    }
    SEAM(3);
    if (IN(4)) {
        pg8::Gemm g{(const bf16_t*)(ws + WS_ZC), (const bf16_t*)(ws + WS_WTO0), MTOK, DM, MIXW, ZC_LD};
        pg8::StaticOrder S; S.init(MTOK, DM, G, bx);
        pg8::EpiOut0 E{args.in[0], args.out, (bf16_t*)(ws + WS_XB), (float*)(ws + WS_SS1)};
        pg8::gemm_phase<pg8::EpiOut0, pg8::StaticOrder, true, true>(lds, g, S, E);
    }
    SEAM(4);
    if (IN(5)) {
        pg8::Gemm g{(const bf16_t*)(ws + WS_XB), (const bf16_t*)(ws + WS_WT1), MTOK, N1, DM, DM};
        pg8::StaticOrder S; S.init(MTOK, N1, G, bx);
        pg8::Epi1 E{(const float*)(ws + WS_SS1), (bf16_t*)(ws + WS_Z1), (float*)(ws + WS_LNS)};
        pg8::gemm_phase<pg8::Epi1, pg8::StaticOrder, true, true>(lds, g, S, E);
    }
    SEAM(5);
    if (IN(6)) { p6_sgu_naive(args, lds, vcu, G, tid); }
    SEAM(6);
    if (IN(7)) {
        pg8::Gemm g{(const bf16_t*)(ws + WS_Z1), (const bf16_t*)(ws + WS_WTO1), MTOK, DM, MIXW, N1};
        pg8::StaticOrder S; S.init(MTOK, DM, G, bx);
        pg8::EpiOut1 E{args.out};
        pg8::gemm_phase<pg8::EpiOut1, pg8::StaticOrder, true, true>(lds, g, S, E);
    }
    SEAM(7);
    if (IN(8)) { p8_final(args, gw, NGW, lane); }
#undef IN
#undef SEAM
}

#ifndef MK_COOP
#define MK_COOP 1
#endif

extern "C" void kernel_launch(void* const* d_in, const int* in_sizes, int n_in, void* d_out, int out_size, void* d_ws, size_t ws_size, hipStream_t stream) {
    static int grid = 0;
    if (grid == 0) {
        if (n_in != 21 || out_size != MTOK * DM || ws_size < WS_END) { fprintf(stderr, "kernel_launch: unexpected shapes (n_in %d out %d ws %zu)\n", n_in, out_size, ws_size); grid = -1; return; }
        int dev = 0, cus = 0, per_cu = 0;
        (void)hipGetDevice(&dev); (void)hipDeviceGetAttribute(&cus, hipDeviceAttributeMultiprocessorCount, dev);
        (void)hipFuncSetAttribute((const void*)fwd_kernel<true>, hipFuncAttributeMaxDynamicSharedMemorySize, LDS_BYTES);
        (void)hipFuncSetAttribute((const void*)fwd_kernel<false>, hipFuncAttributeMaxDynamicSharedMemorySize, LDS_BYTES);
        (void)hipOccupancyMaxActiveBlocksPerMultiprocessor(&per_cu, (const void*)fwd_kernel<true>, NTHREADS, LDS_BYTES);
        if (per_cu < 1) { fprintf(stderr, "kernel_launch: occupancy query says %d blocks per CU\n", per_cu); per_cu = 1; }
        (void)hipGetLastError();
        grid = cus;
        fprintf(stderr, "kernel_launch: grid %d (per_cu %d)\n", grid, per_cu);
    }
    if (grid < 0) return;
    Args a{};
    for (int i = 0; i < 21; ++i) a.in[i] = (const float*)d_in[i];
    a.out = (float*)d_out; a.ws = (unsigned char*)d_ws;
#if MK_COOP
    a.ph_lo = 0; a.ph_hi = NPHASE;
    void* kargs[] = {&a};
    hipError_t e = hipLaunchCooperativeKernel((const void*)fwd_kernel<true>, dim3(grid), dim3(NTHREADS), kargs, LDS_BYTES, stream);
    if (e != hipSuccess) fprintf(stderr, "cooperative launch failed: %s (grid %d)\n", hipGetErrorString(e), grid);
#else
    for (int p = 0; p < NPHASE; ++p) {
        a.ph_lo = p; a.ph_hi = p + 1;
        hipLaunchKernelGGL(fwd_kernel<false>, dim3(grid), dim3(NTHREADS), LDS_BYTES, stream, a);
    }
#endif
}
```

```cpp
#include <hip/hip_runtime.h>
#include <hip/hip_cooperative_groups.h>
#include <cstdio>
#include <cstdint>
namespace cg = cooperative_groups;

#define LAS __attribute__((address_space(3)))
typedef unsigned short bf16_t;
typedef short bf16x8 __attribute__((ext_vector_type(8)));
typedef float f32x4 __attribute__((ext_vector_type(4)));
typedef float f32x2 __attribute__((ext_vector_type(2)));
typedef unsigned u32x4 __attribute__((ext_vector_type(4)));
typedef unsigned u32x2 __attribute__((ext_vector_type(2)));

constexpr int DM = 2048, NB = 4, SEQ = 2048, MTOK = NB * SEQ;
constexpr int N0 = 15616, N0_SRC = 15408;
constexpr int N1 = 12288, MIXW = 4096;
constexpr int ZC_LD = 8192;
constexpr float EPS = 1e-6f;
constexpr int NKV = 4, HD = 128, NH = 16;
constexpr int NCMP = 127;

constexpr size_t MiB = 1u << 20;
constexpr size_t WS_BAR = 0;
constexpr size_t WS_RSTD0 = 1 * MiB, WS_SS1 = WS_RSTD0 + 32768, WS_LNS = WS_SS1 + 32768, WS_COS = WS_LNS + 65536, WS_SIN = WS_COS + 131072;
constexpr size_t WS_KC = 2 * MiB, WS_VC = 2 * MiB + 524288;
constexpr size_t WS_GL = 3 * MiB;
constexpr size_t WS_W1T = 5 * MiB;
constexpr size_t WS_W2T = 7 * MiB;
constexpr size_t WS_PBP = 7 * MiB + 65536;
constexpr size_t WS_SW = 7 * MiB + 524288;
constexpr size_t WS_WT0 = 8 * MiB, WS_WTO0 = 69 * MiB, WS_WT1 = 85 * MiB, WS_WTO1 = 133 * MiB;
constexpr size_t WS_XB = 149 * MiB;
constexpr size_t WS_NG = 181 * MiB;
constexpr size_t WS_ZC = 213 * MiB;
constexpr size_t WS_Q = 341 * MiB;
constexpr size_t WS_KV = 373 * MiB;
constexpr size_t KV_ELEMS = (size_t)MTOK * 512;
constexpr size_t WS_END = 421 * MiB;
constexpr size_t WS_Z1 = WS_ZC;
static_assert(WS_Z1 + (size_t)MTOK * N1 * 2 <= WS_END, "z1 overlay");

constexpr int NWAVES = 8, NTHREADS = 512;
constexpr int LDS_BYTES = 147456;

struct Args { const float* in[21]; float* out; unsigned char* ws; int ph_lo, ph_hi; };

__device__ __forceinline__ float bf_lo(unsigned u) { return __uint_as_float(u << 16); }
__device__ __forceinline__ float bf_hi(unsigned u) { return __uint_as_float(u & 0xffff0000u); }
__device__ __forceinline__ float bf2f(bf16_t b) { return __uint_as_float((unsigned)b << 16); }
__device__ __forceinline__ unsigned f2bf(float f) { unsigned u = __float_as_uint(f); return (u + 0x7fffu + ((u >> 16) & 1u)) >> 16; }
__device__ __forceinline__ unsigned pk2(float lo, float hi) { return f2bf(lo) | (f2bf(hi) << 16); }
__device__ __forceinline__ unsigned cvt_pk_bf16(float lo, float hi) { unsigned r; asm volatile("v_cvt_pk_bf16_f32 %0, %1, %2" : "=v"(r) : "v"(lo), "v"(hi)); return r; }
__device__ __forceinline__ float silu_f(float x) { return x / (1.f + __expf(-x)); }
__device__ __forceinline__ float sigmoid_f(float x) { return 1.f / (1.f + __expf(-x)); }
__device__ __forceinline__ float wave_sum(float v) {
#pragma unroll
    for (int o = 1; o < 64; o <<= 1) v += __shfl_xor(v, o);
    return v;
}
__device__ __forceinline__ float wave_max(float v) {
#pragma unroll
    for (int o = 1; o < 64; o <<= 1) v = fmaxf(v, __shfl_xor(v, o));
    return v;
}
__device__ __forceinline__ int colmap0(int nd) { return nd < 13312 ? nd : (nd < 15360 ? nd + 48 : (nd < 15408 ? nd - 2048 : -1)); }

namespace pg8 {
#define PG8_LAS __attribute__((address_space(3)))
constexpr int BM = 256, BK = 64, HALF = 128, HTB = HALF * BK * 2  , STAGE_BYTES = 8 * HTB, NXCD = 8, WGM = 8;

__host__ __device__ __forceinline__ int lds_byte(int r, int c) { const int st = (r >> 4) * 2 + (c >> 5), rr = r & 15, cc = c & 31, ob = rr * 64 + cc * 2; return st * 1024 + (ob ^ (((ob >> 9) & 1) << 5)); }
__host__ __device__ __forceinline__ void stage_rc(int b, int& R, int& C) { const int st = b / 1024, sb = b % 1024, swz = sb ^ (((sb >> 9) & 1) << 5); R = (st >> 1) * 16 + swz / 64; C = (st & 1) * 32 + (swz % 64) / 2; }
__host__ __device__ __forceinline__ int perm32(int rho) { const int n = rho >> 4, i = rho & 15; return 8 * (i >> 2) + 4 * n + (i & 3); }

struct Unit { int pm, pn; };
struct Gemm { const bf16_t* A; const bf16_t* Bt; int M, N, K, lda; };

struct StaticOrder {
    int nM, nN, nwg, G, c;
    __host__ __device__ void init(int M, int N, int G_, int c_) { nM = M / BM; nN = N / BM; nwg = nM * nN; G = G_; c = c_; }
    __host__ __device__ bool next(int i, Unit& u) const {
        const long L = (long)i * G + c; if (L >= nwg) return false;
        int wgid = (int)L; { const int q = nwg / NXCD, r = nwg % NXCD, xcd = wgid % NXCD, off = wgid / NXCD; wgid = (xcd < r ? xcd * (q + 1) : r * (q + 1) + (xcd - r) * q) + off; }
        const int nig = WGM * nN, gid = wgid / nig, fm = gid * WGM, gsz = (nM - fm) < WGM ? (nM - fm) : WGM;
        u.pm = fm + ((wgid % nig) % gsz); u.pn = (wgid % nig) / gsz; return true;
    }
    __device__ __forceinline__ void a_ready(const Unit&) const {}
    __device__ __forceinline__ void done(const Unit&) const {}
};


struct Epi0 {
    static constexpr bool PERM = true, AFTER_DRAIN = false;
    const float* rstd; bf16_t* ZC; bf16_t* Q; bf16_t* KV; bf16_t* NG; float* GL; const float* COS; const float* SIN;
    __device__ __forceinline__ void operator()(const f32x4 (&acc)[2][2][4][2], const Unit& u, int wr, int wc, int fr, int fq) const {
        const int pn = u.pn;
        const int rowb = u.pm * BM + wr * 64 + fr;
        const int cl = wc * 32 + 8 * fq;
        const bool rot = (pn == 44 || pn == 45 || pn == 48 || pn == 49) && (wc == 0);
#pragma unroll
        for (int ai = 0; ai < 2; ++ai)
#pragma unroll
            for (int m = 0; m < 4; ++m) {
                const int row = rowb + ai * HALF + m * 16;
                const float rs = rstd[row];
                const int t = row & (SEQ - 1), b = row >> 11;
                f32x4 cs0, cs1, sn0, sn1;
                if (rot) { const float* cp = COS + t * 16 + 8 * (fq & 1); const float* sp = SIN + t * 16 + 8 * (fq & 1);
                    cs0 = *(const f32x4*)cp; cs1 = *(const f32x4*)(cp + 4); sn0 = *(const f32x4*)sp; sn1 = *(const f32x4*)(sp + 4); }
#pragma unroll
                for (int bj = 0; bj < 2; ++bj) {
                    f32x4 v0 = acc[ai][bj][m][0] * rs, v1 = acc[ai][bj][m][1] * rs;
                    if (rot) {
                        f32x4 p0, p1;
#pragma unroll
                        for (int j = 0; j < 4; ++j) { p0[j] = __shfl_xor(v0[j], 32); p1[j] = __shfl_xor(v1[j], 32); }
                        if (fq < 2) { v0 = v0 * cs0 - p0 * sn0; v1 = v1 * cs1 - p1 * sn1; }
                        else        { v0 = v0 * cs0 + p0 * sn0; v1 = v1 * cs1 + p1 * sn1; }
                    }
                    const int c = cl + bj * HALF;
                    if (pn == 60) {
                        if (c < 48) { float* gp = GL + (size_t)row * 48 + c; *(f32x4*)gp = v0; *(f32x4*)(gp + 4) = v1; }
                    } else {
                        u32x4 w; w.x = cvt_pk_bf16(v0[0], v0[1]); w.y = cvt_pk_bf16(v0[2], v0[3]); w.z = cvt_pk_bf16(v1[0], v1[1]); w.w = cvt_pk_bf16(v1[2], v1[3]);
                        bf16_t* dst;
                        if (pn < 32) dst = ZC + (size_t)row * ZC_LD + pn * BM + c;
                        else if (pn < 40) dst = Q + (size_t)row * DM + (pn - 32) * BM + c;
                        else if (pn < 52) { const int which = (pn - 40) >> 1, g = ((pn - 40) & 1) * 2 + bj;
                            dst = KV + (size_t)which * KV_ELEMS + ((size_t)((b * NKV + g) * SEQ + t)) * HD + cl; }
                        else dst = NG + (size_t)row * DM + (pn - 52) * BM + c;
                        *(u32x4*)dst = w;
                    }
                }
            }
    }
};

struct EpiOut0 {
    static constexpr bool PERM = false, AFTER_DRAIN = false;
    const float* X; float* X1; bf16_t* X1B; float* SS;
    __device__ __forceinline__ void operator()(const f32x4 (&acc)[2][2][4][2], const Unit& u, int wr, int wc, int fr, int fq) const {
        const int rowb = u.pm * BM + wr * 64 + fr, colb = u.pn * BM + wc * 32 + 4 * fq;
#pragma unroll
        for (int ai = 0; ai < 2; ++ai)
#pragma unroll
            for (int m = 0; m < 4; ++m) {
                const int row = rowb + ai * HALF + m * 16; float ss = 0.f;
#pragma unroll
                for (int bj = 0; bj < 2; ++bj)
#pragma unroll
                    for (int n = 0; n < 2; ++n) {
                        const size_t off = (size_t)row * DM + colb + bj * HALF + n * 16;
                        const f32x4 x1 = *(const f32x4*)(X + off) + acc[ai][bj][m][n];
                        *(f32x4*)(X1 + off) = x1;
                        u32x2 w; w.x = cvt_pk_bf16(x1[0], x1[1]); w.y = cvt_pk_bf16(x1[2], x1[3]); *(u32x2*)(X1B + off) = w;
                        ss += (x1[0] * x1[0] + x1[1] * x1[1]) + (x1[2] * x1[2] + x1[3] * x1[3]);
                    }
                ss += __shfl_xor(ss, 16); ss += __shfl_xor(ss, 32);
                if (fq == 0) atomicAdd(SS + row, ss);
            }
    }
};

struct Epi1 {
    static constexpr bool PERM = true, AFTER_DRAIN = false;
    const float* SS; bf16_t* Z1; float* LNS;
    __device__ __forceinline__ void operator()(const f32x4 (&acc)[2][2][4][2], const Unit& u, int wr, int wc, int fr, int fq) const {
        const int rowb = u.pm * BM + wr * 64 + fr, colb = u.pn * BM + wc * 32 + 8 * fq;
        const bool isv = (u.pn >= 16 && u.pn < 32);
#pragma unroll
        for (int ai = 0; ai < 2; ++ai)
#pragma unroll
            for (int m = 0; m < 4; ++m) {
                const int row = rowb + ai * HALF + m * 16;
                const float rs = __builtin_amdgcn_rsqf(SS[row] * (1.0f / DM) + EPS);
                float s1 = 0.f, s2 = 0.f;
#pragma unroll
                for (int bj = 0; bj < 2; ++bj) {
                    const f32x4 v0 = acc[ai][bj][m][0] * rs, v1 = acc[ai][bj][m][1] * rs;
                    u32x4 w; w.x = cvt_pk_bf16(v0[0], v0[1]); w.y = cvt_pk_bf16(v0[2], v0[3]); w.z = cvt_pk_bf16(v1[0], v1[1]); w.w = cvt_pk_bf16(v1[2], v1[3]);
                    *(u32x4*)(Z1 + (size_t)row * N1 + colb + bj * HALF) = w;
                    s1 += (v0[0] + v0[1]) + (v0[2] + v0[3]) + (v1[0] + v1[1]) + (v1[2] + v1[3]);
                    s2 += (v0[0] * v0[0] + v0[1] * v0[1]) + (v0[2] * v0[2] + v0[3] * v0[3]) + (v1[0] * v1[0] + v1[1] * v1[1]) + (v1[2] * v1[2] + v1[3] * v1[3]);
                }
                if (isv) {
                    s1 += __shfl_xor(s1, 16); s1 += __shfl_xor(s1, 32); s2 += __shfl_xor(s2, 16); s2 += __shfl_xor(s2, 32);
                    if (fq == 0) { atomicAdd(LNS + 2 * row, s1); atomicAdd(LNS + 2 * row + 1, s2); }
                }
            }
    }
};

struct EpiOut1 {
    static constexpr bool PERM = false, AFTER_DRAIN = false;
    float* OUT;
    __device__ __forceinline__ void operator()(const f32x4 (&acc)[2][2][4][2], const Unit& u, int wr, int wc, int fr, int fq) const {
        const int rowb = u.pm * BM + wr * 64 + fr, colb = u.pn * BM + wc * 32 + 4 * fq;
#pragma unroll
        for (int ai = 0; ai < 2; ++ai)
#pragma unroll
            for (int m = 0; m < 4; ++m) {
                const int row = rowb + ai * HALF + m * 16;
#pragma unroll
                for (int bj = 0; bj < 2; ++bj)
#pragma unroll
                    for (int n = 0; n < 2; ++n) {
                        float* p = OUT + (size_t)row * DM + colb + bj * HALF + n * 16;
                        *(f32x4*)p = *(const f32x4*)p + acc[ai][bj][m][n];
                    }
            }
    }
};

template <class Epi, class Sched, bool ALIGN_EPI = false, bool SP2 = false>
__device__ __forceinline__ void gemm_phase(PG8_LAS unsigned char* lds, const Gemm g, const Sched& S, const Epi& E) {
    const int tid = threadIdx.x, wid = __builtin_amdgcn_readfirstlane(tid >> 6), lane = tid & 63, wr = wid >> 2, wc = wid & 3, fr = lane & 15, fq = lane >> 4;
    const int K = g.K, nt = K / BK;
    unsigned voffA[2], voffB[2];
#pragma unroll
    for (int i = 0; i < 2; ++i) { int R, C; stage_rc(tid * 16 + i * 8192, R, C); const int Rb = Epi::PERM ? ((R & ~31) + perm32(R & 31)) : R;
        voffA[i] = (unsigned)(R * g.lda + C) * 2u; voffB[i] = (unsigned)(Rb * K + C) * 2u; }
    const size_t kstep = (size_t)(BK * 2);
    const size_t hstepA = (size_t)HALF * g.lda * 2, hstepB = (size_t)HALF * K * 2;
    const size_t tstepA = 2 * hstepA, tstepB = 2 * hstepB;
    const unsigned ldsw = (unsigned)wid * 1024u;
    const int aoff = lds_byte(wr * 64 + fr, fq * 8), boff = lds_byte(wc * 32 + fr, fq * 8);
#define PG8_SA(b, h) (((b) * 2 + (h)) * HTB)
#define PG8_SB(b, h) ((4 + (b) * 2 + (h)) * HTB)
#define PG8_STAGE(bufoff, gbase, voff) do { _Pragma("unroll") for (int _i = 0; _i < 2; ++_i) \
        __builtin_amdgcn_global_load_lds((const unsigned*)((const char*)(gbase) + (voff)[_i]), (PG8_LAS unsigned*)(lds + (bufoff) + ldsw + _i * 8192), 16, 0, 0); } while (0)
#define PG8_LDA(dst, b, h) do { _Pragma("unroll") for (int m = 0; m < 4; ++m) _Pragma("unroll") for (int k = 0; k < 2; ++k) dst[m][k] = *(const PG8_LAS bf16x8*)(lds + PG8_SA(b, h) + aoff + m * 2048 + k * 1024); } while (0)
#define PG8_LDB(dst, b, h) do { _Pragma("unroll") for (int n = 0; n < 2; ++n) _Pragma("unroll") for (int k = 0; k < 2; ++k) dst[n][k] = *(const PG8_LAS bf16x8*)(lds + PG8_SB(b, h) + boff + n * 2048 + k * 1024); } while (0)
#define PG8_MMA(ai, bj, At, Bt) do { __builtin_amdgcn_s_setprio(1); _Pragma("unroll") for (int m = 0; m < 4; ++m) _Pragma("unroll") for (int n = 0; n < 2; ++n) _Pragma("unroll") for (int k = 0; k < 2; ++k) \
        acc[ai][bj][m][n] = __builtin_amdgcn_mfma_f32_16x16x32_bf16(Bt[n][k], At[m][k], acc[ai][bj][m][n], 0, 0, 0); __builtin_amdgcn_s_setprio(0); } while (0)
#define PG8_WAIT_V(n) asm volatile("s_waitcnt vmcnt(" #n ")" ::: "memory")
#define PG8_WAIT_L(n) asm volatile("s_waitcnt lgkmcnt(" #n ")" ::: "memory")
#define PG8_BAR __builtin_amdgcn_s_barrier()
#define PG8_SCHED __builtin_amdgcn_sched_barrier(0)
    Unit cur, nxt; int ui = 0;
    if (!S.next(0, cur)) return;
    f32x4 acc[2][2][4][2];
#pragma unroll
    for (int a = 0; a < 2; ++a)
#pragma unroll
        for (int b = 0; b < 2; ++b)
#pragma unroll
            for (int m = 0; m < 4; ++m)
#pragma unroll
                for (int n = 0; n < 2; ++n) acc[a][b][m][n] = (f32x4){0.f, 0.f, 0.f, 0.f};
    bf16x8 At[4][2], B0[2][2], B1[2][2];
    const char* cA = (const char*)g.A + (size_t)cur.pm * tstepA; const char* cB = (const char*)g.Bt + (size_t)cur.pn * tstepB;
    S.a_ready(cur);
    if constexpr (SP2) {
        PG8_STAGE(PG8_SB(0, 0), cB, voffB); PG8_STAGE(PG8_SB(0, 1), cB + hstepB, voffB); PG8_STAGE(PG8_SA(0, 0), cA, voffA); PG8_STAGE(PG8_SA(0, 1), cA + hstepA, voffA);
        if (wr == 1) PG8_BAR;
        PG8_WAIT_V(2); PG8_BAR;
        PG8_STAGE(PG8_SB(1, 0), cB + kstep, voffB); PG8_STAGE(PG8_SA(1, 0), cA + kstep, voffA); PG8_STAGE(PG8_SB(1, 1), cB + hstepB + kstep, voffB);
        PG8_WAIT_V(6); PG8_BAR;
    } else {
        PG8_STAGE(PG8_SB(0, 0), cB, voffB); PG8_STAGE(PG8_SA(0, 0), cA, voffA); PG8_STAGE(PG8_SB(0, 1), cB + hstepB, voffB); PG8_STAGE(PG8_SA(0, 1), cA + hstepA, voffA);
        if (wr == 1) PG8_BAR;
        PG8_WAIT_V(4); PG8_BAR;
        PG8_STAGE(PG8_SB(1, 0), cB + kstep, voffB); PG8_STAGE(PG8_SA(1, 0), cA + kstep, voffA); PG8_STAGE(PG8_SB(1, 1), cB + hstepB + kstep, voffB);
        PG8_WAIT_V(6); PG8_BAR;
    }
    for (;;) {
        const bool has_next = S.next(ui + 1, nxt);
        const char* nA = has_next ? (const char*)g.A + (size_t)nxt.pm * tstepA : cA; const char* nB = has_next ? (const char*)g.Bt + (size_t)nxt.pn * tstepB : cB;
        for (int t = 0; t < nt; t += 2) {
            const bool last = (t == nt - 2);
            const char* a1 = cA + (size_t)(t + 1) * kstep;
            const char* a2 = last ? nA : cA + (size_t)(t + 2) * kstep; const char* b2 = last ? nB : cB + (size_t)(t + 2) * kstep;
            const char* a3 = a2 + kstep; const char* b3 = b2 + kstep;
            if (last && has_next) S.a_ready(nxt);
            if constexpr (SP2) {
            PG8_LDB(B0, 0, 0); PG8_LDB(B1, 0, 1); PG8_SCHED; PG8_LDA(At, 0, 0); PG8_STAGE(PG8_SA(1, 1), a1 + hstepA, voffA);
            PG8_WAIT_V(8); PG8_WAIT_L(0); PG8_BAR; PG8_MMA(0, 0, At, B0); PG8_MMA(0, 1, At, B1); PG8_BAR; PG8_SCHED;
            PG8_LDA(At, 0, 1); PG8_STAGE(PG8_SB(0, 0), b2, voffB); PG8_STAGE(PG8_SB(0, 1), b2 + hstepB, voffB); PG8_STAGE(PG8_SA(0, 0), a2, voffA);
            PG8_WAIT_V(8); PG8_WAIT_L(0); PG8_BAR; PG8_MMA(1, 0, At, B0); PG8_MMA(1, 1, At, B1); PG8_BAR; PG8_SCHED;
            PG8_LDB(B0, 1, 0); PG8_LDB(B1, 1, 1); PG8_SCHED; PG8_LDA(At, 1, 0); PG8_STAGE(PG8_SA(0, 1), a2 + hstepA, voffA);
            PG8_WAIT_V(8); PG8_WAIT_L(0); PG8_BAR; PG8_MMA(0, 0, At, B0); PG8_MMA(0, 1, At, B1); PG8_BAR; PG8_SCHED;
            PG8_LDA(At, 1, 1); PG8_STAGE(PG8_SB(1, 0), b3, voffB); PG8_STAGE(PG8_SB(1, 1), b3 + hstepB, voffB); PG8_STAGE(PG8_SA(1, 0), a3, voffA);
            PG8_WAIT_V(8); PG8_WAIT_L(0); PG8_BAR; PG8_MMA(1, 0, At, B0); PG8_MMA(1, 1, At, B1); PG8_BAR; PG8_SCHED;
            } else {
            PG8_LDB(B0, 0, 0); PG8_SCHED; PG8_LDA(At, 0, 0); PG8_STAGE(PG8_SA(1, 1), a1 + hstepA, voffA);
            PG8_WAIT_L(8); PG8_BAR; PG8_WAIT_L(0); PG8_MMA(0, 0, At, B0); PG8_BAR; PG8_SCHED;
            PG8_LDB(B1, 0, 1); PG8_STAGE(PG8_SB(0, 0), b2, voffB);
            PG8_BAR; PG8_WAIT_L(0); PG8_MMA(0, 1, At, B1); PG8_BAR;
            PG8_LDA(At, 0, 1); PG8_STAGE(PG8_SA(0, 0), a2, voffA);
            PG8_BAR; PG8_WAIT_L(0); PG8_MMA(1, 0, At, B0); PG8_BAR; PG8_SCHED;
            PG8_STAGE(PG8_SB(0, 1), b2 + hstepB, voffB);
            PG8_WAIT_V(6); PG8_BAR; PG8_MMA(1, 1, At, B1); PG8_BAR;
            PG8_LDB(B0, 1, 0); PG8_SCHED; PG8_LDA(At, 1, 0); PG8_STAGE(PG8_SA(0, 1), a2 + hstepA, voffA);
            PG8_WAIT_L(8); PG8_BAR; PG8_WAIT_L(0); PG8_MMA(0, 0, At, B0); PG8_BAR; PG8_SCHED;
            PG8_LDB(B1, 1, 1); PG8_STAGE(PG8_SB(1, 0), b3, voffB);
            PG8_BAR; PG8_WAIT_L(0); PG8_MMA(0, 1, At, B1); PG8_BAR;
            PG8_LDA(At, 1, 1); PG8_STAGE(PG8_SA(1, 0), a3, voffA);
            PG8_BAR; PG8_WAIT_L(0); PG8_MMA(1, 0, At, B0); PG8_BAR; PG8_SCHED;
            PG8_STAGE(PG8_SB(1, 1), b3 + hstepB, voffB);
            PG8_WAIT_V(6); PG8_BAR; PG8_MMA(1, 1, At, B1); PG8_BAR;
            }
        }
        if constexpr (ALIGN_EPI) { if (wr == 0) PG8_BAR; }
        if constexpr (!Epi::AFTER_DRAIN) { E(acc, cur, wr, wc, fr, fq); S.done(cur); }
        if (!has_next) break;
#pragma unroll
        for (int a = 0; a < 2; ++a)
#pragma unroll
            for (int b = 0; b < 2; ++b)
#pragma unroll
                for (int m = 0; m < 4; ++m)
#pragma unroll
                    for (int n = 0; n < 2; ++n) acc[a][b][m][n] = (f32x4){0.f, 0.f, 0.f, 0.f};
        cur = nxt; cA = nA; cB = nB; ++ui;
        if constexpr (ALIGN_EPI) { if (wr == 1) PG8_BAR; }
    }
    PG8_WAIT_V(0);
    if constexpr (!ALIGN_EPI) { if (wr == 0) PG8_BAR; }
    PG8_BAR;
    if constexpr (Epi::AFTER_DRAIN) { E.fused(acc, cur, wr, wc, fr, fq, lds, wid, lane); S.done(cur); }
#undef PG8_SA
#undef PG8_SB
#undef PG8_STAGE
#undef PG8_LDA
#undef PG8_LDB
#undef PG8_MMA
#undef PG8_WAIT_V
#undef PG8_WAIT_L
#undef PG8_BAR
#undef PG8_SCHED
}
}

template <int MODE>
__device__ __forceinline__ void p0_transpose_item(const float* W, int K, int Nsrc, int nblk, bf16_t* WT, const float* gvec, LAS float* scr, int item, int lane) {
    const int kb = item / nblk, nb = item % nblk, k0 = 64 * kb, n0 = 32 * nb;
    const int nd = n0 + (lane & 31);
    const int col = (MODE == 0) ? colmap0(nd) : nd;
#pragma unroll 8
    for (int i = 0; i < 32; ++i) { const int kk = 2 * i + (lane >> 5);
        float v = (col >= 0) ? W[(size_t)(k0 + kk) * Nsrc + col] : 0.f;
        if (MODE != 1) v *= gvec[k0 + kk];
        scr[kk * 33 + (lane & 31)] = v; }
    asm volatile("s_waitcnt lgkmcnt(0)" ::: "memory");
    const int c = lane & 7;
#pragma unroll
    for (int j = 0; j < 4; ++j) { const int n = (lane >> 3) + 8 * j; const LAS float* s = scr + (8 * c) * 33 + n;
        u32x4 o; o.x = pk2(s[0 * 33], s[1 * 33]); o.y = pk2(s[2 * 33], s[3 * 33]); o.z = pk2(s[4 * 33], s[5 * 33]); o.w = pk2(s[6 * 33], s[7 * 33]);
        *(u32x4*)(WT + (size_t)(n0 + n) * K + k0 + 8 * c) = o; }
    asm volatile("s_waitcnt lgkmcnt(0)" ::: "memory");
}

__device__ __forceinline__ void p0_prologue(const Args& a, LAS unsigned char* lds, int vcu, int G, int wave, int lane) {
    unsigned char* ws = a.ws;
    LAS float* scr = (LAS float*)(lds + wave * 16384);
    const int gw = vcu * NWAVES + wave, NGW = G * NWAVES;
    constexpr int I0 = (DM / 64) * (N0 / 32), IO = (MIXW / 64) * (DM / 32), I1 = (DM / 64) * (N1 / 32);
    constexpr int NITEMS = I0 + IO + I1 + IO;
    for (int it = gw; it < NITEMS; it += NGW) {
        int r = it;
        if (r < I0) { p0_transpose_item<0>(a.in[2], DM, N0_SRC, N0 / 32, (bf16_t*)(ws + WS_WT0), a.in[1], scr, r, lane); continue; } r -= I0;
        if (r < IO) { p0_transpose_item<1>(a.in[12], MIXW, DM, DM / 32, (bf16_t*)(ws + WS_WTO0), nullptr, scr, r, lane); continue; } r -= IO;
        if (r < I1) { p0_transpose_item<2>(a.in[14], DM, N1, N1 / 32, (bf16_t*)(ws + WS_WT1), a.in[13], scr, r, lane); continue; } r -= I1;
        p0_transpose_item<1>(a.in[19], MIXW, DM, DM / 32, (bf16_t*)(ws + WS_WTO1), nullptr, scr, r, lane);
    }
    for (int it = gw; it < 2 * (256 + 8); it += NGW) {
        const int kv = it / 264, r = it % 264;
        if (r < 256) p0_transpose_item<1>(a.in[kv ? 9 : 5], 4096, 128, 4, (bf16_t*)(ws + WS_W1T) + (size_t)kv * 128 * 4096, nullptr, scr, r, lane);
        else p0_transpose_item<1>(a.in[kv ? 11 : 7], 128, 128, 4, (bf16_t*)(ws + WS_W2T) + (size_t)kv * 128 * 128, nullptr, scr, r - 256, lane);
    }
    {
        const int gt0 = gw * 64 + lane, NGT0 = NGW * 64;
        bf16_t* SW = (bf16_t*)(ws + WS_SW); const float* wsp = a.in[17];
        for (int i = gt0; i < 16 * 128 * 128; i += NGT0) { const int s = i & 127, t = (i >> 7) & 127; SW[i] = (bf16_t)(s <= t ? f2bf(wsp[i]) : 0u); }
        float* PBP = (float*)(ws + WS_PBP);
        for (int i = gt0; i < 2 * 32 * 128; i += NGT0) { const int j = i & 127, ic = (i >> 7) & 31, kv = i >> 12;
            const float* pos = a.in[kv ? 8 : 4] + ic * 128; const float* w1 = a.in[kv ? 9 : 5] + (size_t)ic * 128 * 128 + j; float s = 0.f;
            for (int q = 0; q < 128; ++q) s += pos[q] * w1[(size_t)q * 128]; PBP[i] = s; }
    }
    const float* x = a.in[0]; bf16_t* XB = (bf16_t*)(ws + WS_XB); float* rstd0 = (float*)(ws + WS_RSTD0);
    for (int m = gw; m < MTOK; m += NGW) {
        const f32x4* xr = (const f32x4*)(x + (size_t)m * DM) + lane;
        u32x2* o8 = (u32x2*)(XB + (size_t)m * DM) + lane;
        float s = 0.f;
#pragma unroll
        for (int j = 0; j < 8; ++j) { const f32x4 v = xr[64 * j]; s += (v.x * v.x + v.y * v.y) + (v.z * v.z + v.w * v.w);
            u32x2 w; w.x = pk2(v.x, v.y); w.y = pk2(v.z, v.w); o8[64 * j] = w; }
        s = wave_sum(s);
        if (lane == 0) rstd0[m] = 1.0f / sqrtf(s * (1.0f / DM) + EPS);
    }
    const int gt = gw * 64 + lane, NGT = NGW * 64;
    float* SS1 = (float*)(ws + WS_SS1); float* LNS = (float*)(ws + WS_LNS);
    for (int i = gt; i < MTOK; i += NGT) { SS1[i] = 0.f; LNS[2 * i] = 0.f; LNS[2 * i + 1] = 0.f; }
    float* COS = (float*)(ws + WS_COS); float* SIN = (float*)(ws + WS_SIN);
    for (int i = gt; i < SEQ * 16; i += NGT) { const int t = i >> 4, f = i & 15;
        const float inv = powf(500000.0f, -((float)f * 2.0f) / 32.0f); const float ang = (float)t * inv;
        COS[i] = cosf(ang); SIN[i] = sinf(ang); }
}

__device__ __forceinline__ void p2_conv(const Args& a, int gt, int NGT) {
    bf16_t* ZC = (bf16_t*)(a.ws + WS_ZC); const float* cw = a.in[3];
    for (int idx = gt; idx < MTOK * 256; idx += NGT) {
        const int row = idx >> 8, c8 = (idx & 255) * 8, t = row & (SEQ - 1);
        bf16_t* base = ZC + (size_t)row * ZC_LD + c8;
        const u32x4 cb = *(const u32x4*)base, cg = *(const u32x4*)(base + 6144);
        const u32x4 cc0 = *(const u32x4*)(base + 2048), ch0 = *(const u32x4*)(base + 4096);
        u32x4 cc1 = {0, 0, 0, 0}, ch1 = {0, 0, 0, 0}, cc2 = {0, 0, 0, 0}, ch2 = {0, 0, 0, 0};
        if (t >= 1) { cc1 = *(const u32x4*)(base - ZC_LD + 2048); ch1 = *(const u32x4*)(base - ZC_LD + 4096); }
        if (t >= 2) { cc2 = *(const u32x4*)(base - 2 * ZC_LD + 2048); ch2 = *(const u32x4*)(base - 2 * ZC_LD + 4096); }
        float w0[8], w1[8], w2[8];
#pragma unroll
        for (int j = 0; j < 8; ++j) { w0[j] = cw[c8 + j]; w1[j] = cw[DM + c8 + j]; w2[j] = cw[2 * DM + c8 + j]; }
        u32x4 o;
#pragma unroll
        for (int q = 0; q < 4; ++q) {
            float r[2];
#pragma unroll
            for (int hh = 0; hh < 2; ++hh) {
                const int j = 2 * q + hh;
                const float p0 = hh ? bf_hi(cc0[q]) * bf_hi(ch0[q]) : bf_lo(cc0[q]) * bf_lo(ch0[q]);
                const float p1 = hh ? bf_hi(cc1[q]) * bf_hi(ch1[q]) : bf_lo(cc1[q]) * bf_lo(ch1[q]);
                const float p2 = hh ? bf_hi(cc2[q]) * bf_hi(ch2[q]) : bf_lo(cc2[q]) * bf_lo(ch2[q]);
                const float conv = w0[j] * p2 + w1[j] * p1 + w2[j] * p0;
                const float b = hh ? bf_hi(cb[q]) : bf_lo(cb[q]); const float g = hh ? bf_hi(cg[q]) : bf_lo(cg[q]);
                r[hh] = b * conv * silu_f(g);
            }
            o[q] = pk2(r[0], r[1]);
        }
        *(u32x4*)base = o;
    }
}

__device__ __forceinline__ void p2_compress(const Args& a, LAS unsigned char* lds, int blk, int G, int tid) {
    LAS float* tok = (LAS float*)lds;
    LAS float* pos = (LAS float*)(lds + 73728);
    LAS float* red = (LAS float*)(lds + 73728 + 16384);
    LAS float* hid = (LAS float*)(lds + 73728 + 32768);
    const int j = tid & 127, iq = tid >> 7;
    for (int unit = blk; unit < 2 * 16 * 16; unit += G) {
        const int kv = unit >> 8, bg = (unit >> 4) & 15, cg8 = unit & 15;
        const bf16_t* src = (const bf16_t*)(a.ws + WS_KV) + (size_t)kv * KV_ELEMS + ((size_t)bg * SEQ + 128 * cg8) * HD;
        const float* posg = a.in[kv ? 8 : 4]; const float* w1 = a.in[kv ? 9 : 5]; const float* b1 = a.in[kv ? 10 : 6]; const float* w2 = a.in[kv ? 11 : 7];
        const int ntok = (cg8 == 15) ? 128 : 144;
        __syncthreads();
        for (int i = tid; i < ntok * 128; i += NTHREADS) tok[i] = bf2f(src[i]);
        for (int i = tid; i < 4096; i += NTHREADS) pos[i] = posg[i];
        __syncthreads();
        float acc[8];
#pragma unroll
        for (int cc = 0; cc < 8; ++cc) acc[cc] = 0.f;
        const int ncc = (cg8 == 15) ? 7 : 8;
        for (int i = iq * 1024; i < iq * 1024 + 1024; ++i) {
            const float w = w1[(size_t)i * 128 + j]; const float p = pos[i];
#pragma unroll
            for (int cc = 0; cc < 8; ++cc) if (cc < ncc) acc[cc] += (tok[cc * 2048 + i] + p) * w;
        }
#pragma unroll
        for (int cc = 0; cc < 8; ++cc) red[(iq * 8 + cc) * 128 + j] = acc[cc];
        __syncthreads();
        for (int i = tid; i < 8 * 128; i += NTHREADS) { const int jj = i & 127;
            const float h = red[i] + red[1024 + i] + red[2048 + i] + red[3072 + i] + b1[jj]; hid[i] = silu_f(h); }
        __syncthreads();
        bf16_t* dst = (bf16_t*)(a.ws + (kv ? WS_VC : WS_KC)) + (size_t)bg * 128 * 128;
        for (int o = tid; o < 8 * 128; o += NTHREADS) { const int cc = o >> 7, d = o & 127;
            if (cc >= ncc) { if (cg8 == 15 && cc == 7) dst[(size_t)127 * 128 + d] = 0; }
            else { float s = 0.f;
                for (int jj = 0; jj < 128; ++jj) s += hid[cc * 128 + jj] * w2[jj * 128 + d];
                dst[(size_t)(8 * cg8 + cc) * 128 + d] = (bf16_t)f2bf(s); } }
    }
    __syncthreads();
}

__device__ __forceinline__ void attn_batch(const bf16_t* Kb, const bf16_t* Vb, int first, int lo, int hi, bool valid, const LAS float* qs,
                                           float (&m)[4], float (&l)[4], float (&o)[4][2], int lane) {
    int kr = first + lane; kr = kr < lo ? lo : (kr > hi ? hi : kr);
    const u32x4* kp = (const u32x4*)(Kb + (size_t)kr * HD);
    float s[4] = {0.f, 0.f, 0.f, 0.f};
#pragma unroll 4
    for (int c = 0; c < 16; ++c) { const u32x4 kv = kp[c];
        float kf[8]; kf[0] = bf_lo(kv.x); kf[1] = bf_hi(kv.x); kf[2] = bf_lo(kv.y); kf[3] = bf_hi(kv.y); kf[4] = bf_lo(kv.z); kf[5] = bf_hi(kv.z); kf[6] = bf_lo(kv.w); kf[7] = bf_hi(kv.w);
#pragma unroll
        for (int h = 0; h < 4; ++h) { const LAS f32x4* q4 = (const LAS f32x4*)(qs + h * HD + c * 8); const f32x4 qa = q4[0], qb = q4[1];
            s[h] += (qa[0] * kf[0] + qa[1] * kf[1]) + (qa[2] * kf[2] + qa[3] * kf[3]) + (qb[0] * kf[4] + qb[1] * kf[5]) + (qb[2] * kf[6] + qb[3] * kf[7]); }
    }
    float ps[4];
#pragma unroll
    for (int h = 0; h < 4; ++h) {
        const float sv = valid ? s[h] : -INFINITY;
        const float bm = wave_max(sv); const float mn = fmaxf(m[h], bm);
        float p = 0.f, alpha = 1.f;
        if (mn > -INFINITY) { p = valid ? __expf(sv - mn) : 0.f; alpha = (m[h] > -INFINITY) ? __expf(m[h] - mn) : 0.f; }
        l[h] = l[h] * alpha + wave_sum(p); o[h][0] *= alpha; o[h][1] *= alpha; m[h] = mn; ps[h] = p;
    }
    for (int jj = 0; jj < 64; ++jj) {
        int vr = first + jj; vr = vr < lo ? lo : (vr > hi ? hi : vr);
        const unsigned vv = *(const unsigned*)(Vb + (size_t)vr * HD + 2 * lane);
        const float v0 = bf_lo(vv), v1 = bf_hi(vv);
#pragma unroll
        for (int h = 0; h < 4; ++h) { const float pj = __shfl(ps[h], jj); o[h][0] += pj * v0; o[h][1] += pj * v1; }
    }
}

__device__ __forceinline__ void p3_nsa_naive(const Args& a, LAS unsigned char* lds, int gw, int NGW, int wave, int lane) {
    unsigned char* ws = a.ws;
    LAS float* qs = (LAS float*)(lds + wave * 8192);
    LAS float* qr = qs + 512;
    LAS float* Pc = qr + 512;
    const bf16_t* Q = (const bf16_t*)(ws + WS_Q); const bf16_t* KVb = (const bf16_t*)(ws + WS_KV);
    const bf16_t* KC = (const bf16_t*)(ws + WS_KC); const bf16_t* VC = (const bf16_t*)(ws + WS_VC);
    const float* GL = (const float*)(ws + WS_GL); const bf16_t* NG = (const bf16_t*)(ws + WS_NG);
    const float* COS = (const float*)(ws + WS_COS); const float* SIN = (const float*)(ws + WS_SIN);
    bf16_t* ZC = (bf16_t*)(ws + WS_ZC);
    const float scale = 0.08838834764831845f;
    for (int task = gw; task < NB * NKV * SEQ; task += NGW) {
        const int t = task & (SEQ - 1), bg = task >> 11, b = bg >> 2, g = bg & 3;
        const int row = b * SEQ + t;
        { const u32x4 qv = *(const u32x4*)(Q + (size_t)row * DM + g * 512 + lane * 8);
          float f[8]; f[0] = bf_lo(qv.x); f[1] = bf_hi(qv.x); f[2] = bf_lo(qv.y); f[3] = bf_hi(qv.y); f[4] = bf_lo(qv.z); f[5] = bf_hi(qv.z); f[6] = bf_lo(qv.w); f[7] = bf_hi(qv.w);
#pragma unroll
          for (int j = 0; j < 8; ++j) { qs[lane * 8 + j] = f[j] * scale; qr[lane * 8 + j] = f[j] * scale; } }
        asm volatile("s_waitcnt lgkmcnt(0)" ::: "memory");
        { const int h = lane >> 4, i = lane & 15; const float x1 = qs[h * HD + i], x2 = qs[h * HD + 16 + i]; const float c = COS[t * 16 + i], s = SIN[t * 16 + i];
          qr[h * HD + i] = x1 * c - x2 * s; qr[h * HD + 16 + i] = x2 * c + x1 * s; }
        asm volatile("s_waitcnt lgkmcnt(0)" ::: "memory");
        float oc[4][2], Pl0 = 0.f, Pl1 = 0.f;
        {
            const bf16_t* Kc = KC + (size_t)bg * 128 * 128; const bf16_t* Vc = VC + (size_t)bg * 128 * 128;
            const int c0 = lane, c1 = 64 + lane;
            const bool v0 = (16 * c0 + 31 <= t), v1 = (c1 < NCMP) && (16 * c1 + 31 <= t);
            const int r1 = c1 < NCMP ? c1 : NCMP - 1;
            float s0[4] = {0.f, 0.f, 0.f, 0.f}, s1[4] = {0.f, 0.f, 0.f, 0.f};
            const u32x4* k0p = (const u32x4*)(Kc + (size_t)c0 * HD); const u32x4* k1p = (const u32x4*)(Kc + (size_t)r1 * HD);
#pragma unroll 2
            for (int c = 0; c < 16; ++c) { const u32x4 ka = k0p[c], kb = k1p[c];
                float fa[8], fb[8];
                fa[0] = bf_lo(ka.x); fa[1] = bf_hi(ka.x); fa[2] = bf_lo(ka.y); fa[3] = bf_hi(ka.y); fa[4] = bf_lo(ka.z); fa[5] = bf_hi(ka.z); fa[6] = bf_lo(ka.w); fa[7] = bf_hi(ka.w);
                fb[0] = bf_lo(kb.x); fb[1] = bf_hi(kb.x); fb[2] = bf_lo(kb.y); fb[3] = bf_hi(kb.y); fb[4] = bf_lo(kb.z); fb[5] = bf_hi(kb.z); fb[6] = bf_lo(kb.w); fb[7] = bf_hi(kb.w);
#pragma unroll
                for (int h = 0; h < 4; ++h)
#pragma unroll
                    for (int jj = 0; jj < 8; ++jj) { const float qv = qs[h * HD + c * 8 + jj]; s0[h] += qv * fa[jj]; s1[h] += qv * fb[jj]; } }
            float p0[4], p1[4];
#pragma unroll
            for (int h = 0; h < 4; ++h) {
                const float a0 = v0 ? s0[h] : -INFINITY, a1 = v1 ? s1[h] : -INFINITY;
                const float mx = wave_max(fmaxf(a0, a1));
                float e0 = 0.f, e1 = 0.f;
                if (mx > -INFINITY) { e0 = v0 ? __expf(a0 - mx) : 0.f; e1 = v1 ? __expf(a1 - mx) : 0.f; }
                const float den = wave_sum(e0 + e1); const float inv = den > 0.f ? 1.0f / den : 1.0f;
                p0[h] = e0 * inv; p1[h] = e1 * inv; Pl0 += p0[h]; Pl1 += p1[h];
                oc[h][0] = 0.f; oc[h][1] = 0.f;
            }
            for (int jj = 0; jj < 64; ++jj) {
                const unsigned va = *(const unsigned*)(Vc + (size_t)jj * HD + 2 * lane);
                const int rr = (64 + jj) < NCMP ? (64 + jj) : NCMP - 1;
                const unsigned vb = *(const unsigned*)(Vc + (size_t)rr * HD + 2 * lane);
#pragma unroll
                for (int h = 0; h < 4; ++h) { const float pa = __shfl(p0[h], jj), pb = __shfl(p1[h], jj);
                    oc[h][0] += pa * bf_lo(va) + pb * bf_lo(vb); oc[h][1] += pa * bf_hi(va) + pb * bf_hi(vb); }
            }
            Pc[lane] = Pl0; Pc[64 + lane] = Pl1;
        }
        asm volatile("s_waitcnt lgkmcnt(0)" ::: "memory");
        unsigned selmask = 0u;
        {
            const int cur = t >> 6;
            float val = -INFINITY;
            if (lane < 32) {
                if (lane == 0 || lane == cur) val = INFINITY;
                else if (64 * lane <= t) { float s = 0.f;
                    for (int c = 4 * lane - 1; c <= 4 * lane + 3; ++c) if (c >= 0 && c < NCMP) s += Pc[c];
                    val = s; }
            }
            bool taken = (lane >= 32);
            for (int r = 0; r < 8; ++r) {
                const float cand = taken ? -INFINITY : val;
                const float mx = wave_max(cand);
                if (!(mx > -INFINITY)) break;
                const unsigned long long bal = __ballot(!taken && cand == mx);
                const int idx = __ffsll((long long)bal) - 1;
                selmask |= 1u << idx;
                if (lane == idx) taken = true;
            }
        }
        float os[4][2], ms[4], ls[4];
#pragma unroll
        for (int h = 0; h < 4; ++h) { os[h][0] = 0.f; os[h][1] = 0.f; ms[h] = -INFINITY; ls[h] = 0.f; }
        {
            const bf16_t* Ks = KVb + 2 * KV_ELEMS + (size_t)bg * SEQ * HD; const bf16_t* Vs = KVb + 3 * KV_ELEMS + (size_t)bg * SEQ * HD;
            unsigned mk = selmask;
            while (mk) { const int jb = __ffs((int)mk) - 1; mk &= mk - 1;
                attn_batch(Ks, Vs, 64 * jb, 0, SEQ - 1, (64 * jb + lane) <= t, qr, ms, ls, os, lane); }
        }
        float ow[4][2], mw[4], lw[4];
#pragma unroll
        for (int h = 0; h < 4; ++h) { ow[h][0] = 0.f; ow[h][1] = 0.f; mw[h] = -INFINITY; lw[h] = 0.f; }
        {
            const bf16_t* Kw = KVb + 4 * KV_ELEMS + (size_t)bg * SEQ * HD; const bf16_t* Vw = KVb + 5 * KV_ELEMS + (size_t)bg * SEQ * HD;
            const int first = t - 511;
            for (int b8 = 0; b8 < 8; ++b8) { const int f0 = first + 64 * b8;
                if (f0 + 63 < 0) continue;
                attn_batch(Kw, Vw, f0, 0, SEQ - 1, (f0 + lane) >= 0, qr, mw, lw, ow, lane); }
        }
#pragma unroll
        for (int h = 0; h < 4; ++h) {
            const int hh = g * 4 + h;
            const float g0 = sigmoid_f(GL[(size_t)row * 48 + hh]), g1 = sigmoid_f(GL[(size_t)row * 48 + 16 + hh]), g2 = sigmoid_f(GL[(size_t)row * 48 + 32 + hh]);
            const float is = ls[h] > 0.f ? 1.0f / ls[h] : 0.f, iw = lw[h] > 0.f ? 1.0f / lw[h] : 0.f;
            const unsigned ngv = *(const unsigned*)(NG + (size_t)row * DM + hh * HD + 2 * lane);
            const float y0 = (g0 * oc[h][0] + g1 * os[h][0] * is + g2 * ow[h][0] * iw) * silu_f(bf_lo(ngv));
            const float y1 = (g0 * oc[h][1] + g1 * os[h][1] * is + g2 * ow[h][1] * iw) * silu_f(bf_hi(ngv));
            *(unsigned*)(ZC + (size_t)row * ZC_LD + 2048 + hh * HD + 2 * lane) = pk2(y0, y1);
        }
    }
}


namespace nsa {
typedef float f32x16 __attribute__((ext_vector_type(16)));
typedef short s16x4 __attribute__((ext_vector_type(4)));
constexpr int KVBLK = 64, SHM = 16384;
constexpr float SCALE = 0.08838834764831845f, THR = 8.f;
constexpr int L_V = 0, L_K = 32768, L_WS = 65536, L_SEL = 67584, L_UNI = 67840, L_GS = 68608, L_LS = L_GS + 33792, L_IMP = L_LS + 33792, L_END = L_IMP + 8448;
static_assert(L_END <= LDS_BYTES, "nsa lds");
#define KSWZ(row, colB) ((row) * 256 + ((colB) ^ (((row) & 7) << 4)))
#define SBAR() __builtin_amdgcn_sched_barrier(0)
__device__ __forceinline__ int v_st(int k, int c) { const int kk = (k & ~0xC) | ((k & 4) << 1) | ((k & 8) >> 1); return ((kk >> 3) * 4 + (c >> 5)) * 512 + ((kk & 7) * 32 + (c & 31)) * 2; }
__device__ __forceinline__ int v_rd_base(int lane) { return ((lane & 3) << 3) | (((lane >> 2) & 3) << 6) | (((lane >> 4) & 1) << 5) | (((lane >> 5) & 1) << 8); }
constexpr int v_rd_off(int d0, int ks, int half) { return d0 * 512 + ks * 4096 + half * 2048; }
__device__ __forceinline__ int crow(int r, int hi) { return (r & 3) + 8 * (r >> 2) + 4 * hi; }
__device__ __forceinline__ bf16x8 pack8(f32x4 a, f32x4 b) {
    u32x4 w = {cvt_pk_bf16(a[0], a[1]), cvt_pk_bf16(a[2], a[3]), cvt_pk_bf16(b[0], b[1]), cvt_pk_bf16(b[2], b[3])};
    return *reinterpret_cast<bf16x8*>(&w);
}
__device__ __forceinline__ void mask_tile(f32x16& p0, f32x16& p1, int dq, unsigned W) {
    const float NEG = -__builtin_inff();
#pragma unroll
    for (int r = 0; r < 16; ++r) {
        const int c = (r & 3) + 8 * (r >> 2);
        if ((unsigned)(dq - c) >= W) p0[r] = NEG;
        if ((unsigned)(dq - c - 32) >= W) p1[r] = NEG;
    }
}
__device__ __forceinline__ void mask_all(f32x16& p0, f32x16& p1) {
    const float NEG = -__builtin_inff();
#pragma unroll
    for (int r = 0; r < 16; ++r) { p0[r] = NEG; p1[r] = NEG; }
}
__device__ __forceinline__ void partialSM(f32x16& p0, f32x16& p1, float& m_reg, float& mn, float& alpha) {
    float pmax = p0[0];
#pragma unroll
    for (int r = 1; r < 16; ++r) pmax = fmaxf(pmax, p0[r]);
#pragma unroll
    for (int r = 0; r < 16; ++r) pmax = fmaxf(pmax, p1[r]);
    { auto rr = __builtin_amdgcn_permlane32_swap(__float_as_uint(pmax), __float_as_uint(pmax), false, false);
      pmax = fmaxf(__uint_as_float(rr[0]), __uint_as_float(rr[1])); }
    constexpr float C2 = 1.4426950408889634f * SCALE;
    if (__builtin_expect(__all((pmax - m_reg) * SCALE <= THR), 1)) { mn = m_reg; alpha = 1.f; }
    else { mn = fmaxf(m_reg, pmax); alpha = __builtin_amdgcn_exp2f((m_reg - mn) * C2); m_reg = mn; }
    const float mnL = -mn * C2;
#pragma unroll
    for (int r = 0; r < 16; ++r) p0[r] = fmaf(p0[r], C2, mnL);
#pragma unroll
    for (int r = 0; r < 16; ++r) p1[r] = fmaf(p1[r], C2, mnL);
#pragma unroll
    for (int r = 0; r < 16; ++r) p0[r] = __builtin_amdgcn_exp2f(p0[r]);
}
#define NSA_PK4(P, B_, OUT) do { unsigned a0 = cvt_pk_bf16(P[B_+0], P[B_+1]), a1 = cvt_pk_bf16(P[B_+2], P[B_+3]);                 \
        unsigned b0 = cvt_pk_bf16(P[B_+4], P[B_+5]), b1 = cvt_pk_bf16(P[B_+6], P[B_+7]);                                         \
        auto r0 = __builtin_amdgcn_permlane32_swap(a0, b0, false, false); auto r1 = __builtin_amdgcn_permlane32_swap(a1, b1, false, false); \
        u32x4 w = {r0[0], r1[0], r0[1], r1[1]}; OUT = *reinterpret_cast<bf16x8*>(&w); } while (0)
__device__ __forceinline__ void pack_p(const f32x16& p0, const f32x16& p1, bf16x8& pa0, bf16x8& pa1, bf16x8& pa2, bf16x8& pa3) {
    NSA_PK4(p0, 0, pa0); NSA_PK4(p0, 8, pa1); NSA_PK4(p1, 0, pa2); NSA_PK4(p1, 8, pa3);
}
__device__ __forceinline__ void finishSM(f32x16& p0, f32x16& p1, float alpha, float& l_reg, bf16x8& pa0, bf16x8& pa1, bf16x8& pa2, bf16x8& pa3) {
#pragma unroll
    for (int r = 0; r < 16; ++r) p1[r] = __builtin_amdgcn_exp2f(p1[r]);
    float ps = 0;
#pragma unroll
    for (int r = 0; r < 16; ++r) ps += p0[r];
#pragma unroll
    for (int r = 0; r < 16; ++r) ps += p1[r];
    { auto rr = __builtin_amdgcn_permlane32_swap(__float_as_uint(ps), __float_as_uint(ps), false, false);
      ps = __uint_as_float(rr[0]) + __uint_as_float(rr[1]); }
    l_reg = l_reg * alpha + ps;
    pack_p(p0, p1, pa0, pa1, pa2, pa3);
}
template <int KB>
__device__ __forceinline__ void qkt(f32x16& p0, f32x16& p1, const LAS unsigned char* lds, int r32, int hi, const bf16x8* qr) {
    p0 = f32x16{}; p1 = f32x16{};
    const LAS unsigned char* kb[4];
#pragma unroll
    for (int dd = 0; dd < 4; ++dd) kb[dd] = lds + L_K + KB * SHM + KSWZ(r32, (dd * 16 + hi * 8) * 2);
#pragma unroll
    for (int d0 = 0; d0 < 8; ++d0) { const LAS unsigned char* a = kb[d0 & 3] + (d0 >> 2) * 128;
        const bf16x8 b0 = *reinterpret_cast<const LAS bf16x8*>(a);
        const bf16x8 b1 = *reinterpret_cast<const LAS bf16x8*>(a + 32 * 256);
        p0 = __builtin_amdgcn_mfma_f32_32x32x16_bf16(b0, qr[d0], p0, 0, 0, 0);
        p1 = __builtin_amdgcn_mfma_f32_32x32x16_bf16(b1, qr[d0], p1, 0, 0, 0); }
}
template <int VB>
__device__ __forceinline__ void pv_tile(f32x16* o, int vb0, bf16x8 pa0, bf16x8 pa1, bf16x8 pa2, bf16x8 pa3) {
#define TRRD(dst, off) asm volatile("ds_read_b64_tr_b16 %0, %1 offset:%2" : "=&v"(dst) : "v"(vb0), "i"(off) : "memory")
#define PV_D0(d0) do { s16x4 l0, l1, l2, l3, h0, h1, h2, h3; constexpr int b_ = L_V + VB * SHM + v_rd_off(d0, 0, 0); \
        TRRD(l0, b_); TRRD(h0, b_ + 2048); TRRD(l1, b_ + 4096); TRRD(h1, b_ + 6144); TRRD(l2, b_ + 8192); TRRD(h2, b_ + 10240); TRRD(l3, b_ + 12288); TRRD(h3, b_ + 14336); \
        asm volatile("s_waitcnt lgkmcnt(0)" ::: "memory"); SBAR();   \
        o[d0] = __builtin_amdgcn_mfma_f32_32x32x16_bf16(pa0, (bf16x8){l0[0], l0[1], l0[2], l0[3], h0[0], h0[1], h0[2], h0[3]}, o[d0], 0, 0, 0);   \
        o[d0] = __builtin_amdgcn_mfma_f32_32x32x16_bf16(pa1, (bf16x8){l1[0], l1[1], l1[2], l1[3], h1[0], h1[1], h1[2], h1[3]}, o[d0], 0, 0, 0);   \
        o[d0] = __builtin_amdgcn_mfma_f32_32x32x16_bf16(pa2, (bf16x8){l2[0], l2[1], l2[2], l2[3], h2[0], h2[1], h2[2], h2[3]}, o[d0], 0, 0, 0);   \
        o[d0] = __builtin_amdgcn_mfma_f32_32x32x16_bf16(pa3, (bf16x8){l3[0], l3[1], l3[2], l3[3], h3[0], h3[1], h3[2], h3[3]}, o[d0], 0, 0, 0); } while (0)
    PV_D0(0); PV_D0(1); PV_D0(2); PV_D0(3);
#undef PV_D0
#undef TRRD
}

struct Ctx {
    LAS unsigned char* lds; int tid, wid, lane, r32, hi, sr, sc, vst0, vst1, kws, vb0;
    LAS float* li_l; LAS float* al_l;
};
__device__ __forceinline__ Ctx make_ctx(LAS unsigned char* lds) {
    Ctx c; c.lds = lds; c.tid = threadIdx.x; asm volatile("" : "+v"(c.tid));
    c.wid = __builtin_amdgcn_readfirstlane(c.tid >> 6); c.lane = c.tid & 63; c.r32 = c.lane & 31; c.hi = c.lane >> 5;
    c.sr = c.tid >> 4; c.sc = (c.tid & 15) * 8; c.vst0 = v_st(c.sr, c.sc); c.vst1 = v_st(32 + c.sr, c.sc); c.kws = KSWZ(c.sr, c.sc * 2);
    c.vb0 = (int)(unsigned)(uintptr_t)lds + v_rd_base(c.lane);
    LAS float* wsf = (LAS float*)(lds + L_WS) + c.wid * 64; c.li_l = wsf; c.al_l = wsf + 32;
    return c;
}
struct Stage { bf16x8 k0, k1, v0, v1; };
__device__ __forceinline__ void sload(Stage& S, const bf16_t* Kh, const bf16_t* Vh, int k0, const Ctx& c) {
    S.v0 = *(const bf16x8*)(Vh + (size_t)(k0 + c.sr) * HD + c.sc); S.v1 = *(const bf16x8*)(Vh + (size_t)(k0 + 32 + c.sr) * HD + c.sc);
    S.k0 = *(const bf16x8*)(Kh + (size_t)(k0 + c.sr) * HD + c.sc); S.k1 = *(const bf16x8*)(Kh + (size_t)(k0 + 32 + c.sr) * HD + c.sc);
}
__device__ __forceinline__ void swrite(const Stage& S, int bf, const Ctx& c) {
    *(LAS bf16x8*)(c.lds + L_V + bf * SHM + c.vst0) = S.v0; *(LAS bf16x8*)(c.lds + L_V + bf * SHM + c.vst1) = S.v1;
    *(LAS bf16x8*)(c.lds + L_K + bf * SHM + c.kws) = S.k0; *(LAS bf16x8*)(c.lds + L_K + bf * SHM + c.kws + 32 * 256) = S.k1;
}
__device__ __forceinline__ void rescale_rows(f32x16 (&o)[4], float a, const Ctx& c) {
    if (c.hi == 0) c.al_l[c.r32] = a;
    asm volatile("s_waitcnt lgkmcnt(0)" ::: "memory");
    float s[16];
#pragma unroll
    for (int r = 0; r < 16; ++r) s[r] = c.al_l[crow(r, c.hi)];
#pragma unroll
    for (int d = 0; d < 4; ++d)
#pragma unroll
        for (int r = 0; r < 16; ++r) o[d][r] *= s[r];
    asm volatile("s_waitcnt lgkmcnt(0)" ::: "memory");
}
template <int BUF, int MK>
__device__ __forceinline__ void tile_step(f32x16 (&o)[4], float& m_reg, float& l_reg, const bf16x8* qf, const Ctx& c, int j, int tpos, unsigned sel, int jcur) {
    f32x16 p0, p1; float mn, alpha; bf16x8 pa0, pa1, pa2, pa3;
    if (MK == 1) { const bool act = __any((sel >> j) & 1u); if (!act) return; }
    qkt<BUF>(p0, p1, c.lds, c.r32, c.hi, qf);
    const int dq = tpos - KVBLK * j - 4 * c.hi;
    if (MK == 0) { if (j == jcur || j == jcur - 8) mask_tile(p0, p1, dq, 512u); }
    else { if (j == jcur) mask_tile(p0, p1, dq, 0x7fffffffu);
        const bool on = (sel >> j) & 1u; const float NEG = -__builtin_inff();
#pragma unroll
        for (int r = 0; r < 16; ++r) { p0[r] = on ? p0[r] : NEG; p1[r] = on ? p1[r] : NEG; } }
    partialSM(p0, p1, m_reg, mn, alpha);
    if (__any(alpha < 1.f)) rescale_rows(o, alpha, c);
    finishSM(p0, p1, alpha, l_reg, pa0, pa1, pa2, pa3); SBAR();
    pv_tile<BUF>(o, c.vb0, pa0, pa1, pa2, pa3);
}
template <int MK>
__device__ __forceinline__ void run_tiles(f32x16 (&o)[4], float& m_reg, float& l_reg, const bf16x8* qf, const Ctx& c, const bf16_t* Kh, const bf16_t* Vh,
                                          unsigned tiles, int tpos, unsigned sel, int jcur) {
    Stage S;
    int j = __ffs((int)tiles) - 1; tiles &= tiles - 1;
    sload(S, Kh, Vh, KVBLK * j, c); swrite(S, 0, c);
    __syncthreads();
    for (;;) {
        int jn = tiles ? __ffs((int)tiles) - 1 : -1; tiles &= tiles - 1;
        if (jn >= 0) sload(S, Kh, Vh, KVBLK * jn, c);
        tile_step<0, MK>(o, m_reg, l_reg, qf, c, j, tpos, sel, jcur);
        if (jn >= 0) swrite(S, 1, c);
        __syncthreads();
        if (jn < 0) break;
        j = jn; jn = tiles ? __ffs((int)tiles) - 1 : -1; tiles &= tiles - 1;
        if (jn >= 0) sload(S, Kh, Vh, KVBLK * jn, c);
        tile_step<1, MK>(o, m_reg, l_reg, qf, c, j, tpos, sel, jcur);
        if (jn >= 0) swrite(S, 0, c);
        __syncthreads();
        if (jn < 0) break;
        j = jn;
    }
}
__device__ __forceinline__ void load_q(bf16x8 (&qf)[8], const bf16_t* Q, int row, int h, int hi) {
    const bf16_t* qp = Q + (size_t)row * DM + h * HD + hi * 8;
#pragma unroll
    for (int d0 = 0; d0 < 8; ++d0) qf[d0] = *(const bf16x8*)(qp + d0 * 16);
}
__device__ __forceinline__ void rotate_q(bf16x8& q0, bf16x8& q1, const float* COS, const float* SIN, int t, int hi) {
    const f32x4 c0 = *(const f32x4*)(COS + t * 16 + hi * 8), c1 = *(const f32x4*)(COS + t * 16 + hi * 8 + 4);
    const f32x4 s0 = *(const f32x4*)(SIN + t * 16 + hi * 8), s1 = *(const f32x4*)(SIN + t * 16 + hi * 8 + 4);
    f32x4 a0, a1, b0, b1;
#pragma unroll
    for (int jj = 0; jj < 4; ++jj) { a0[jj] = bf2f((bf16_t)q0[jj]); a1[jj] = bf2f((bf16_t)q0[4 + jj]); b0[jj] = bf2f((bf16_t)q1[jj]); b1[jj] = bf2f((bf16_t)q1[4 + jj]); }
    q0 = pack8(a0 * c0 - b0 * s0, a1 * c1 - b1 * s1);
    q1 = pack8(b0 * c0 + a0 * s0, b1 * c1 + a1 * s1);
}

__device__ __forceinline__ void window_unit(const Args& a, LAS unsigned char* lds, int bg, int qb) {
    unsigned char* ws = a.ws;
    const Ctx c = make_ctx(lds);
    const int n = c.wid >> 1, th = c.wid & 1, tq = 32 * th + c.r32, t = 64 * qb + tq, b = bg >> 2, g = bg & 3, h = g * 4 + n, row = b * SEQ + t;
    bf16x8 qf[8];
    load_q(qf, (const bf16_t*)(ws + WS_Q), row, h, c.hi);
    rotate_q(qf[0], qf[1], (const float*)(ws + WS_COS), (const float*)(ws + WS_SIN), t, c.hi);
    const bf16_t* Kh = (const bf16_t*)(ws + WS_KV) + 4 * KV_ELEMS + (size_t)bg * SEQ * HD; const bf16_t* Vh = (const bf16_t*)(ws + WS_KV) + 5 * KV_ELEMS + (size_t)bg * SEQ * HD;
    f32x16 o[4] = {}; float m_reg = -1e30f, l_reg = 0.f;
    const int jlo = qb >= 8 ? qb - 8 : 0;
    const unsigned tiles = (qb == 31 ? 0xffffffffu : ((1u << (qb + 1)) - 1u)) & ~((1u << jlo) - 1u);
    run_tiles<0>(o, m_reg, l_reg, qf, c, Kh, Vh, tiles, t, 0u, qb);
    const float g2 = sigmoid_f(((const float*)(ws + WS_GL))[(size_t)row * 48 + 32 + h]);
    rescale_rows(o, l_reg > 0.f ? g2 / l_reg : 0.f, c);
    bf16_t* OW = (bf16_t*)(ws + WS_XB);
    const int rbase = b * SEQ + 64 * qb + 32 * th;
#pragma unroll
    for (int r = 0; r < 16; ++r) { const int orow = rbase + crow(r, c.hi);
#pragma unroll
        for (int d0 = 0; d0 < 4; ++d0) { const float v = o[d0][r]; const float vn = __shfl_xor(v, 1);
            if ((c.r32 & 1) == 0) *(unsigned*)(OW + (size_t)orow * DM + h * HD + d0 * 32 + c.r32) = cvt_pk_bf16(v, vn); } }
}

__device__ __forceinline__ void cmpsel_unit(const Args& a, LAS unsigned char* lds, int bg, int qb) {
    unsigned char* ws = a.ws;
    const Ctx c = make_ctx(lds);
    const int n = c.wid >> 1, th = c.wid & 1, tq = 32 * th + c.r32, t = 64 * qb + tq, b = bg >> 2, g = bg & 3, h = g * 4 + n, row = b * SEQ + t;
    const float* GL = (const float*)(ws + WS_GL);
    LAS float* GS = (LAS float*)(lds + L_GS); LAS float* LS = (LAS float*)(lds + L_LS);
    LAS unsigned* SEL = (LAS unsigned*)(lds + L_SEL); LAS unsigned* UNI = (LAS unsigned*)(lds + L_UNI);
    bf16x8 qf[8];
    load_q(qf, (const bf16_t*)(ws + WS_Q), row, h, c.hi);
    f32x16 o[4] = {};
    float l_c;
    {
        const bf16_t* Kc = (const bf16_t*)(ws + WS_KC) + (size_t)bg * 128 * HD; const bf16_t* Vc = (const bf16_t*)(ws + WS_VC) + (size_t)bg * 128 * HD;
        { Stage S0; sload(S0, Kc, Vc, 0, c); swrite(S0, 0, c); }
        { Stage S1; sload(S1, Kc, Vc, 64, c); swrite(S1, 1, c); }
        __syncthreads();
        f32x16 pA0, pA1, pB0, pB1;
        qkt<0>(pA0, pA1, c.lds, c.r32, c.hi, qf); qkt<1>(pB0, pB1, c.lds, c.r32, c.hi, qf);
        const int cmax = t >= 31 ? ((t - 31) >> 4) : -1;
        const float NEG = -__builtin_inff();
#pragma unroll
        for (int r = 0; r < 16; ++r) { const int cc = crow(r, c.hi);
            if (cc > cmax) pA0[r] = NEG; if (cc + 32 > cmax) pA1[r] = NEG; if (cc + 64 > cmax) pB0[r] = NEG; if (cc + 96 > cmax) pB1[r] = NEG; }
        float mx = -1e30f;
#pragma unroll
        for (int r = 0; r < 16; ++r) mx = fmaxf(fmaxf(mx, fmaxf(pA0[r], pA1[r])), fmaxf(pB0[r], pB1[r]));
        { auto rr = __builtin_amdgcn_permlane32_swap(__float_as_uint(mx), __float_as_uint(mx), false, false); mx = fmaxf(__uint_as_float(rr[0]), __uint_as_float(rr[1])); }
        constexpr float C2 = 1.4426950408889634f * SCALE;
        const float mnL = -mx * C2; float ps = 0.f;
#pragma unroll
        for (int r = 0; r < 16; ++r) { pA0[r] = __builtin_amdgcn_exp2f(fmaf(pA0[r], C2, mnL)); pA1[r] = __builtin_amdgcn_exp2f(fmaf(pA1[r], C2, mnL));
            pB0[r] = __builtin_amdgcn_exp2f(fmaf(pB0[r], C2, mnL)); pB1[r] = __builtin_amdgcn_exp2f(fmaf(pB1[r], C2, mnL)); ps += (pA0[r] + pA1[r]) + (pB0[r] + pB1[r]); }
        { auto rr = __builtin_amdgcn_permlane32_swap(__float_as_uint(ps), __float_as_uint(ps), false, false); ps = __uint_as_float(rr[0]) + __uint_as_float(rr[1]); }
        l_c = ps;
        const float inv = ps > 0.f ? 1.0f / ps : 0.f;
        LAS float* gsr = GS + (n * 64 + tq) * 33; LAS float* lsr = LS + (n * 64 + tq) * 33;
#pragma unroll
        for (int k = 0; k < 4; ++k) {
            const int jb = 2 * k + c.hi;
            gsr[jb]      = ((pA0[4 * k] + pA0[4 * k + 1]) + (pA0[4 * k + 2] + pA0[4 * k + 3])) * inv; lsr[jb]      = pA0[4 * k + 3] * inv;
            gsr[8 + jb]  = ((pA1[4 * k] + pA1[4 * k + 1]) + (pA1[4 * k + 2] + pA1[4 * k + 3])) * inv; lsr[8 + jb]  = pA1[4 * k + 3] * inv;
            gsr[16 + jb] = ((pB0[4 * k] + pB0[4 * k + 1]) + (pB0[4 * k + 2] + pB0[4 * k + 3])) * inv; lsr[16 + jb] = pB0[4 * k + 3] * inv;
            gsr[24 + jb] = ((pB1[4 * k] + pB1[4 * k + 1]) + (pB1[4 * k + 2] + pB1[4 * k + 3])) * inv; lsr[24 + jb] = pB1[4 * k + 3] * inv;
        }
        bf16x8 pa0, pa1, pa2, pa3;
        pack_p(pA0, pA1, pa0, pa1, pa2, pa3); SBAR(); pv_tile<0>(o, c.vb0, pa0, pa1, pa2, pa3);
        pack_p(pB0, pB1, pa0, pa1, pa2, pa3); SBAR(); pv_tile<1>(o, c.vb0, pa0, pa1, pa2, pa3);
    }
    __syncthreads();
    {
        LAS float* IMP = (LAS float*)(lds + L_IMP);
        const int tk = c.tid & 63, j0 = c.wid * 4;
        const LAS float* gb = GS + tk * 33 + j0; const LAS float* lb = LS + tk * 33 + j0 - 1;
#pragma unroll
        for (int jj = 0; jj < 4; ++jj) { float s = 0.f;
#pragma unroll
            for (int nn = 0; nn < 4; ++nn) { s += gb[nn * 2112 + jj]; const float lv = lb[nn * 2112 + jj]; s += (j0 + jj > 0) ? lv : 0.f; }
            IMP[tk * 33 + j0 + jj] = s; }
    }
    __syncthreads();
    if (c.wid == 0) {
        const LAS float* IMP = (const LAS float*)(lds + L_IMP);
        const int tk = c.lane;
        unsigned selm = 1u | (1u << qb);
        if (qb >= 2) {
            const int nfree = qb - 1;
            if (nfree <= 6) selm |= ((1u << qb) - 1u) & ~1u;
            else {
                float v[32];
#pragma unroll
                for (int jj = 1; jj < 31; ++jj) { const float s = IMP[tk * 33 + jj]; v[jj] = (jj < qb) ? s : -1.0f; }
                unsigned taken = 0u;
                for (int rnd = 0; rnd < 6; ++rnd) {
                    float best = -0.5f; int bi = -1;
#pragma unroll
                    for (int jj = 1; jj < 31; ++jj) { const bool ok = !((taken >> jj) & 1u) && v[jj] > best; best = ok ? v[jj] : best; bi = ok ? jj : bi; }
                    if (bi >= 0) taken |= 1u << bi;
                }
                selm |= taken;
            }
        }
        SEL[tk] = selm;
        unsigned u = selm;
#pragma unroll
        for (int off = 1; off < 64; off <<= 1) u |= (unsigned)__shfl_xor((int)u, off);
        if (c.lane == 0) UNI[0] = u;
    }
    bf16_t* ZC = (bf16_t*)(ws + WS_ZC);
    const int rbase = b * SEQ + 64 * qb + 32 * th;
    {
        const float g0 = sigmoid_f(GL[(size_t)row * 48 + h]);
        rescale_rows(o, l_c > 0.f ? g0 / l_c : 0.f, c);
#pragma unroll
        for (int r = 0; r < 16; ++r) { const int orow = rbase + crow(r, c.hi);
#pragma unroll
            for (int d0 = 0; d0 < 4; ++d0) ZC[(size_t)orow * ZC_LD + 2048 + h * HD + d0 * 32 + c.r32] = (bf16_t)(cvt_pk_bf16(o[d0][r], 0.f) & 0xffffu); }
#pragma unroll
        for (int d = 0; d < 4; ++d) o[d] = f32x16{};
    }
    __syncthreads();
    const unsigned sel = SEL[tq]; const unsigned uni = (unsigned)__builtin_amdgcn_readfirstlane((int)UNI[0]);
    rotate_q(qf[0], qf[1], (const float*)(ws + WS_COS), (const float*)(ws + WS_SIN), t, c.hi);
    float m_reg = -1e30f, l_reg = 0.f;
    {
        const bf16_t* Kh = (const bf16_t*)(ws + WS_KV) + 2 * KV_ELEMS + (size_t)bg * SEQ * HD; const bf16_t* Vh = (const bf16_t*)(ws + WS_KV) + 3 * KV_ELEMS + (size_t)bg * SEQ * HD;
        run_tiles<1>(o, m_reg, l_reg, qf, c, Kh, Vh, uni, t, sel, qb);
    }
    const float g1 = sigmoid_f(GL[(size_t)row * 48 + 16 + h]);
    rescale_rows(o, l_reg > 0.f ? g1 / l_reg : 0.f, c);
    const bf16_t* OW = (const bf16_t*)(ws + WS_XB); const bf16_t* NG = (const bf16_t*)(ws + WS_NG);
    int rbase2 = rbase; asm volatile("" : "+v"(rbase2));
#pragma unroll
    for (int r = 0; r < 16; ++r) { const int orow = rbase2 + crow(r, c.hi);
#pragma unroll
        for (int d0 = 0; d0 < 4; ++d0) {
            const size_t col = (size_t)h * HD + d0 * 32 + c.r32;
            bf16_t* yp = ZC + (size_t)orow * ZC_LD + 2048 + col;
            const float occ = bf2f(*yp);
            const float ow = bf2f(OW[(size_t)orow * DM + col]), ng = bf2f(NG[(size_t)orow * DM + col]);
            const float v = (occ + o[d0][r] + ow) * silu_f(ng);
            *yp = (bf16_t)(cvt_pk_bf16(v, 0.f) & 0xffffu); } }
    __syncthreads();
}

__device__ __forceinline__ void compress_unit(const Args& a, LAS unsigned char* lds, int task) {
    unsigned char* ws = a.ws;
    int tid = threadIdx.x; asm volatile("" : "+v"(tid));
    const int wid = __builtin_amdgcn_readfirstlane(tid >> 6), lane = tid & 63, r32 = lane & 31, hi = lane >> 5;
    const int mb = task & 3, bg = (task >> 2) & 15, kv = task >> 6;
    const bf16_t* X = (const bf16_t*)(ws + WS_KV) + (size_t)kv * KV_ELEMS + (size_t)bg * SEQ * HD;
    const bf16_t* W1T = (const bf16_t*)(ws + WS_W1T) + (size_t)kv * 128 * 4096;
    const bf16_t* W2T = (const bf16_t*)(ws + WS_W2T) + (size_t)kv * 128 * 128;
    int cc = 32 * mb + r32; if (cc > NCMP - 1) cc = NCMP - 1;
    f32x16 acc[4] = {};
#pragma unroll 1
    for (int l = 4 * wid; l < 4 * wid + 4; ++l) {
        const bf16_t* xr = X + (size_t)(16 * cc + l) * HD + hi * 8;
        const bf16_t* wr = W1T + (size_t)r32 * 4096 + l * 128 + hi * 8;
#pragma unroll
        for (int ks = 0; ks < 8; ++ks) {
            const bf16x8 af = *(const bf16x8*)(xr + 16 * ks);
#pragma unroll
            for (int nb = 0; nb < 4; ++nb) { const bf16x8 bfr = *(const bf16x8*)(wr + (size_t)nb * 32 * 4096 + 16 * ks);
                acc[nb] = __builtin_amdgcn_mfma_f32_32x32x16_bf16(af, bfr, acc[nb], 0, 0, 0); }
        }
    }
    LAS float* part = (LAS float*)lds;
    LAS bf16_t* hid = (LAS bf16_t*)(lds + 131072);
#pragma unroll
    for (int nb = 0; nb < 4; ++nb)
#pragma unroll
        for (int r = 0; r < 16; ++r) part[wid * 4096 + crow(r, hi) * 128 + nb * 32 + r32] = acc[nb][r];
    __syncthreads();
    {
        const float* PBP = (const float*)(ws + WS_PBP) + kv * 4096; const float* b1 = a.in[kv ? 10 : 6];
        for (int e = tid; e < 32 * 128; e += NTHREADS) { const int j = e & 127, m = e >> 7;
            float s = b1[j];
            for (int q = 0; q < 32; ++q) s += PBP[q * 128 + j];
#pragma unroll
            for (int w = 0; w < 8; ++w) s += part[w * 4096 + e];
            hid[m * 136 + j] = (bf16_t)f2bf(silu_f(s)); }
    }
    __syncthreads();
    if (wid < 4) {
        f32x16 o2 = {};
#pragma unroll
        for (int ks = 0; ks < 8; ++ks) {
            const bf16x8 af = *(const LAS bf16x8*)(hid + r32 * 136 + 16 * ks + hi * 8);
            const bf16x8 bfr = *(const bf16x8*)(W2T + (size_t)(32 * wid + r32) * 128 + 16 * ks + hi * 8);
            o2 = __builtin_amdgcn_mfma_f32_32x32x16_bf16(af, bfr, o2, 0, 0, 0);
        }
        bf16_t* dst = (bf16_t*)(ws + (kv ? WS_VC : WS_KC)) + (size_t)bg * 128 * 128;
#pragma unroll
        for (int r = 0; r < 16; ++r) { const int c2 = 32 * mb + crow(r, hi);
            dst[(size_t)c2 * 128 + 32 * wid + r32] = (bf16_t)(c2 < NCMP ? f2bf(o2[r]) : 0u); }
    }
    __syncthreads();
}

__device__ __forceinline__ void sgu_unit(const Args& a, LAS unsigned char* lds, int ch, int h) {
    unsigned char* ws = a.ws;
    int tid = threadIdx.x; asm volatile("" : "+v"(tid));
    const int wid = __builtin_amdgcn_readfirstlane(tid >> 6), lane = tid & 63, r32 = lane & 31, hi = lane >> 5;
    const int tb = wid & 3, dh = wid >> 2, row0 = ch * 128;
    bf16_t* Z1 = (bf16_t*)(ws + WS_Z1); const float* LNS = (const float*)(ws + WS_LNS);
    const float* lng = a.in[15]; const float* lnb = a.in[16]; const float* bsp = a.in[18];
    {
        const int sr = tid >> 4, sc = (tid & 15) * 8;
#pragma unroll
        for (int dhh = 0; dhh < 2; ++dhh) {
            const int col = h * 256 + dhh * 128 + sc;
            const f32x4 g0 = *(const f32x4*)(lng + col), g1 = *(const f32x4*)(lng + col + 4), b0 = *(const f32x4*)(lnb + col), b1 = *(const f32x4*)(lnb + col + 4);
#pragma unroll
            for (int q = 0; q < 4; ++q) {
                const int s = 32 * q + sr, row = row0 + s;
                const float sum = LNS[2 * row], sq = LNS[2 * row + 1]; const float mu = sum * (1.0f / MIXW);
                const float rstd = __builtin_amdgcn_rsqf(fmaxf(sq * (1.0f / MIXW) - mu * mu, 0.f) + EPS);
                const u32x4 vv = *(const u32x4*)(Z1 + (size_t)row * N1 + MIXW + col);
                f32x4 x0 = {bf_lo(vv.x), bf_hi(vv.x), bf_lo(vv.y), bf_hi(vv.y)}, x1 = {bf_lo(vv.z), bf_hi(vv.z), bf_lo(vv.w), bf_hi(vv.w)};
                x0 = (x0 - mu) * rstd * g0 + b0; x1 = (x1 - mu) * rstd * g1 + b1;
                *(LAS bf16x8*)(lds + L_V + ((q >> 1) * 2 + dhh) * SHM + v_st(32 * (q & 1) + sr, sc)) = pack8(x0, x1);
            }
        }
    }
    __syncthreads();
    f32x16 o[4] = {};
    {
        const bf16_t* wp = (const bf16_t*)(ws + WS_SW) + (size_t)(h * 128 + 32 * tb + r32) * 128 + hi * 8;
        const int vb0 = (int)(unsigned)(uintptr_t)lds + v_rd_base(lane);
        bf16x8 pa0 = *(const bf16x8*)(wp), pa1 = *(const bf16x8*)(wp + 16), pa2 = *(const bf16x8*)(wp + 32), pa3 = *(const bf16x8*)(wp + 48);
        if (dh == 0) pv_tile<0>(o, vb0, pa0, pa1, pa2, pa3); else pv_tile<1>(o, vb0, pa0, pa1, pa2, pa3);
        if (tb >= 2) {
            pa0 = *(const bf16x8*)(wp + 64); pa1 = *(const bf16x8*)(wp + 80); pa2 = *(const bf16x8*)(wp + 96); pa3 = *(const bf16x8*)(wp + 112);
            if (dh == 0) pv_tile<2>(o, vb0, pa0, pa1, pa2, pa3); else pv_tile<3>(o, vb0, pa0, pa1, pa2, pa3);
        }
    }
#pragma unroll
    for (int r = 0; r < 16; ++r) { const int t = 32 * tb + crow(r, hi); const float bias = bsp[h * 128 + t];
        bf16_t* up = Z1 + (size_t)(row0 + t) * N1 + h * 256 + dh * 128 + r32;
#pragma unroll
        for (int d0 = 0; d0 < 4; ++d0) {
            const float u = bf2f(up[d0 * 32]), zg = bf2f(up[d0 * 32 + 2 * MIXW]);
            const float y = u * (o[d0][r] + bias) * silu_f(zg);
            const float yn = __shfl_xor(y, 1);
            if ((r32 & 1) == 0) *(unsigned*)(up + d0 * 32) = cvt_pk_bf16(y, yn); } }
    __syncthreads();
}
}

__device__ __forceinline__ void p6_sgu_naive(const Args& a, LAS unsigned char* lds, int blk, int G, int tid) {
    LAS float* vn = (LAS float*)lds;
    LAS float* Wt = (LAS float*)(lds + 65536);
    bf16_t* Z1 = (bf16_t*)(a.ws + WS_Z1); const float* LNS = (const float*)(a.ws + WS_LNS);
    const float* lng = a.in[15]; const float* lnb = a.in[16]; const float* wsp = a.in[17]; const float* bsp = a.in[18];
    const int d = tid & 127, tq = tid >> 7;
    for (int unit = blk; unit < 64 * 16 * 2; unit += G) {
        const int dh = unit & 1, h = (unit >> 1) & 15, ch = unit >> 5;
        const int row0 = ch * 128, col = h * 256 + dh * 128;
        __syncthreads();
        for (int i = tid; i < 128 * 128; i += NTHREADS) { const int s = i >> 7, dd = i & 127; const int row = row0 + s;
            const float sum = LNS[2 * row], sq = LNS[2 * row + 1]; const float mu = sum * (1.0f / MIXW); const float var = sq * (1.0f / MIXW) - mu * mu;
            const float rstd = 1.0f / sqrtf(fmaxf(var, 0.f) + EPS);
            const float v = bf2f(Z1[(size_t)row * N1 + MIXW + col + dd]);
            vn[i] = (v - mu) * rstd * lng[col + dd] + lnb[col + dd];
            Wt[i] = wsp[(size_t)h * 16384 + i]; }
        __syncthreads();
        for (int tt = 0; tt < 32; ++tt) {
            const int t = tq + 4 * tt;
            float mix = 0.f;
            for (int s = 0; s <= t; ++s) mix += Wt[t * 128 + s] * vn[s * 128 + d];
            mix += bsp[h * 128 + t];
            const size_t off = (size_t)(row0 + t) * N1 + col + d;
            const float u = bf2f(Z1[off]), zg = bf2f(Z1[off + 2 * MIXW]);
            Z1[off] = (bf16_t)f2bf(u * mix * silu_f(zg));
        }
    }
    __syncthreads();
}

__device__ __forceinline__ void p8_final(const Args& a, int gw, int NGW, int lane) {
    const float* gf = a.in[20];
    for (int m = gw; m < MTOK; m += NGW) {
        f32x4* xr = (f32x4*)(a.out + (size_t)m * DM) + lane;
        f32x4 v[8]; float s = 0.f;
#pragma unroll
        for (int j = 0; j < 8; ++j) { v[j] = xr[64 * j]; s += (v[j].x * v[j].x + v[j].y * v[j].y) + (v[j].z * v[j].z + v[j].w * v[j].w); }
        s = wave_sum(s);
        const float rs = 1.0f / sqrtf(s * (1.0f / DM) + EPS);
#pragma unroll
        for (int j = 0; j < 8; ++j) { const f32x4 gg = *((const f32x4*)gf + lane + 64 * j); xr[64 * j] = v[j] * rs * gg; }
    }
}

#define GAS __attribute__((address_space(1)))
typedef GAS unsigned gu32;
#define XB_TMO      128
#define XB_XCNT(j)  (256  + 64 * (j))
#define XB_XSUB(j)  (1280 + 64 * (j))
#define XB_XGEN(j)  (2304 + 64 * (j))
#define XB_TOP      3328
#define XB_TOPGEN   3392
#define XCD_BAR_WORDS 3456
#define XB_SPIN_CAP (1u << 18)

__device__ __forceinline__ unsigned xb_ld(unsigned* p)              { return __hip_atomic_load(p, __ATOMIC_RELAXED, __HIP_MEMORY_SCOPE_AGENT); }
__device__ __forceinline__ unsigned xb_add(unsigned* p, unsigned v) { return __hip_atomic_fetch_add(p, v, __ATOMIC_RELAXED, __HIP_MEMORY_SCOPE_AGENT); }
__device__ __forceinline__ unsigned xb_xcc_id() { return (unsigned)__builtin_amdgcn_s_getreg((3 << 11) | 20) & 0xFu; }
#define XB_SPIN(cond, bar) do { unsigned _sp = 0; while (cond) { __builtin_amdgcn_s_sleep(1); \
    if ((++_sp & 255u) == 0u) { if (xb_ld(&(bar)[XB_TMO])) break; if (_sp > XB_SPIN_CAP) { atomicAdd(&(bar)[XB_TMO], 1u); break; } } } } while (0)

struct XcdBarrier {
    unsigned* bar; unsigned x;
    volatile LAS unsigned* st;
};

__device__ __forceinline__ XcdBarrier xcd_barrier_post(unsigned* bar, volatile LAS unsigned* st) {
    XcdBarrier b; b.bar = bar; b.x = xb_xcc_id(); b.st = st;
    if (threadIdx.x == 0) (void)xb_add(&bar[XB_XCNT(b.x)], 1u);
    return b;
}
__device__ __forceinline__ void xcd_barrier_complete(unsigned* bar, unsigned x, unsigned& nloc, unsigned& nx) {
    const unsigned G = gridDim.x * gridDim.y * gridDim.z;
    unsigned sum, cnt, mine, sp = 0u;
    for (;;) {
        sum = 0u; cnt = 0u; mine = 0u;
#pragma unroll
        for (unsigned j = 0; j < 16; ++j) { const unsigned c = xb_ld(&bar[XB_XCNT(j)]); sum += c; cnt += (c > 0u) ? 1u : 0u; mine = (j == x) ? c : mine; }
        if (sum == G) break;
        __builtin_amdgcn_s_sleep(1);
        if ((++sp & 255u) == 0u) { if (xb_ld(&bar[XB_TMO])) break; if (sp > XB_SPIN_CAP) { atomicAdd(&bar[XB_TMO], 1u); break; } }
    }
    nloc = mine > 0u ? mine : 1u; nx = cnt > 0u ? cnt : 1u;
}

__device__ __forceinline__ void xcd_barrier(const XcdBarrier& b) {
    asm volatile("s_waitcnt vmcnt(0)" ::: "memory");
    __syncthreads();
    if (threadIdx.x == 0) {
        unsigned* bar = b.bar;
        __builtin_amdgcn_s_waitcnt(0);
        unsigned nloc = b.st[0], nx = b.st[1];
        if (nloc == 0u) { xcd_barrier_complete(bar, b.x, nloc, nx); b.st[0] = nloc; b.st[1] = nx; }
        const unsigned old = xb_add(&bar[XB_XSUB(b.x)], 1u);
        const unsigned gen = old / nloc;
        if (old + 1u == (gen + 1u) * nloc) {
            __builtin_amdgcn_fence(__ATOMIC_RELEASE, "agent");
            asm volatile("s_waitcnt vmcnt(0)" ::: "memory");
            const unsigned og = xb_add(&bar[XB_TOP], 1u);
            const unsigned tg = og / nx;
            if (og + 1u == (tg + 1u) * nx) xb_add(&bar[XB_TOPGEN], 1u);
            else XB_SPIN(xb_ld(&bar[XB_TOPGEN]) == tg, bar);
            __builtin_amdgcn_fence(__ATOMIC_ACQUIRE, "agent");
            xb_add(&bar[XB_XGEN(b.x)], 1u);
            asm volatile("s_waitcnt vmcnt(0)" ::: "memory");
        } else {
            XB_SPIN(xb_ld(&bar[XB_XGEN(b.x)]) == gen, bar);
            __builtin_amdgcn_fence(__ATOMIC_ACQUIRE, "agent");
            asm volatile("s_waitcnt vmcnt(0)" ::: "memory");
        }
    }
    __syncthreads();
}

constexpr int NPHASE = 9;
template <bool COOP>
__global__ void __launch_bounds__(NTHREADS, 2) fwd_kernel(Args args) {
    extern __shared__ __attribute__((aligned(16))) unsigned char lds_raw[];
    LAS unsigned char* lds = (LAS unsigned char*)lds_raw;
    const int tid = threadIdx.x, lane = tid & 63, wave = __builtin_amdgcn_readfirstlane(tid >> 6);
    const int G = gridDim.x, bx = blockIdx.x;
    const int vcu = (G % 8 == 0) ? (bx % 8) * (G / 8) + bx / 8 : bx;
    const int gw = vcu * NWAVES + wave, NGW = G * NWAVES, gt = gw * 64 + lane, NGT = NGW * 64;
    const int lo = args.ph_lo, hi = args.ph_hi;
    unsigned char* ws = args.ws;
#define IN(k) (lo <= (k) && (k) < hi)
    unsigned* barw = (unsigned*)(ws + WS_BAR);
    volatile LAS unsigned* bst = (volatile LAS unsigned*)(lds + LDS_BYTES - 64);
    XcdBarrier bar; bar.bar = barw; bar.x = 0; bar.st = bst;
#define SEAM(k) do { if (COOP) { if (IN(k) && IN((k) + 1)) { xcd_barrier(bar); } } } while (0)

    if (IN(0)) {
#ifdef REP_P0
        p0_prologue(args, lds, vcu, G, wave, lane); __syncthreads();
#endif
        if (COOP) { if (tid == 0) { bst[0] = 0u; bst[1] = 0u; }
            if (bx == 0) for (int i = tid; i < XCD_BAR_WORDS; i += NTHREADS) barw[i] = 0u; }
        p0_prologue(args, lds, vcu, G, wave, lane);
    }
    if (COOP) { if (IN(0) && IN(1)) { __threadfence(); cg::this_grid().sync(); __threadfence(); bar = xcd_barrier_post(barw, bst); } }
#define P1_BODY do { \
        pg8::Gemm g{(const bf16_t*)(ws + WS_XB), (const bf16_t*)(ws + WS_WT0), MTOK, N0, DM, DM}; \
        pg8::StaticOrder S; S.init(MTOK, N0, G, bx); \
        pg8::Epi0 E{(const float*)(ws + WS_RSTD0), (bf16_t*)(ws + WS_ZC), (bf16_t*)(ws + WS_Q), (bf16_t*)(ws + WS_KV), (bf16_t*)(ws + WS_NG), (float*)(ws + WS_GL), \
                    (const float*)(ws + WS_COS), (const float*)(ws + WS_SIN)}; \
        pg8::gemm_phase<pg8::Epi0, pg8::StaticOrder, true, true>(lds, g, S, E); } while (0)
    if (IN(1)) {
#ifdef REP_P1
        P1_BODY; __syncthreads();
#endif
        P1_BODY;
    }
    SEAM(1);
    if (IN(2)) {
#ifdef REP_P2C
        for (int task = vcu; task < 128; task += G) nsa::compress_unit(args, lds, task);
#endif
#ifdef REP_P2W
        for (int item = vcu; item < 256; item += G) { const int bg = item >> 4, p = item & 15; for (int k = 0; k < 2; ++k) nsa::window_unit(args, lds, bg, k ? 31 - p : p); }
#endif
        for (int task = vcu; task < 128; task += G) nsa::compress_unit(args, lds, task);
        for (int item = vcu; item < 256; item += G) { const int bg = item >> 4, p = item & 15;
#ifndef NO_WINDOW
            for (int k = 0; k < 2; ++k) nsa::window_unit(args, lds, bg, k ? 31 - p : p);
#endif
        }
        p2_conv(args, gt, NGT);
    }
    SEAM(2);
    if (IN(3)) {
#ifdef REP_P3
      for (int rep = 0; rep < 2; ++rep)
#endif
        for (int item = vcu; item < 256; item += G) { const int bg = item >> 4, p = item & 15;
#ifndef NO_CMPSEL
            for (int k = 0; k < 2; ++k) nsa::cmpsel_unit(args, lds, bg, k ? 31 - p : p);
#endif
        }
    }
    SEAM(3);
    if (IN(4)) {
        pg8::Gemm g{(const bf16_t*)(ws + WS_ZC), (const bf16_t*)(ws + WS_WTO0), MTOK, DM, MIXW, ZC_LD};
        pg8::StaticOrder S; S.init(MTOK, DM, G, bx);
        pg8::EpiOut0 E{args.in[0], args.out, (bf16_t*)(ws + WS_XB), (float*)(ws + WS_SS1)};
        pg8::gemm_phase<pg8::EpiOut0, pg8::StaticOrder, true, true>(lds, g, S, E);
    }
    SEAM(4);
    if (IN(5)) {
        pg8::Gemm g{(const bf16_t*)(ws + WS_XB), (const bf16_t*)(ws + WS_WT1), MTOK, N1, DM, DM};
        pg8::StaticOrder S; S.init(MTOK, N1, G, bx);
        pg8::Epi1 E{(const float*)(ws + WS_SS1), (bf16_t*)(ws + WS_Z1), (float*)(ws + WS_LNS)};
        pg8::gemm_phase<pg8::Epi1, pg8::StaticOrder, true, true>(lds, g, S, E);
    }
    SEAM(5);
    if (IN(6)) { for (int unit = vcu; unit < 1024; unit += G) nsa::sgu_unit(args, lds, unit >> 4, unit & 15); }
    SEAM(6);
    if (IN(7)) {
        pg8::Gemm g{(const bf16_t*)(ws + WS_Z1), (const bf16_t*)(ws + WS_WTO1), MTOK, DM, MIXW, N1};
        pg8::StaticOrder S; S.init(MTOK, DM, G, bx);
        pg8::EpiOut1 E{args.out};
        pg8::gemm_phase<pg8::EpiOut1, pg8::StaticOrder, true, true>(lds, g, S, E);
    }
    SEAM(7);
    if (IN(8)) { p8_final(args, gw, NGW, lane); }
#undef IN
#undef SEAM
}

#ifndef MK_COOP
#define MK_COOP 1
#endif

extern "C" void kernel_launch(void* const* d_in, const int* in_sizes, int n_in, void* d_out, int out_size, void* d_ws, size_t ws_size, hipStream_t stream) {
    static int grid = 0;
    if (grid == 0) {
        if (n_in != 21 || out_size != MTOK * DM || ws_size < WS_END) { fprintf(stderr, "kernel_launch: unexpected shapes (n_in %d out %d ws %zu)\n", n_in, out_size, ws_size); grid = -1; return; }
        int dev = 0, cus = 0, per_cu = 0;
        (void)hipGetDevice(&dev); (void)hipDeviceGetAttribute(&cus, hipDeviceAttributeMultiprocessorCount, dev);
        (void)hipFuncSetAttribute((const void*)fwd_kernel<true>, hipFuncAttributeMaxDynamicSharedMemorySize, LDS_BYTES);
        (void)hipFuncSetAttribute((const void*)fwd_kernel<false>, hipFuncAttributeMaxDynamicSharedMemorySize, LDS_BYTES);
        (void)hipOccupancyMaxActiveBlocksPerMultiprocessor(&per_cu, (const void*)fwd_kernel<true>, NTHREADS, LDS_BYTES);
        if (per_cu < 1) { fprintf(stderr, "kernel_launch: occupancy query says %d blocks per CU\n", per_cu); per_cu = 1; }
        (void)hipGetLastError();
        grid = cus;
        fprintf(stderr, "kernel_launch: grid %d (per_cu %d)\n", grid, per_cu);
    }
    if (grid < 0) return;
    Args a{};
    for (int i = 0; i < 21; ++i) a.in[i] = (const float*)d_in[i];
    a.out = (float*)d_out; a.ws = (unsigned char*)d_ws;
#if MK_COOP
    a.ph_lo = 0; a.ph_hi = NPHASE;
    void* kargs[] = {&a};
    hipError_t e = hipLaunchCooperativeKernel((const void*)fwd_kernel<true>, dim3(grid), dim3(NTHREADS), kargs, LDS_BYTES, stream);
    if (e != hipSuccess) fprintf(stderr, "cooperative launch failed: %s (grid %d)\n", hipGetErrorString(e), grid);
#else
    for (int p = 0; p < NPHASE; ++p) {
        a.ph_lo = p; a.ph_hi = p + 1;
        hipLaunchKernelGGL(fwd_kernel<false>, dim3(grid), dim3(NTHREADS), LDS_BYTES, stream, a);
    }
#endif
}
```

```cpp
#include <hip/hip_runtime.h>
#include <hip/hip_cooperative_groups.h>
#include <cstdio>
#include <cstdint>
namespace cg = cooperative_groups;

#define LAS __attribute__((address_space(3)))
typedef unsigned short bf16_t;
typedef short bf16x8 __attribute__((ext_vector_type(8)));
typedef float f32x4 __attribute__((ext_vector_type(4)));
typedef float f32x2 __attribute__((ext_vector_type(2)));
typedef unsigned u32x4 __attribute__((ext_vector_type(4)));
typedef unsigned u32x2 __attribute__((ext_vector_type(2)));

constexpr int DM = 2048, NB = 4, SEQ = 2048, MTOK = NB * SEQ;
constexpr int N0 = 15616, N0_SRC = 15408;
constexpr int N1 = 12288, MIXW = 4096;
constexpr int ZC_LD = 8192;
constexpr float EPS = 1e-6f;
constexpr int NKV = 4, HD = 128, NH = 16;
constexpr int NCMP = 127;

constexpr size_t MiB = 1u << 20;
constexpr size_t WS_BAR = 0;
constexpr size_t WS_RSTD0 = 1 * MiB, WS_SS1 = WS_RSTD0 + 32768, WS_LNS = WS_SS1 + 32768, WS_COS = WS_LNS + 65536, WS_SIN = WS_COS + 131072;
constexpr size_t WS_KC = 2 * MiB, WS_VC = 2 * MiB + 524288;
constexpr size_t WS_GL = 3 * MiB;
constexpr size_t WS_W1T = 5 * MiB;
constexpr size_t WS_W2T = 7 * MiB;
constexpr size_t WS_PBP = 7 * MiB + 65536;
constexpr size_t WS_DUMMY = 7 * MiB + 131072;
constexpr size_t WS_SW = 7 * MiB + 524288;
constexpr size_t WS_WT0 = 8 * MiB, WS_WTO0 = 69 * MiB, WS_WT1 = 85 * MiB, WS_WTO1 = 133 * MiB;
constexpr size_t WS_XB = 149 * MiB;
constexpr size_t WS_NG = 181 * MiB;
constexpr size_t WS_ZC = 213 * MiB;
constexpr size_t WS_Q = 341 * MiB;
constexpr size_t WS_KV = 373 * MiB;
constexpr size_t KV_ELEMS = (size_t)MTOK * 512;
constexpr size_t WS_END = 421 * MiB;
constexpr size_t WS_Z1 = WS_ZC;
static_assert(WS_Z1 + (size_t)MTOK * N1 * 2 <= WS_END, "z1 overlay");

constexpr int NWAVES = 8, NTHREADS = 512;
constexpr int LDS_BYTES = 147456;

struct Args { const float* in[21]; float* out; unsigned char* ws; int ph_lo, ph_hi; };

__device__ __forceinline__ float bf_lo(unsigned u) { return __uint_as_float(u << 16); }
__device__ __forceinline__ float bf_hi(unsigned u) { return __uint_as_float(u & 0xffff0000u); }
__device__ __forceinline__ float bf2f(bf16_t b) { return __uint_as_float((unsigned)b << 16); }
__device__ __forceinline__ unsigned f2bf(float f) { unsigned u = __float_as_uint(f); return (u + 0x7fffu + ((u >> 16) & 1u)) >> 16; }
__device__ __forceinline__ unsigned pk2(float lo, float hi) { return f2bf(lo) | (f2bf(hi) << 16); }
__device__ __forceinline__ unsigned cvt_pk_bf16(float lo, float hi) { unsigned r; asm volatile("v_cvt_pk_bf16_f32 %0, %1, %2" : "=v"(r) : "v"(lo), "v"(hi)); return r; }
__device__ __forceinline__ float silu_f(float x) { return x / (1.f + __expf(-x)); }
__device__ __forceinline__ float sigmoid_f(float x) { return 1.f / (1.f + __expf(-x)); }
__device__ __forceinline__ float wave_sum(float v) {
#pragma unroll
    for (int o = 1; o < 64; o <<= 1) v += __shfl_xor(v, o);
    return v;
}
__device__ __forceinline__ float wave_max(float v) {
#pragma unroll
    for (int o = 1; o < 64; o <<= 1) v = fmaxf(v, __shfl_xor(v, o));
    return v;
}
__device__ __forceinline__ int colmap0(int nd) { return nd < 13312 ? nd : (nd < 15360 ? nd + 48 : (nd < 15408 ? nd - 2048 : -1)); }

namespace pg8 {
#define PG8_LAS __attribute__((address_space(3)))
constexpr int BM = 256, BK = 64, HALF = 128, HTB = HALF * BK * 2  , STAGE_BYTES = 8 * HTB, NXCD = 8, WGM = 8;

__host__ __device__ __forceinline__ int lds_byte(int r, int c) { const int st = (r >> 4) * 2 + (c >> 5), rr = r & 15, cc = c & 31, ob = rr * 64 + cc * 2; return st * 1024 + (ob ^ (((ob >> 9) & 1) << 5)); }
__host__ __device__ __forceinline__ void stage_rc(int b, int& R, int& C) { const int st = b / 1024, sb = b % 1024, swz = sb ^ (((sb >> 9) & 1) << 5); R = (st >> 1) * 16 + swz / 64; C = (st & 1) * 32 + (swz % 64) / 2; }
__host__ __device__ __forceinline__ int perm32(int rho) { const int n = rho >> 4, i = rho & 15; return 8 * (i >> 2) + 4 * n + (i & 3); }

struct Unit { int pm, pn; };
struct Gemm { const bf16_t* A; const bf16_t* Bt; int M, N, K, lda; };

struct StaticOrder {
    int nM, nN, nwg, G, c;
    __host__ __device__ void init(int M, int N, int G_, int c_) { nM = M / BM; nN = N / BM; nwg = nM * nN; G = G_; c = c_; }
    __host__ __device__ bool next(int i, Unit& u) const {
        const long L = (long)i * G + c; if (L >= nwg) return false;
        int wgid = (int)L; { const int q = nwg / NXCD, r = nwg % NXCD, xcd = wgid % NXCD, off = wgid / NXCD; wgid = (xcd < r ? xcd * (q + 1) : r * (q + 1) + (xcd - r) * q) + off; }
        const int nig = WGM * nN, gid = wgid / nig, fm = gid * WGM, gsz = (nM - fm) < WGM ? (nM - fm) : WGM;
        u.pm = fm + ((wgid % nig) % gsz); u.pn = (wgid % nig) / gsz; return true;
    }
    __device__ __forceinline__ void a_ready(const Unit&) const {}
    __device__ __forceinline__ void done(const Unit&) const {}
};


struct Epi0 {
    static constexpr bool PERM = true, AFTER_DRAIN = false;
    const float* rstd; bf16_t* ZC; bf16_t* Q; bf16_t* KV; bf16_t* NG; float* GL; const float* COS; const float* SIN;
    __device__ __forceinline__ void operator()(const f32x4 (&acc)[2][2][4][2], const Unit& u, int wr, int wc, int fr, int fq) const {
        const int pn = u.pn;
        const int rowb = u.pm * BM + wr * 64 + fr;
        const int cl = wc * 32 + 8 * fq;
        const bool rot = (pn == 44 || pn == 45 || pn == 48 || pn == 49) && (wc == 0);
#pragma unroll
        for (int ai = 0; ai < 2; ++ai)
#pragma unroll
            for (int m = 0; m < 4; ++m) {
                const int row = rowb + ai * HALF + m * 16;
                const float rs = rstd[row];
                const int t = row & (SEQ - 1), b = row >> 11;
                f32x4 cs0, cs1, sn0, sn1;
                if (rot) { const float* cp = COS + t * 16 + 8 * (fq & 1); const float* sp = SIN + t * 16 + 8 * (fq & 1);
                    cs0 = *(const f32x4*)cp; cs1 = *(const f32x4*)(cp + 4); sn0 = *(const f32x4*)sp; sn1 = *(const f32x4*)(sp + 4); }
#pragma unroll
                for (int bj = 0; bj < 2; ++bj) {
                    f32x4 v0 = acc[ai][bj][m][0] * rs, v1 = acc[ai][bj][m][1] * rs;
                    if (rot) {
                        f32x4 p0, p1;
#pragma unroll
                        for (int j = 0; j < 4; ++j) { p0[j] = __shfl_xor(v0[j], 32); p1[j] = __shfl_xor(v1[j], 32); }
                        if (fq < 2) { v0 = v0 * cs0 - p0 * sn0; v1 = v1 * cs1 - p1 * sn1; }
                        else        { v0 = v0 * cs0 + p0 * sn0; v1 = v1 * cs1 + p1 * sn1; }
                    }
                    const int c = cl + bj * HALF;
                    if (pn == 60) {
                        if (c < 48) { float* gp = GL + (size_t)row * 48 + c; *(f32x4*)gp = v0; *(f32x4*)(gp + 4) = v1; }
                    } else {
                        u32x4 w; w.x = cvt_pk_bf16(v0[0], v0[1]); w.y = cvt_pk_bf16(v0[2], v0[3]); w.z = cvt_pk_bf16(v1[0], v1[1]); w.w = cvt_pk_bf16(v1[2], v1[3]);
                        bf16_t* dst;
                        if (pn < 32) dst = ZC + (size_t)row * ZC_LD + pn * BM + c;
                        else if (pn < 40) dst = Q + (size_t)row * DM + (pn - 32) * BM + c;
                        else if (pn < 52) { const int which = (pn - 40) >> 1, g = ((pn - 40) & 1) * 2 + bj;
                            dst = KV + (size_t)which * KV_ELEMS + ((size_t)((b * NKV + g) * SEQ + t)) * HD + cl; }
                        else dst = NG + (size_t)row * DM + (pn - 52) * BM + c;
                        *(u32x4*)dst = w;
                    }
                }
            }
    }
};

struct EpiOut0 {
    static constexpr bool PERM = false, AFTER_DRAIN = false;
    const float* X; float* X1; bf16_t* X1B; float* SS;
    __device__ __forceinline__ void operator()(const f32x4 (&acc)[2][2][4][2], const Unit& u, int wr, int wc, int fr, int fq) const {
        const int rowb = u.pm * BM + wr * 64 + fr, colb = u.pn * BM + wc * 32 + 4 * fq;
#pragma unroll
        for (int ai = 0; ai < 2; ++ai)
#pragma unroll
            for (int m = 0; m < 4; ++m) {
                const int row = rowb + ai * HALF + m * 16; float ss = 0.f;
#pragma unroll
                for (int bj = 0; bj < 2; ++bj)
#pragma unroll
                    for (int n = 0; n < 2; ++n) {
                        const size_t off = (size_t)row * DM + colb + bj * HALF + n * 16;
                        const f32x4 x1 = *(const f32x4*)(X + off) + acc[ai][bj][m][n];
                        *(f32x4*)(X1 + off) = x1;
                        u32x2 w; w.x = cvt_pk_bf16(x1[0], x1[1]); w.y = cvt_pk_bf16(x1[2], x1[3]); *(u32x2*)(X1B + off) = w;
                        ss += (x1[0] * x1[0] + x1[1] * x1[1]) + (x1[2] * x1[2] + x1[3] * x1[3]);
                    }
                ss += __shfl_xor(ss, 16); ss += __shfl_xor(ss, 32);
                if (fq == 0) atomicAdd(SS + row, ss);
            }
    }
};

struct Epi1 {
    static constexpr bool PERM = true, AFTER_DRAIN = false;
    const float* SS; bf16_t* Z1; float* LNS;
    __device__ __forceinline__ void operator()(const f32x4 (&acc)[2][2][4][2], const Unit& u, int wr, int wc, int fr, int fq) const {
        const int rowb = u.pm * BM + wr * 64 + fr, colb = u.pn * BM + wc * 32 + 8 * fq;
        const bool isv = (u.pn >= 16 && u.pn < 32);
#pragma unroll
        for (int ai = 0; ai < 2; ++ai)
#pragma unroll
            for (int m = 0; m < 4; ++m) {
                const int row = rowb + ai * HALF + m * 16;
                const float rs = __builtin_amdgcn_rsqf(SS[row] * (1.0f / DM) + EPS);
                float s1 = 0.f, s2 = 0.f;
#pragma unroll
                for (int bj = 0; bj < 2; ++bj) {
                    const f32x4 v0 = acc[ai][bj][m][0] * rs, v1 = acc[ai][bj][m][1] * rs;
                    u32x4 w; w.x = cvt_pk_bf16(v0[0], v0[1]); w.y = cvt_pk_bf16(v0[2], v0[3]); w.z = cvt_pk_bf16(v1[0], v1[1]); w.w = cvt_pk_bf16(v1[2], v1[3]);
                    *(u32x4*)(Z1 + (size_t)row * N1 + colb + bj * HALF) = w;
                    s1 += (v0[0] + v0[1]) + (v0[2] + v0[3]) + (v1[0] + v1[1]) + (v1[2] + v1[3]);
                    s2 += (v0[0] * v0[0] + v0[1] * v0[1]) + (v0[2] * v0[2] + v0[3] * v0[3]) + (v1[0] * v1[0] + v1[1] * v1[1]) + (v1[2] * v1[2] + v1[3] * v1[3]);
                }
                if (isv) {
                    s1 += __shfl_xor(s1, 16); s1 += __shfl_xor(s1, 32); s2 += __shfl_xor(s2, 16); s2 += __shfl_xor(s2, 32);
                    if (fq == 0) { atomicAdd(LNS + 2 * row, s1); atomicAdd(LNS + 2 * row + 1, s2); }
                }
            }
    }
};

struct EpiNull {
    static constexpr bool PERM = true, AFTER_DRAIN = false; float* dummy;
    __device__ __forceinline__ void operator()(const f32x4 (&acc)[2][2][4][2], const Unit& u, int wr, int wc, int fr, int fq) const {
        float s = 0.f;
#pragma unroll
        for (int ai = 0; ai < 2; ++ai)
#pragma unroll
            for (int bj = 0; bj < 2; ++bj)
#pragma unroll
                for (int m = 0; m < 4; ++m)
#pragma unroll
                    for (int n = 0; n < 2; ++n) s += acc[ai][bj][m][n][0] + acc[ai][bj][m][n][1] + acc[ai][bj][m][n][2] + acc[ai][bj][m][n][3];
        if (s == 1.2345678f) dummy[0] = s;
    }
};
struct EpiOut1 {
    static constexpr bool PERM = false, AFTER_DRAIN = false;
    float* OUT;
    __device__ __forceinline__ void operator()(const f32x4 (&acc)[2][2][4][2], const Unit& u, int wr, int wc, int fr, int fq) const {
        const int rowb = u.pm * BM + wr * 64 + fr, colb = u.pn * BM + wc * 32 + 4 * fq;
#pragma unroll
        for (int ai = 0; ai < 2; ++ai)
#pragma unroll
            for (int m = 0; m < 4; ++m) {
                const int row = rowb + ai * HALF + m * 16;
#pragma unroll
                for (int bj = 0; bj < 2; ++bj)
#pragma unroll
                    for (int n = 0; n < 2; ++n) {
                        float* p = OUT + (size_t)row * DM + colb + bj * HALF + n * 16;
                        *(f32x4*)p = *(const f32x4*)p + acc[ai][bj][m][n];
                    }
            }
    }
};

template <class Epi, class Sched, bool ALIGN_EPI = false, bool SP2 = false>
__device__ __forceinline__ void gemm_phase(PG8_LAS unsigned char* lds, const Gemm g, const Sched& S, const Epi& E) {
    const int tid = threadIdx.x, wid = __builtin_amdgcn_readfirstlane(tid >> 6), lane = tid & 63, wr = wid >> 2, wc = wid & 3, fr = lane & 15, fq = lane >> 4;
    const int K = g.K, nt = K / BK;
    unsigned voffA[2], voffB[2];
#pragma unroll
    for (int i = 0; i < 2; ++i) { int R, C; stage_rc(tid * 16 + i * 8192, R, C); const int Rb = Epi::PERM ? ((R & ~31) + perm32(R & 31)) : R;
        voffA[i] = (unsigned)(R * g.lda + C) * 2u; voffB[i] = (unsigned)(Rb * K + C) * 2u; }
    const size_t kstep = (size_t)(BK * 2);
    const size_t hstepA = (size_t)HALF * g.lda * 2, hstepB = (size_t)HALF * K * 2;
    const size_t tstepA = 2 * hstepA, tstepB = 2 * hstepB;
    const unsigned ldsw = (unsigned)wid * 1024u;
    const int aoff = lds_byte(wr * 64 + fr, fq * 8), boff = lds_byte(wc * 32 + fr, fq * 8);
#define PG8_SA(b, h) (((b) * 2 + (h)) * HTB)
#define PG8_SB(b, h) ((4 + (b) * 2 + (h)) * HTB)
#define PG8_STAGE(bufoff, gbase, voff) do { _Pragma("unroll") for (int _i = 0; _i < 2; ++_i) \
        __builtin_amdgcn_global_load_lds((const unsigned*)((const char*)(gbase) + (voff)[_i]), (PG8_LAS unsigned*)(lds + (bufoff) + ldsw + _i * 8192), 16, 0, 0); } while (0)
#define PG8_LDA(dst, b, h) do { _Pragma("unroll") for (int m = 0; m < 4; ++m) _Pragma("unroll") for (int k = 0; k < 2; ++k) dst[m][k] = *(const PG8_LAS bf16x8*)(lds + PG8_SA(b, h) + aoff + m * 2048 + k * 1024); } while (0)
#define PG8_LDB(dst, b, h) do { _Pragma("unroll") for (int n = 0; n < 2; ++n) _Pragma("unroll") for (int k = 0; k < 2; ++k) dst[n][k] = *(const PG8_LAS bf16x8*)(lds + PG8_SB(b, h) + boff + n * 2048 + k * 1024); } while (0)
#define PG8_MMA(ai, bj, At, Bt) do { __builtin_amdgcn_s_setprio(1); _Pragma("unroll") for (int m = 0; m < 4; ++m) _Pragma("unroll") for (int n = 0; n < 2; ++n) _Pragma("unroll") for (int k = 0; k < 2; ++k) \
        acc[ai][bj][m][n] = __builtin_amdgcn_mfma_f32_16x16x32_bf16(Bt[n][k], At[m][k], acc[ai][bj][m][n], 0, 0, 0); __builtin_amdgcn_s_setprio(0); } while (0)
#define PG8_WAIT_V(n) asm volatile("s_waitcnt vmcnt(" #n ")" ::: "memory")
#define PG8_WAIT_L(n) asm volatile("s_waitcnt lgkmcnt(" #n ")" ::: "memory")
#define PG8_BAR __builtin_amdgcn_s_barrier()
#define PG8_SCHED __builtin_amdgcn_sched_barrier(0)
    Unit cur, nxt; int ui = 0;
    if (!S.next(0, cur)) return;
    f32x4 acc[2][2][4][2];
#pragma unroll
    for (int a = 0; a < 2; ++a)
#pragma unroll
        for (int b = 0; b < 2; ++b)
#pragma unroll
            for (int m = 0; m < 4; ++m)
#pragma unroll
                for (int n = 0; n < 2; ++n) acc[a][b][m][n] = (f32x4){0.f, 0.f, 0.f, 0.f};
    bf16x8 At[4][2], B0[2][2], B1[2][2];
    const char* cA = (const char*)g.A + (size_t)cur.pm * tstepA; const char* cB = (const char*)g.Bt + (size_t)cur.pn * tstepB;
    S.a_ready(cur);
    if constexpr (SP2) {
        PG8_STAGE(PG8_SB(0, 0), cB, voffB); PG8_STAGE(PG8_SB(0, 1), cB + hstepB, voffB); PG8_STAGE(PG8_SA(0, 0), cA, voffA); PG8_STAGE(PG8_SA(0, 1), cA + hstepA, voffA);
        if (wr == 1) PG8_BAR;
        PG8_WAIT_V(2); PG8_BAR;
        PG8_STAGE(PG8_SB(1, 0), cB + kstep, voffB); PG8_STAGE(PG8_SA(1, 0), cA + kstep, voffA); PG8_STAGE(PG8_SB(1, 1), cB + hstepB + kstep, voffB);
        PG8_WAIT_V(6); PG8_BAR;
    } else {
        PG8_STAGE(PG8_SB(0, 0), cB, voffB); PG8_STAGE(PG8_SA(0, 0), cA, voffA); PG8_STAGE(PG8_SB(0, 1), cB + hstepB, voffB); PG8_STAGE(PG8_SA(0, 1), cA + hstepA, voffA);
        if (wr == 1) PG8_BAR;
        PG8_WAIT_V(4); PG8_BAR;
        PG8_STAGE(PG8_SB(1, 0), cB + kstep, voffB); PG8_STAGE(PG8_SA(1, 0), cA + kstep, voffA); PG8_STAGE(PG8_SB(1, 1), cB + hstepB + kstep, voffB);
        PG8_WAIT_V(6); PG8_BAR;
    }
    for (;;) {
        const bool has_next = S.next(ui + 1, nxt);
        const char* nA = has_next ? (const char*)g.A + (size_t)nxt.pm * tstepA : cA; const char* nB = has_next ? (const char*)g.Bt + (size_t)nxt.pn * tstepB : cB;
        for (int t = 0; t < nt; t += 2) {
            const bool last = (t == nt - 2);
            const char* a1 = cA + (size_t)(t + 1) * kstep;
            const char* a2 = last ? nA : cA + (size_t)(t + 2) * kstep; const char* b2 = last ? nB : cB + (size_t)(t + 2) * kstep;
            const char* a3 = a2 + kstep; const char* b3 = b2 + kstep;
            if (last && has_next) S.a_ready(nxt);
            if constexpr (SP2) {
            PG8_LDB(B0, 0, 0); PG8_LDB(B1, 0, 1); PG8_SCHED; PG8_LDA(At, 0, 0); PG8_STAGE(PG8_SA(1, 1), a1 + hstepA, voffA);
            PG8_WAIT_V(8); PG8_WAIT_L(0); PG8_BAR; PG8_MMA(0, 0, At, B0); PG8_MMA(0, 1, At, B1); PG8_BAR; PG8_SCHED;
            PG8_LDA(At, 0, 1); PG8_STAGE(PG8_SB(0, 0), b2, voffB); PG8_STAGE(PG8_SB(0, 1), b2 + hstepB, voffB); PG8_STAGE(PG8_SA(0, 0), a2, voffA);
            PG8_WAIT_V(8); PG8_WAIT_L(0); PG8_BAR; PG8_MMA(1, 0, At, B0); PG8_MMA(1, 1, At, B1); PG8_BAR; PG8_SCHED;
            PG8_LDB(B0, 1, 0); PG8_LDB(B1, 1, 1); PG8_SCHED; PG8_LDA(At, 1, 0); PG8_STAGE(PG8_SA(0, 1), a2 + hstepA, voffA);
            PG8_WAIT_V(8); PG8_WAIT_L(0); PG8_BAR; PG8_MMA(0, 0, At, B0); PG8_MMA(0, 1, At, B1); PG8_BAR; PG8_SCHED;
            PG8_LDA(At, 1, 1); PG8_STAGE(PG8_SB(1, 0), b3, voffB); PG8_STAGE(PG8_SB(1, 1), b3 + hstepB, voffB); PG8_STAGE(PG8_SA(1, 0), a3, voffA);
            PG8_WAIT_V(8); PG8_WAIT_L(0); PG8_BAR; PG8_MMA(1, 0, At, B0); PG8_MMA(1, 1, At, B1); PG8_BAR; PG8_SCHED;
            } else {
            PG8_LDB(B0, 0, 0); PG8_SCHED; PG8_LDA(At, 0, 0); PG8_STAGE(PG8_SA(1, 1), a1 + hstepA, voffA);
            PG8_WAIT_L(8); PG8_BAR; PG8_WAIT_L(0); PG8_MMA(0, 0, At, B0); PG8_BAR; PG8_SCHED;
            PG8_LDB(B1, 0, 1); PG8_STAGE(PG8_SB(0, 0), b2, voffB);
            PG8_BAR; PG8_WAIT_L(0); PG8_MMA(0, 1, At, B1); PG8_BAR;
            PG8_LDA(At, 0, 1); PG8_STAGE(PG8_SA(0, 0), a2, voffA);
            PG8_BAR; PG8_WAIT_L(0); PG8_MMA(1, 0, At, B0); PG8_BAR; PG8_SCHED;
            PG8_STAGE(PG8_SB(0, 1), b2 + hstepB, voffB);
            PG8_WAIT_V(6); PG8_BAR; PG8_MMA(1, 1, At, B1); PG8_BAR;
            PG8_LDB(B0, 1, 0); PG8_SCHED; PG8_LDA(At, 1, 0); PG8_STAGE(PG8_SA(0, 1), a2 + hstepA, voffA);
            PG8_WAIT_L(8); PG8_BAR; PG8_WAIT_L(0); PG8_MMA(0, 0, At, B0); PG8_BAR; PG8_SCHED;
            PG8_LDB(B1, 1, 1); PG8_STAGE(PG8_SB(1, 0), b3, voffB);
            PG8_BAR; PG8_WAIT_L(0); PG8_MMA(0, 1, At, B1); PG8_BAR;
            PG8_LDA(At, 1, 1); PG8_STAGE(PG8_SA(1, 0), a3, voffA);
            PG8_BAR; PG8_WAIT_L(0); PG8_MMA(1, 0, At, B0); PG8_BAR; PG8_SCHED;
            PG8_STAGE(PG8_SB(1, 1), b3 + hstepB, voffB);
            PG8_WAIT_V(6); PG8_BAR; PG8_MMA(1, 1, At, B1); PG8_BAR;
            }
        }
        if constexpr (ALIGN_EPI) { if (wr == 0) PG8_BAR; }
        if constexpr (!Epi::AFTER_DRAIN) { E(acc, cur, wr, wc, fr, fq); S.done(cur); }
        if (!has_next) break;
#pragma unroll
        for (int a = 0; a < 2; ++a)
#pragma unroll
            for (int b = 0; b < 2; ++b)
#pragma unroll
                for (int m = 0; m < 4; ++m)
#pragma unroll
                    for (int n = 0; n < 2; ++n) acc[a][b][m][n] = (f32x4){0.f, 0.f, 0.f, 0.f};
        cur = nxt; cA = nA; cB = nB; ++ui;
        if constexpr (ALIGN_EPI) { if (wr == 1) PG8_BAR; }
    }
    PG8_WAIT_V(0);
    if constexpr (!ALIGN_EPI) { if (wr == 0) PG8_BAR; }
    PG8_BAR;
    if constexpr (Epi::AFTER_DRAIN) { E.fused(acc, cur, wr, wc, fr, fq, lds, wid, lane); S.done(cur); }
#undef PG8_SA
#undef PG8_SB
#undef PG8_STAGE
#undef PG8_LDA
#undef PG8_LDB
#undef PG8_MMA
#undef PG8_WAIT_V
#undef PG8_WAIT_L
#undef PG8_BAR
#undef PG8_SCHED
}
}

template <int MODE>
__device__ __forceinline__ void p0_transpose_item(const float* W, int K, int Nsrc, int nblk, bf16_t* WT, const float* gvec, LAS float* scr, int item, int lane) {
    const int kb = item / nblk, nb = item % nblk, k0 = 64 * kb, n0 = 32 * nb;
    const int nd = n0 + (lane & 31);
    const int col = (MODE == 0) ? colmap0(nd) : nd;
#pragma unroll 8
    for (int i = 0; i < 32; ++i) { const int kk = 2 * i + (lane >> 5);
        float v = (col >= 0) ? W[(size_t)(k0 + kk) * Nsrc + col] : 0.f;
        if (MODE != 1) v *= gvec[k0 + kk];
        scr[kk * 33 + (lane & 31)] = v; }
    asm volatile("s_waitcnt lgkmcnt(0)" ::: "memory");
    const int c = lane & 7;
#pragma unroll
    for (int j = 0; j < 4; ++j) { const int n = (lane >> 3) + 8 * j; const LAS float* s = scr + (8 * c) * 33 + n;
        u32x4 o; o.x = pk2(s[0 * 33], s[1 * 33]); o.y = pk2(s[2 * 33], s[3 * 33]); o.z = pk2(s[4 * 33], s[5 * 33]); o.w = pk2(s[6 * 33], s[7 * 33]);
        *(u32x4*)(WT + (size_t)(n0 + n) * K + k0 + 8 * c) = o; }
    asm volatile("s_waitcnt lgkmcnt(0)" ::: "memory");
}

__device__ __forceinline__ void p0_prologue(const Args& a, LAS unsigned char* lds, int vcu, int G, int wave, int lane) {
    unsigned char* ws = a.ws;
    LAS float* scr = (LAS float*)(lds + wave * 16384);
    const int gw = vcu * NWAVES + wave, NGW = G * NWAVES;
    constexpr int I0 = (DM / 64) * (N0 / 32), IO = (MIXW / 64) * (DM / 32), I1 = (DM / 64) * (N1 / 32);
    constexpr int NITEMS = I0 + IO + I1 + IO;
    for (int it = gw; it < NITEMS; it += NGW) {
        int r = it;
        if (r < I0) { p0_transpose_item<0>(a.in[2], DM, N0_SRC, N0 / 32, (bf16_t*)(ws + WS_WT0), a.in[1], scr, r, lane); continue; } r -= I0;
        if (r < IO) { p0_transpose_item<1>(a.in[12], MIXW, DM, DM / 32, (bf16_t*)(ws + WS_WTO0), nullptr, scr, r, lane); continue; } r -= IO;
        if (r < I1) { p0_transpose_item<2>(a.in[14], DM, N1, N1 / 32, (bf16_t*)(ws + WS_WT1), a.in[13], scr, r, lane); continue; } r -= I1;
        p0_transpose_item<1>(a.in[19], MIXW, DM, DM / 32, (bf16_t*)(ws + WS_WTO1), nullptr, scr, r, lane);
    }
    for (int it = gw; it < 2 * (256 + 8); it += NGW) {
        const int kv = it / 264, r = it % 264;
        if (r < 256) p0_transpose_item<1>(a.in[kv ? 9 : 5], 4096, 128, 4, (bf16_t*)(ws + WS_W1T) + (size_t)kv * 128 * 4096, nullptr, scr, r, lane);
        else p0_transpose_item<1>(a.in[kv ? 11 : 7], 128, 128, 4, (bf16_t*)(ws + WS_W2T) + (size_t)kv * 128 * 128, nullptr, scr, r - 256, lane);
    }
    {
        const int gt0 = gw * 64 + lane, NGT0 = NGW * 64;
        bf16_t* SW = (bf16_t*)(ws + WS_SW); const float* wsp = a.in[17];
        for (int i = gt0; i < 16 * 128 * 128; i += NGT0) { const int s = i & 127, t = (i >> 7) & 127; SW[i] = (bf16_t)(s <= t ? f2bf(wsp[i]) : 0u); }
        float* PBP = (float*)(ws + WS_PBP);
        for (int i = gt0; i < 2 * 32 * 128; i += NGT0) { const int j = i & 127, ic = (i >> 7) & 31, kv = i >> 12;
            const float* pos = a.in[kv ? 8 : 4] + ic * 128; const float* w1 = a.in[kv ? 9 : 5] + (size_t)ic * 128 * 128 + j; float s = 0.f;
            for (int q = 0; q < 128; ++q) s += pos[q] * w1[(size_t)q * 128]; PBP[i] = s; }
    }
    const float* x = a.in[0]; bf16_t* XB = (bf16_t*)(ws + WS_XB); float* rstd0 = (float*)(ws + WS_RSTD0);
    for (int m = gw; m < MTOK; m += NGW) {
        const f32x4* xr = (const f32x4*)(x + (size_t)m * DM) + lane;
        u32x2* o8 = (u32x2*)(XB + (size_t)m * DM) + lane;
        float s = 0.f;
#pragma unroll
        for (int j = 0; j < 8; ++j) { const f32x4 v = xr[64 * j]; s += (v.x * v.x + v.y * v.y) + (v.z * v.z + v.w * v.w);
            u32x2 w; w.x = pk2(v.x, v.y); w.y = pk2(v.z, v.w); o8[64 * j] = w; }
        s = wave_sum(s);
        if (lane == 0) rstd0[m] = 1.0f / sqrtf(s * (1.0f / DM) + EPS);
    }
    const int gt = gw * 64 + lane, NGT = NGW * 64;
    float* SS1 = (float*)(ws + WS_SS1); float* LNS = (float*)(ws + WS_LNS);
    for (int i = gt; i < MTOK; i += NGT) { SS1[i] = 0.f; LNS[2 * i] = 0.f; LNS[2 * i + 1] = 0.f; }
    float* COS = (float*)(ws + WS_COS); float* SIN = (float*)(ws + WS_SIN);
    for (int i = gt; i < SEQ * 16; i += NGT) { const int t = i >> 4, f = i & 15;
        const float inv = powf(500000.0f, -((float)f * 2.0f) / 32.0f); const float ang = (float)t * inv;
        COS[i] = cosf(ang); SIN[i] = sinf(ang); }
}

__device__ __forceinline__ void p2_conv(const Args& a, int gt, int NGT, bool dry = false) {
    bf16_t* ZC = (bf16_t*)(a.ws + WS_ZC); const float* cw = a.in[3];
    for (int idx = gt; idx < MTOK * 256; idx += NGT) {
        const int row = idx >> 8, c8 = (idx & 255) * 8, t = row & (SEQ - 1);
        bf16_t* base = ZC + (size_t)row * ZC_LD + c8;
        const u32x4 cb = *(const u32x4*)base, cg = *(const u32x4*)(base + 6144);
        const u32x4 cc0 = *(const u32x4*)(base + 2048), ch0 = *(const u32x4*)(base + 4096);
        u32x4 cc1 = {0, 0, 0, 0}, ch1 = {0, 0, 0, 0}, cc2 = {0, 0, 0, 0}, ch2 = {0, 0, 0, 0};
        if (t >= 1) { cc1 = *(const u32x4*)(base - ZC_LD + 2048); ch1 = *(const u32x4*)(base - ZC_LD + 4096); }
        if (t >= 2) { cc2 = *(const u32x4*)(base - 2 * ZC_LD + 2048); ch2 = *(const u32x4*)(base - 2 * ZC_LD + 4096); }
        float w0[8], w1[8], w2[8];
#pragma unroll
        for (int j = 0; j < 8; ++j) { w0[j] = cw[c8 + j]; w1[j] = cw[DM + c8 + j]; w2[j] = cw[2 * DM + c8 + j]; }
        u32x4 o;
#pragma unroll
        for (int q = 0; q < 4; ++q) {
            float r[2];
#pragma unroll
            for (int hh = 0; hh < 2; ++hh) {
                const int j = 2 * q + hh;
                const float p0 = hh ? bf_hi(cc0[q]) * bf_hi(ch0[q]) : bf_lo(cc0[q]) * bf_lo(ch0[q]);
                const float p1 = hh ? bf_hi(cc1[q]) * bf_hi(ch1[q]) : bf_lo(cc1[q]) * bf_lo(ch1[q]);
                const float p2 = hh ? bf_hi(cc2[q]) * bf_hi(ch2[q]) : bf_lo(cc2[q]) * bf_lo(ch2[q]);
                const float conv = w0[j] * p2 + w1[j] * p1 + w2[j] * p0;
                const float b = hh ? bf_hi(cb[q]) : bf_lo(cb[q]); const float g = hh ? bf_hi(cg[q]) : bf_lo(cg[q]);
                r[hh] = b * conv * silu_f(g);
            }
            o[q] = pk2(r[0], r[1]);
        }
        *(u32x4*)(dry ? (bf16_t*)(a.ws + WS_DUMMY) + (threadIdx.x * 8) : base) = o;
    }
}

__device__ __forceinline__ void p2_compress(const Args& a, LAS unsigned char* lds, int blk, int G, int tid) {
    LAS float* tok = (LAS float*)lds;
    LAS float* pos = (LAS float*)(lds + 73728);
    LAS float* red = (LAS float*)(lds + 73728 + 16384);
    LAS float* hid = (LAS float*)(lds + 73728 + 32768);
    const int j = tid & 127, iq = tid >> 7;
    for (int unit = blk; unit < 2 * 16 * 16; unit += G) {
        const int kv = unit >> 8, bg = (unit >> 4) & 15, cg8 = unit & 15;
        const bf16_t* src = (const bf16_t*)(a.ws + WS_KV) + (size_t)kv * KV_ELEMS + ((size_t)bg * SEQ + 128 * cg8) * HD;
        const float* posg = a.in[kv ? 8 : 4]; const float* w1 = a.in[kv ? 9 : 5]; const float* b1 = a.in[kv ? 10 : 6]; const float* w2 = a.in[kv ? 11 : 7];
        const int ntok = (cg8 == 15) ? 128 : 144;
        __syncthreads();
        for (int i = tid; i < ntok * 128; i += NTHREADS) tok[i] = bf2f(src[i]);
        for (int i = tid; i < 4096; i += NTHREADS) pos[i] = posg[i];
        __syncthreads();
        float acc[8];
#pragma unroll
        for (int cc = 0; cc < 8; ++cc) acc[cc] = 0.f;
        const int ncc = (cg8 == 15) ? 7 : 8;
        for (int i = iq * 1024; i < iq * 1024 + 1024; ++i) {
            const float w = w1[(size_t)i * 128 + j]; const float p = pos[i];
#pragma unroll
            for (int cc = 0; cc < 8; ++cc) if (cc < ncc) acc[cc] += (tok[cc * 2048 + i] + p) * w;
        }
#pragma unroll
        for (int cc = 0; cc < 8; ++cc) red[(iq * 8 + cc) * 128 + j] = acc[cc];
        __syncthreads();
        for (int i = tid; i < 8 * 128; i += NTHREADS) { const int jj = i & 127;
            const float h = red[i] + red[1024 + i] + red[2048 + i] + red[3072 + i] + b1[jj]; hid[i] = silu_f(h); }
        __syncthreads();
        bf16_t* dst = (bf16_t*)(a.ws + (kv ? WS_VC : WS_KC)) + (size_t)bg * 128 * 128;
        for (int o = tid; o < 8 * 128; o += NTHREADS) { const int cc = o >> 7, d = o & 127;
            if (cc >= ncc) { if (cg8 == 15 && cc == 7) dst[(size_t)127 * 128 + d] = 0; }
            else { float s = 0.f;
                for (int jj = 0; jj < 128; ++jj) s += hid[cc * 128 + jj] * w2[jj * 128 + d];
                dst[(size_t)(8 * cg8 + cc) * 128 + d] = (bf16_t)f2bf(s); } }
    }
    __syncthreads();
}

__device__ __forceinline__ void attn_batch(const bf16_t* Kb, const bf16_t* Vb, int first, int lo, int hi, bool valid, const LAS float* qs,
                                           float (&m)[4], float (&l)[4], float (&o)[4][2], int lane) {
    int kr = first + lane; kr = kr < lo ? lo : (kr > hi ? hi : kr);
    const u32x4* kp = (const u32x4*)(Kb + (size_t)kr * HD);
    float s[4] = {0.f, 0.f, 0.f, 0.f};
#pragma unroll 4
    for (int c = 0; c < 16; ++c) { const u32x4 kv = kp[c];
        float kf[8]; kf[0] = bf_lo(kv.x); kf[1] = bf_hi(kv.x); kf[2] = bf_lo(kv.y); kf[3] = bf_hi(kv.y); kf[4] = bf_lo(kv.z); kf[5] = bf_hi(kv.z); kf[6] = bf_lo(kv.w); kf[7] = bf_hi(kv.w);
#pragma unroll
        for (int h = 0; h < 4; ++h) { const LAS f32x4* q4 = (const LAS f32x4*)(qs + h * HD + c * 8); const f32x4 qa = q4[0], qb = q4[1];
            s[h] += (qa[0] * kf[0] + qa[1] * kf[1]) + (qa[2] * kf[2] + qa[3] * kf[3]) + (qb[0] * kf[4] + qb[1] * kf[5]) + (qb[2] * kf[6] + qb[3] * kf[7]); }
    }
    float ps[4];
#pragma unroll
    for (int h = 0; h < 4; ++h) {
        const float sv = valid ? s[h] : -INFINITY;
        const float bm = wave_max(sv); const float mn = fmaxf(m[h], bm);
        float p = 0.f, alpha = 1.f;
        if (mn > -INFINITY) { p = valid ? __expf(sv - mn) : 0.f; alpha = (m[h] > -INFINITY) ? __expf(m[h] - mn) : 0.f; }
        l[h] = l[h] * alpha + wave_sum(p); o[h][0] *= alpha; o[h][1] *= alpha; m[h] = mn; ps[h] = p;
    }
    for (int jj = 0; jj < 64; ++jj) {
        int vr = first + jj; vr = vr < lo ? lo : (vr > hi ? hi : vr);
        const unsigned vv = *(const unsigned*)(Vb + (size_t)vr * HD + 2 * lane);
        const float v0 = bf_lo(vv), v1 = bf_hi(vv);
#pragma unroll
        for (int h = 0; h < 4; ++h) { const float pj = __shfl(ps[h], jj); o[h][0] += pj * v0; o[h][1] += pj * v1; }
    }
}

__device__ __forceinline__ void p3_nsa_naive(const Args& a, LAS unsigned char* lds, int gw, int NGW, int wave, int lane) {
    unsigned char* ws = a.ws;
    LAS float* qs = (LAS float*)(lds + wave * 8192);
    LAS float* qr = qs + 512;
    LAS float* Pc = qr + 512;
    const bf16_t* Q = (const bf16_t*)(ws + WS_Q); const bf16_t* KVb = (const bf16_t*)(ws + WS_KV);
    const bf16_t* KC = (const bf16_t*)(ws + WS_KC); const bf16_t* VC = (const bf16_t*)(ws + WS_VC);
    const float* GL = (const float*)(ws + WS_GL); const bf16_t* NG = (const bf16_t*)(ws + WS_NG);
    const float* COS = (const float*)(ws + WS_COS); const float* SIN = (const float*)(ws + WS_SIN);
    bf16_t* ZC = (bf16_t*)(ws + WS_ZC);
    const float scale = 0.08838834764831845f;
    for (int task = gw; task < NB * NKV * SEQ; task += NGW) {
        const int t = task & (SEQ - 1), bg = task >> 11, b = bg >> 2, g = bg & 3;
        const int row = b * SEQ + t;
        { const u32x4 qv = *(const u32x4*)(Q + (size_t)row * DM + g * 512 + lane * 8);
          float f[8]; f[0] = bf_lo(qv.x); f[1] = bf_hi(qv.x); f[2] = bf_lo(qv.y); f[3] = bf_hi(qv.y); f[4] = bf_lo(qv.z); f[5] = bf_hi(qv.z); f[6] = bf_lo(qv.w); f[7] = bf_hi(qv.w);
#pragma unroll
          for (int j = 0; j < 8; ++j) { qs[lane * 8 + j] = f[j] * scale; qr[lane * 8 + j] = f[j] * scale; } }
        asm volatile("s_waitcnt lgkmcnt(0)" ::: "memory");
        { const int h = lane >> 4, i = lane & 15; const float x1 = qs[h * HD + i], x2 = qs[h * HD + 16 + i]; const float c = COS[t * 16 + i], s = SIN[t * 16 + i];
          qr[h * HD + i] = x1 * c - x2 * s; qr[h * HD + 16 + i] = x2 * c + x1 * s; }
        asm volatile("s_waitcnt lgkmcnt(0)" ::: "memory");
        float oc[4][2], Pl0 = 0.f, Pl1 = 0.f;
        {
            const bf16_t* Kc = KC + (size_t)bg * 128 * 128; const bf16_t* Vc = VC + (size_t)bg * 128 * 128;
            const int c0 = lane, c1 = 64 + lane;
            const bool v0 = (16 * c0 + 31 <= t), v1 = (c1 < NCMP) && (16 * c1 + 31 <= t);
            const int r1 = c1 < NCMP ? c1 : NCMP - 1;
            float s0[4] = {0.f, 0.f, 0.f, 0.f}, s1[4] = {0.f, 0.f, 0.f, 0.f};
            const u32x4* k0p = (const u32x4*)(Kc + (size_t)c0 * HD); const u32x4* k1p = (const u32x4*)(Kc + (size_t)r1 * HD);
#pragma unroll 2
            for (int c = 0; c < 16; ++c) { const u32x4 ka = k0p[c], kb = k1p[c];
                float fa[8], fb[8];
                fa[0] = bf_lo(ka.x); fa[1] = bf_hi(ka.x); fa[2] = bf_lo(ka.y); fa[3] = bf_hi(ka.y); fa[4] = bf_lo(ka.z); fa[5] = bf_hi(ka.z); fa[6] = bf_lo(ka.w); fa[7] = bf_hi(ka.w);
                fb[0] = bf_lo(kb.x); fb[1] = bf_hi(kb.x); fb[2] = bf_lo(kb.y); fb[3] = bf_hi(kb.y); fb[4] = bf_lo(kb.z); fb[5] = bf_hi(kb.z); fb[6] = bf_lo(kb.w); fb[7] = bf_hi(kb.w);
#pragma unroll
                for (int h = 0; h < 4; ++h)
#pragma unroll
                    for (int jj = 0; jj < 8; ++jj) { const float qv = qs[h * HD + c * 8 + jj]; s0[h] += qv * fa[jj]; s1[h] += qv * fb[jj]; } }
            float p0[4], p1[4];
#pragma unroll
            for (int h = 0; h < 4; ++h) {
                const float a0 = v0 ? s0[h] : -INFINITY, a1 = v1 ? s1[h] : -INFINITY;
                const float mx = wave_max(fmaxf(a0, a1));
                float e0 = 0.f, e1 = 0.f;
                if (mx > -INFINITY) { e0 = v0 ? __expf(a0 - mx) : 0.f; e1 = v1 ? __expf(a1 - mx) : 0.f; }
                const float den = wave_sum(e0 + e1); const float inv = den > 0.f ? 1.0f / den : 1.0f;
                p0[h] = e0 * inv; p1[h] = e1 * inv; Pl0 += p0[h]; Pl1 += p1[h];
                oc[h][0] = 0.f; oc[h][1] = 0.f;
            }
            for (int jj = 0; jj < 64; ++jj) {
                const unsigned va = *(const unsigned*)(Vc + (size_t)jj * HD + 2 * lane);
                const int rr = (64 + jj) < NCMP ? (64 + jj) : NCMP - 1;
                const unsigned vb = *(const unsigned*)(Vc + (size_t)rr * HD + 2 * lane);
#pragma unroll
                for (int h = 0; h < 4; ++h) { const float pa = __shfl(p0[h], jj), pb = __shfl(p1[h], jj);
                    oc[h][0] += pa * bf_lo(va) + pb * bf_lo(vb); oc[h][1] += pa * bf_hi(va) + pb * bf_hi(vb); }
            }
            Pc[lane] = Pl0; Pc[64 + lane] = Pl1;
        }
        asm volatile("s_waitcnt lgkmcnt(0)" ::: "memory");
        unsigned selmask = 0u;
        {
            const int cur = t >> 6;
            float val = -INFINITY;
            if (lane < 32) {
                if (lane == 0 || lane == cur) val = INFINITY;
                else if (64 * lane <= t) { float s = 0.f;
                    for (int c = 4 * lane - 1; c <= 4 * lane + 3; ++c) if (c >= 0 && c < NCMP) s += Pc[c];
                    val = s; }
            }
            bool taken = (lane >= 32);
            for (int r = 0; r < 8; ++r) {
                const float cand = taken ? -INFINITY : val;
                const float mx = wave_max(cand);
                if (!(mx > -INFINITY)) break;
                const unsigned long long bal = __ballot(!taken && cand == mx);
                const int idx = __ffsll((long long)bal) - 1;
                selmask |= 1u << idx;
                if (lane == idx) taken = true;
            }
        }
        float os[4][2], ms[4], ls[4];
#pragma unroll
        for (int h = 0; h < 4; ++h) { os[h][0] = 0.f; os[h][1] = 0.f; ms[h] = -INFINITY; ls[h] = 0.f; }
        {
            const bf16_t* Ks = KVb + 2 * KV_ELEMS + (size_t)bg * SEQ * HD; const bf16_t* Vs = KVb + 3 * KV_ELEMS + (size_t)bg * SEQ * HD;
            unsigned mk = selmask;
            while (mk) { const int jb = __ffs((int)mk) - 1; mk &= mk - 1;
                attn_batch(Ks, Vs, 64 * jb, 0, SEQ - 1, (64 * jb + lane) <= t, qr, ms, ls, os, lane); }
        }
        float ow[4][2], mw[4], lw[4];
#pragma unroll
        for (int h = 0; h < 4; ++h) { ow[h][0] = 0.f; ow[h][1] = 0.f; mw[h] = -INFINITY; lw[h] = 0.f; }
        {
            const bf16_t* Kw = KVb + 4 * KV_ELEMS + (size_t)bg * SEQ * HD; const bf16_t* Vw = KVb + 5 * KV_ELEMS + (size_t)bg * SEQ * HD;
            const int first = t - 511;
            for (int b8 = 0; b8 < 8; ++b8) { const int f0 = first + 64 * b8;
                if (f0 + 63 < 0) continue;
                attn_batch(Kw, Vw, f0, 0, SEQ - 1, (f0 + lane) >= 0, qr, mw, lw, ow, lane); }
        }
#pragma unroll
        for (int h = 0; h < 4; ++h) {
            const int hh = g * 4 + h;
            const float g0 = sigmoid_f(GL[(size_t)row * 48 + hh]), g1 = sigmoid_f(GL[(size_t)row * 48 + 16 + hh]), g2 = sigmoid_f(GL[(size_t)row * 48 + 32 + hh]);
            const float is = ls[h] > 0.f ? 1.0f / ls[h] : 0.f, iw = lw[h] > 0.f ? 1.0f / lw[h] : 0.f;
            const unsigned ngv = *(const unsigned*)(NG + (size_t)row * DM + hh * HD + 2 * lane);
            const float y0 = (g0 * oc[h][0] + g1 * os[h][0] * is + g2 * ow[h][0] * iw) * silu_f(bf_lo(ngv));
            const float y1 = (g0 * oc[h][1] + g1 * os[h][1] * is + g2 * ow[h][1] * iw) * silu_f(bf_hi(ngv));
            *(unsigned*)(ZC + (size_t)row * ZC_LD + 2048 + hh * HD + 2 * lane) = pk2(y0, y1);
        }
    }
}


namespace nsa {
typedef float f32x16 __attribute__((ext_vector_type(16)));
typedef short s16x4 __attribute__((ext_vector_type(4)));
constexpr int KVBLK = 64, SHM = 16384;
constexpr float SCALE = 0.08838834764831845f, THR = 8.f;
constexpr int L_V = 0, L_K = 32768, L_WS = 65536, L_SEL = 67584, L_UNI = 67840, L_GS = 68608, L_LS = L_GS + 33792, L_IMP = L_LS + 33792, L_END = L_IMP + 8448;
static_assert(L_END <= LDS_BYTES, "nsa lds");
#define KSWZ(row, colB) ((row) * 256 + ((colB) ^ (((row) & 7) << 4)))
#define SBAR() __builtin_amdgcn_sched_barrier(0)
__device__ __forceinline__ int v_st(int k, int c) { const int kk = (k & ~0xC) | ((k & 4) << 1) | ((k & 8) >> 1); return ((kk >> 3) * 4 + (c >> 5)) * 512 + ((kk & 7) * 32 + (c & 31)) * 2; }
__device__ __forceinline__ int v_rd_base(int lane) { return ((lane & 3) << 3) | (((lane >> 2) & 3) << 6) | (((lane >> 4) & 1) << 5) | (((lane >> 5) & 1) << 8); }
constexpr int v_rd_off(int d0, int ks, int half) { return d0 * 512 + ks * 4096 + half * 2048; }
__device__ __forceinline__ int crow(int r, int hi) { return (r & 3) + 8 * (r >> 2) + 4 * hi; }
__device__ __forceinline__ bf16x8 pack8(f32x4 a, f32x4 b) {
    u32x4 w = {cvt_pk_bf16(a[0], a[1]), cvt_pk_bf16(a[2], a[3]), cvt_pk_bf16(b[0], b[1]), cvt_pk_bf16(b[2], b[3])};
    return *reinterpret_cast<bf16x8*>(&w);
}
__device__ __forceinline__ void mask_tile(f32x16& p0, f32x16& p1, int dq, unsigned W) {
    const float NEG = -__builtin_inff();
#pragma unroll
    for (int r = 0; r < 16; ++r) {
        const int c = (r & 3) + 8 * (r >> 2);
        if ((unsigned)(dq - c) >= W) p0[r] = NEG;
        if ((unsigned)(dq - c - 32) >= W) p1[r] = NEG;
    }
}
__device__ __forceinline__ void mask_all(f32x16& p0, f32x16& p1) {
    const float NEG = -__builtin_inff();
#pragma unroll
    for (int r = 0; r < 16; ++r) { p0[r] = NEG; p1[r] = NEG; }
}
__device__ __forceinline__ void partialSM(f32x16& p0, f32x16& p1, float& m_reg, float& mn, float& alpha) {
    float pmax = p0[0];
#pragma unroll
    for (int r = 1; r < 16; ++r) pmax = fmaxf(pmax, p0[r]);
#pragma unroll
    for (int r = 0; r < 16; ++r) pmax = fmaxf(pmax, p1[r]);
    { auto rr = __builtin_amdgcn_permlane32_swap(__float_as_uint(pmax), __float_as_uint(pmax), false, false);
      pmax = fmaxf(__uint_as_float(rr[0]), __uint_as_float(rr[1])); }
    constexpr float C2 = 1.4426950408889634f * SCALE;
    if (__builtin_expect(__all((pmax - m_reg) * SCALE <= THR), 1)) { mn = m_reg; alpha = 1.f; }
    else { mn = fmaxf(m_reg, pmax); alpha = __builtin_amdgcn_exp2f((m_reg - mn) * C2); m_reg = mn; }
    const float mnL = -mn * C2;
#pragma unroll
    for (int r = 0; r < 16; ++r) p0[r] = fmaf(p0[r], C2, mnL);
#pragma unroll
    for (int r = 0; r < 16; ++r) p1[r] = fmaf(p1[r], C2, mnL);
#pragma unroll
    for (int r = 0; r < 16; ++r) p0[r] = __builtin_amdgcn_exp2f(p0[r]);
}
#define NSA_PK4(P, B_, OUT) do { unsigned a0 = cvt_pk_bf16(P[B_+0], P[B_+1]), a1 = cvt_pk_bf16(P[B_+2], P[B_+3]);                 \
        unsigned b0 = cvt_pk_bf16(P[B_+4], P[B_+5]), b1 = cvt_pk_bf16(P[B_+6], P[B_+7]);                                         \
        auto r0 = __builtin_amdgcn_permlane32_swap(a0, b0, false, false); auto r1 = __builtin_amdgcn_permlane32_swap(a1, b1, false, false); \
        u32x4 w = {r0[0], r1[0], r0[1], r1[1]}; OUT = *reinterpret_cast<bf16x8*>(&w); } while (0)
__device__ __forceinline__ void pack_p(const f32x16& p0, const f32x16& p1, bf16x8& pa0, bf16x8& pa1, bf16x8& pa2, bf16x8& pa3) {
    NSA_PK4(p0, 0, pa0); NSA_PK4(p0, 8, pa1); NSA_PK4(p1, 0, pa2); NSA_PK4(p1, 8, pa3);
}
__device__ __forceinline__ void finishSM(f32x16& p0, f32x16& p1, float alpha, float& l_reg, bf16x8& pa0, bf16x8& pa1, bf16x8& pa2, bf16x8& pa3) {
#pragma unroll
    for (int r = 0; r < 16; ++r) p1[r] = __builtin_amdgcn_exp2f(p1[r]);
    float ps = 0;
#pragma unroll
    for (int r = 0; r < 16; ++r) ps += p0[r];
#pragma unroll
    for (int r = 0; r < 16; ++r) ps += p1[r];
    { auto rr = __builtin_amdgcn_permlane32_swap(__float_as_uint(ps), __float_as_uint(ps), false, false);
      ps = __uint_as_float(rr[0]) + __uint_as_float(rr[1]); }
    l_reg = l_reg * alpha + ps;
    pack_p(p0, p1, pa0, pa1, pa2, pa3);
}
template <int KB>
__device__ __forceinline__ void qkt(f32x16& p0, f32x16& p1, const LAS unsigned char* lds, int r32, int hi, const bf16x8* qr) {
    p0 = f32x16{}; p1 = f32x16{};
    const LAS unsigned char* kb[4];
#pragma unroll
    for (int dd = 0; dd < 4; ++dd) kb[dd] = lds + L_K + KB * SHM + KSWZ(r32, (dd * 16 + hi * 8) * 2);
#pragma unroll
    for (int d0 = 0; d0 < 8; ++d0) { const LAS unsigned char* a = kb[d0 & 3] + (d0 >> 2) * 128;
        const bf16x8 b0 = *reinterpret_cast<const LAS bf16x8*>(a);
        const bf16x8 b1 = *reinterpret_cast<const LAS bf16x8*>(a + 32 * 256);
        p0 = __builtin_amdgcn_mfma_f32_32x32x16_bf16(b0, qr[d0], p0, 0, 0, 0);
        p1 = __builtin_amdgcn_mfma_f32_32x32x16_bf16(b1, qr[d0], p1, 0, 0, 0); }
}
template <int VB>
__device__ __forceinline__ void pv_tile(f32x16* o, int vb0, bf16x8 pa0, bf16x8 pa1, bf16x8 pa2, bf16x8 pa3) {
#define TRRD(dst, off) asm volatile("ds_read_b64_tr_b16 %0, %1 offset:%2" : "=&v"(dst) : "v"(vb0), "i"(off) : "memory")
#define PV_D0(d0) do { s16x4 l0, l1, l2, l3, h0, h1, h2, h3; constexpr int b_ = L_V + VB * SHM + v_rd_off(d0, 0, 0); \
        TRRD(l0, b_); TRRD(h0, b_ + 2048); TRRD(l1, b_ + 4096); TRRD(h1, b_ + 6144); TRRD(l2, b_ + 8192); TRRD(h2, b_ + 10240); TRRD(l3, b_ + 12288); TRRD(h3, b_ + 14336); \
        asm volatile("s_waitcnt lgkmcnt(0)" ::: "memory"); SBAR();   \
        o[d0] = __builtin_amdgcn_mfma_f32_32x32x16_bf16(pa0, (bf16x8){l0[0], l0[1], l0[2], l0[3], h0[0], h0[1], h0[2], h0[3]}, o[d0], 0, 0, 0);   \
        o[d0] = __builtin_amdgcn_mfma_f32_32x32x16_bf16(pa1, (bf16x8){l1[0], l1[1], l1[2], l1[3], h1[0], h1[1], h1[2], h1[3]}, o[d0], 0, 0, 0);   \
        o[d0] = __builtin_amdgcn_mfma_f32_32x32x16_bf16(pa2, (bf16x8){l2[0], l2[1], l2[2], l2[3], h2[0], h2[1], h2[2], h2[3]}, o[d0], 0, 0, 0);   \
        o[d0] = __builtin_amdgcn_mfma_f32_32x32x16_bf16(pa3, (bf16x8){l3[0], l3[1], l3[2], l3[3], h3[0], h3[1], h3[2], h3[3]}, o[d0], 0, 0, 0); } while (0)
    PV_D0(0); PV_D0(1); PV_D0(2); PV_D0(3);
#undef PV_D0
#undef TRRD
}

struct Ctx {
    LAS unsigned char* lds; int tid, wid, lane, r32, hi, sr, sc, vst0, vst1, kws, vb0;
    LAS float* li_l; LAS float* al_l;
};
__device__ __forceinline__ Ctx make_ctx(LAS unsigned char* lds) {
    Ctx c; c.lds = lds; c.tid = threadIdx.x; asm volatile("" : "+v"(c.tid));
    c.wid = __builtin_amdgcn_readfirstlane(c.tid >> 6); c.lane = c.tid & 63; c.r32 = c.lane & 31; c.hi = c.lane >> 5;
    c.sr = c.tid >> 4; c.sc = (c.tid & 15) * 8; c.vst0 = v_st(c.sr, c.sc); c.vst1 = v_st(32 + c.sr, c.sc); c.kws = KSWZ(c.sr, c.sc * 2);
    c.vb0 = (int)(unsigned)(uintptr_t)lds + v_rd_base(c.lane);
    LAS float* wsf = (LAS float*)(lds + L_WS) + c.wid * 64; c.li_l = wsf; c.al_l = wsf + 32;
    return c;
}
struct Stage { bf16x8 k0, k1, v0, v1; };
__device__ __forceinline__ void sload(Stage& S, const bf16_t* Kh, const bf16_t* Vh, int k0, const Ctx& c) {
    S.v0 = *(const bf16x8*)(Vh + (size_t)(k0 + c.sr) * HD + c.sc); S.v1 = *(const bf16x8*)(Vh + (size_t)(k0 + 32 + c.sr) * HD + c.sc);
    S.k0 = *(const bf16x8*)(Kh + (size_t)(k0 + c.sr) * HD + c.sc); S.k1 = *(const bf16x8*)(Kh + (size_t)(k0 + 32 + c.sr) * HD + c.sc);
}
__device__ __forceinline__ void swrite(const Stage& S, int bf, const Ctx& c) {
    *(LAS bf16x8*)(c.lds + L_V + bf * SHM + c.vst0) = S.v0; *(LAS bf16x8*)(c.lds + L_V + bf * SHM + c.vst1) = S.v1;
    *(LAS bf16x8*)(c.lds + L_K + bf * SHM + c.kws) = S.k0; *(LAS bf16x8*)(c.lds + L_K + bf * SHM + c.kws + 32 * 256) = S.k1;
}
__device__ __forceinline__ void rescale_rows(f32x16 (&o)[4], float a, const Ctx& c) {
    if (c.hi == 0) c.al_l[c.r32] = a;
    asm volatile("s_waitcnt lgkmcnt(0)" ::: "memory");
    float s[16];
#pragma unroll
    for (int r = 0; r < 16; ++r) s[r] = c.al_l[crow(r, c.hi)];
#pragma unroll
    for (int d = 0; d < 4; ++d)
#pragma unroll
        for (int r = 0; r < 16; ++r) o[d][r] *= s[r];
    asm volatile("s_waitcnt lgkmcnt(0)" ::: "memory");
}
template <int BUF, int MK>
__device__ __forceinline__ void tile_step(f32x16 (&o)[4], float& m_reg, float& l_reg, const bf16x8* qf, const Ctx& c, int j, int tpos, unsigned sel, int jcur) {
    f32x16 p0, p1; float mn, alpha; bf16x8 pa0, pa1, pa2, pa3;
    if (MK == 1) { const bool act = __any((sel >> j) & 1u); if (!act) return; }
    qkt<BUF>(p0, p1, c.lds, c.r32, c.hi, qf);
    const int dq = tpos - KVBLK * j - 4 * c.hi;
    if (MK == 0) { if (j == jcur || j == jcur - 8) mask_tile(p0, p1, dq, 512u); }
    else { if (j == jcur) mask_tile(p0, p1, dq, 0x7fffffffu);
        const bool on = (sel >> j) & 1u; const float NEG = -__builtin_inff();
#pragma unroll
        for (int r = 0; r < 16; ++r) { p0[r] = on ? p0[r] : NEG; p1[r] = on ? p1[r] : NEG; } }
    partialSM(p0, p1, m_reg, mn, alpha);
    if (__any(alpha < 1.f)) rescale_rows(o, alpha, c);
    finishSM(p0, p1, alpha, l_reg, pa0, pa1, pa2, pa3); SBAR();
    pv_tile<BUF>(o, c.vb0, pa0, pa1, pa2, pa3);
}
template <int MK>
__device__ __forceinline__ void run_tiles(f32x16 (&o)[4], float& m_reg, float& l_reg, const bf16x8* qf, const Ctx& c, const bf16_t* Kh, const bf16_t* Vh,
                                          unsigned tiles, int tpos, unsigned sel, int jcur) {
    Stage S;
    int j = __ffs((int)tiles) - 1; tiles &= tiles - 1;
    sload(S, Kh, Vh, KVBLK * j, c); swrite(S, 0, c);
    __syncthreads();
    for (;;) {
        int jn = tiles ? __ffs((int)tiles) - 1 : -1; tiles &= tiles - 1;
        if (jn >= 0) sload(S, Kh, Vh, KVBLK * jn, c);
        tile_step<0, MK>(o, m_reg, l_reg, qf, c, j, tpos, sel, jcur);
        if (jn >= 0) swrite(S, 1, c);
        __syncthreads();
        if (jn < 0) break;
        j = jn; jn = tiles ? __ffs((int)tiles) - 1 : -1; tiles &= tiles - 1;
        if (jn >= 0) sload(S, Kh, Vh, KVBLK * jn, c);
        tile_step<1, MK>(o, m_reg, l_reg, qf, c, j, tpos, sel, jcur);
        if (jn >= 0) swrite(S, 0, c);
        __syncthreads();
        if (jn < 0) break;
        j = jn;
    }
}
__device__ __forceinline__ void load_q(bf16x8 (&qf)[8], const bf16_t* Q, int row, int h, int hi) {
    const bf16_t* qp = Q + (size_t)row * DM + h * HD + hi * 8;
#pragma unroll
    for (int d0 = 0; d0 < 8; ++d0) qf[d0] = *(const bf16x8*)(qp + d0 * 16);
}
__device__ __forceinline__ void rotate_q(bf16x8& q0, bf16x8& q1, const float* COS, const float* SIN, int t, int hi) {
    const f32x4 c0 = *(const f32x4*)(COS + t * 16 + hi * 8), c1 = *(const f32x4*)(COS + t * 16 + hi * 8 + 4);
    const f32x4 s0 = *(const f32x4*)(SIN + t * 16 + hi * 8), s1 = *(const f32x4*)(SIN + t * 16 + hi * 8 + 4);
    f32x4 a0, a1, b0, b1;
#pragma unroll
    for (int jj = 0; jj < 4; ++jj) { a0[jj] = bf2f((bf16_t)q0[jj]); a1[jj] = bf2f((bf16_t)q0[4 + jj]); b0[jj] = bf2f((bf16_t)q1[jj]); b1[jj] = bf2f((bf16_t)q1[4 + jj]); }
    q0 = pack8(a0 * c0 - b0 * s0, a1 * c1 - b1 * s1);
    q1 = pack8(b0 * c0 + a0 * s0, b1 * c1 + a1 * s1);
}

__device__ __forceinline__ void window_unit(const Args& a, LAS unsigned char* lds, int bg, int qb) {
    unsigned char* ws = a.ws;
    const Ctx c = make_ctx(lds);
    const int n = c.wid >> 1, th = c.wid & 1, tq = 32 * th + c.r32, t = 64 * qb + tq, b = bg >> 2, g = bg & 3, h = g * 4 + n, row = b * SEQ + t;
    bf16x8 qf[8];
    load_q(qf, (const bf16_t*)(ws + WS_Q), row, h, c.hi);
    rotate_q(qf[0], qf[1], (const float*)(ws + WS_COS), (const float*)(ws + WS_SIN), t, c.hi);
    const bf16_t* Kh = (const bf16_t*)(ws + WS_KV) + 4 * KV_ELEMS + (size_t)bg * SEQ * HD; const bf16_t* Vh = (const bf16_t*)(ws + WS_KV) + 5 * KV_ELEMS + (size_t)bg * SEQ * HD;
    f32x16 o[4] = {}; float m_reg = -1e30f, l_reg = 0.f;
    const int jlo = qb >= 8 ? qb - 8 : 0;
    const unsigned tiles = (qb == 31 ? 0xffffffffu : ((1u << (qb + 1)) - 1u)) & ~((1u << jlo) - 1u);
    run_tiles<0>(o, m_reg, l_reg, qf, c, Kh, Vh, tiles, t, 0u, qb);
    const float g2 = sigmoid_f(((const float*)(ws + WS_GL))[(size_t)row * 48 + 32 + h]);
    rescale_rows(o, l_reg > 0.f ? g2 / l_reg : 0.f, c);
    bf16_t* OW = (bf16_t*)(ws + WS_XB);
    const int rbase = b * SEQ + 64 * qb + 32 * th;
#pragma unroll
    for (int r = 0; r < 16; ++r) { const int orow = rbase + crow(r, c.hi);
#pragma unroll
        for (int d0 = 0; d0 < 4; ++d0) { const float v = o[d0][r]; const float vn = __shfl_xor(v, 1);
            if ((c.r32 & 1) == 0) *(unsigned*)(OW + (size_t)orow * DM + h * HD + d0 * 32 + c.r32) = cvt_pk_bf16(v, vn); } }
}

__device__ __forceinline__ void cmpsel_unit(const Args& a, LAS unsigned char* lds, int bg, int qb) {
    unsigned char* ws = a.ws;
    const Ctx c = make_ctx(lds);
    const int n = c.wid >> 1, th = c.wid & 1, tq = 32 * th + c.r32, t = 64 * qb + tq, b = bg >> 2, g = bg & 3, h = g * 4 + n, row = b * SEQ + t;
    const float* GL = (const float*)(ws + WS_GL);
    LAS float* GS = (LAS float*)(lds + L_GS); LAS float* LS = (LAS float*)(lds + L_LS);
    LAS unsigned* SEL = (LAS unsigned*)(lds + L_SEL); LAS unsigned* UNI = (LAS unsigned*)(lds + L_UNI);
    bf16x8 qf[8];
    load_q(qf, (const bf16_t*)(ws + WS_Q), row, h, c.hi);
    f32x16 o[4] = {};
    float l_c;
    {
        const bf16_t* Kc = (const bf16_t*)(ws + WS_KC) + (size_t)bg * 128 * HD; const bf16_t* Vc = (const bf16_t*)(ws + WS_VC) + (size_t)bg * 128 * HD;
        { Stage S0; sload(S0, Kc, Vc, 0, c); swrite(S0, 0, c); }
        { Stage S1; sload(S1, Kc, Vc, 64, c); swrite(S1, 1, c); }
        __syncthreads();
        f32x16 pA0, pA1, pB0, pB1;
        qkt<0>(pA0, pA1, c.lds, c.r32, c.hi, qf); qkt<1>(pB0, pB1, c.lds, c.r32, c.hi, qf);
        const int cmax = t >= 31 ? ((t - 31) >> 4) : -1;
        const float NEG = -__builtin_inff();
#pragma unroll
        for (int r = 0; r < 16; ++r) { const int cc = crow(r, c.hi);
            if (cc > cmax) pA0[r] = NEG; if (cc + 32 > cmax) pA1[r] = NEG; if (cc + 64 > cmax) pB0[r] = NEG; if (cc + 96 > cmax) pB1[r] = NEG; }
        float mx = -1e30f;
#pragma unroll
        for (int r = 0; r < 16; ++r) mx = fmaxf(fmaxf(mx, fmaxf(pA0[r], pA1[r])), fmaxf(pB0[r], pB1[r]));
        { auto rr = __builtin_amdgcn_permlane32_swap(__float_as_uint(mx), __float_as_uint(mx), false, false); mx = fmaxf(__uint_as_float(rr[0]), __uint_as_float(rr[1])); }
        constexpr float C2 = 1.4426950408889634f * SCALE;
        const float mnL = -mx * C2; float ps = 0.f;
#pragma unroll
        for (int r = 0; r < 16; ++r) { pA0[r] = __builtin_amdgcn_exp2f(fmaf(pA0[r], C2, mnL)); pA1[r] = __builtin_amdgcn_exp2f(fmaf(pA1[r], C2, mnL));
            pB0[r] = __builtin_amdgcn_exp2f(fmaf(pB0[r], C2, mnL)); pB1[r] = __builtin_amdgcn_exp2f(fmaf(pB1[r], C2, mnL)); ps += (pA0[r] + pA1[r]) + (pB0[r] + pB1[r]); }
        { auto rr = __builtin_amdgcn_permlane32_swap(__float_as_uint(ps), __float_as_uint(ps), false, false); ps = __uint_as_float(rr[0]) + __uint_as_float(rr[1]); }
        l_c = ps;
        const float inv = ps > 0.f ? 1.0f / ps : 0.f;
        LAS float* gsr = GS + (n * 64 + tq) * 33; LAS float* lsr = LS + (n * 64 + tq) * 33;
#pragma unroll
        for (int k = 0; k < 4; ++k) {
            const int jb = 2 * k + c.hi;
            gsr[jb]      = ((pA0[4 * k] + pA0[4 * k + 1]) + (pA0[4 * k + 2] + pA0[4 * k + 3])) * inv; lsr[jb]      = pA0[4 * k + 3] * inv;
            gsr[8 + jb]  = ((pA1[4 * k] + pA1[4 * k + 1]) + (pA1[4 * k + 2] + pA1[4 * k + 3])) * inv; lsr[8 + jb]  = pA1[4 * k + 3] * inv;
            gsr[16 + jb] = ((pB0[4 * k] + pB0[4 * k + 1]) + (pB0[4 * k + 2] + pB0[4 * k + 3])) * inv; lsr[16 + jb] = pB0[4 * k + 3] * inv;
            gsr[24 + jb] = ((pB1[4 * k] + pB1[4 * k + 1]) + (pB1[4 * k + 2] + pB1[4 * k + 3])) * inv; lsr[24 + jb] = pB1[4 * k + 3] * inv;
        }
        bf16x8 pa0, pa1, pa2, pa3;
        pack_p(pA0, pA1, pa0, pa1, pa2, pa3); SBAR(); pv_tile<0>(o, c.vb0, pa0, pa1, pa2, pa3);
        pack_p(pB0, pB1, pa0, pa1, pa2, pa3); SBAR(); pv_tile<1>(o, c.vb0, pa0, pa1, pa2, pa3);
    }
    __syncthreads();
    {
        LAS float* IMP = (LAS float*)(lds + L_IMP);
        const int tk = c.tid & 63, j0 = c.wid * 4;
        const LAS float* gb = GS + tk * 33 + j0; const LAS float* lb = LS + tk * 33 + j0 - 1;
#pragma unroll
        for (int jj = 0; jj < 4; ++jj) { float s = 0.f;
#pragma unroll
            for (int nn = 0; nn < 4; ++nn) { s += gb[nn * 2112 + jj]; const float lv = lb[nn * 2112 + jj]; s += (j0 + jj > 0) ? lv : 0.f; }
            IMP[tk * 33 + j0 + jj] = s; }
    }
    __syncthreads();
    if (c.wid == 0) {
        const LAS float* IMP = (const LAS float*)(lds + L_IMP);
        const int tk = c.lane;
        unsigned selm = 1u | (1u << qb);
        if (qb >= 2) {
            const int nfree = qb - 1;
            if (nfree <= 6) selm |= ((1u << qb) - 1u) & ~1u;
            else {
                float v[32];
#pragma unroll
                for (int jj = 1; jj < 31; ++jj) { const float s = IMP[tk * 33 + jj]; v[jj] = (jj < qb) ? s : -1.0f; }
                unsigned taken = 0u;
                for (int rnd = 0; rnd < 6; ++rnd) {
                    float best = -0.5f; int bi = -1;
#pragma unroll
                    for (int jj = 1; jj < 31; ++jj) { const bool ok = !((taken >> jj) & 1u) && v[jj] > best; best = ok ? v[jj] : best; bi = ok ? jj : bi; }
                    if (bi >= 0) taken |= 1u << bi;
                }
                selm |= taken;
            }
        }
        SEL[tk] = selm;
        unsigned u = selm;
#pragma unroll
        for (int off = 1; off < 64; off <<= 1) u |= (unsigned)__shfl_xor((int)u, off);
        if (c.lane == 0) UNI[0] = u;
    }
    bf16_t* ZC = (bf16_t*)(ws + WS_ZC);
    const int rbase = b * SEQ + 64 * qb + 32 * th;
    {
        const float g0 = sigmoid_f(GL[(size_t)row * 48 + h]);
        rescale_rows(o, l_c > 0.f ? g0 / l_c : 0.f, c);
#pragma unroll
        for (int r = 0; r < 16; ++r) { const int orow = rbase + crow(r, c.hi);
#pragma unroll
            for (int d0 = 0; d0 < 4; ++d0) ZC[(size_t)orow * ZC_LD + 2048 + h * HD + d0 * 32 + c.r32] = (bf16_t)(cvt_pk_bf16(o[d0][r], 0.f) & 0xffffu); }
#pragma unroll
        for (int d = 0; d < 4; ++d) o[d] = f32x16{};
    }
    __syncthreads();
    const unsigned sel = SEL[tq]; const unsigned uni = (unsigned)__builtin_amdgcn_readfirstlane((int)UNI[0]);
    rotate_q(qf[0], qf[1], (const float*)(ws + WS_COS), (const float*)(ws + WS_SIN), t, c.hi);
    float m_reg = -1e30f, l_reg = 0.f;
    {
        const bf16_t* Kh = (const bf16_t*)(ws + WS_KV) + 2 * KV_ELEMS + (size_t)bg * SEQ * HD; const bf16_t* Vh = (const bf16_t*)(ws + WS_KV) + 3 * KV_ELEMS + (size_t)bg * SEQ * HD;
        run_tiles<1>(o, m_reg, l_reg, qf, c, Kh, Vh, uni, t, sel, qb);
    }
    const float g1 = sigmoid_f(GL[(size_t)row * 48 + 16 + h]);
    rescale_rows(o, l_reg > 0.f ? g1 / l_reg : 0.f, c);
    const bf16_t* OW = (const bf16_t*)(ws + WS_XB); const bf16_t* NG = (const bf16_t*)(ws + WS_NG);
    int rbase2 = rbase; asm volatile("" : "+v"(rbase2));
#pragma unroll
    for (int r = 0; r < 16; ++r) { const int orow = rbase2 + crow(r, c.hi);
#pragma unroll
        for (int d0 = 0; d0 < 4; ++d0) {
            const size_t col = (size_t)h * HD + d0 * 32 + c.r32;
            bf16_t* yp = ZC + (size_t)orow * ZC_LD + 2048 + col;
            const float occ = bf2f(*yp);
            const float ow = bf2f(OW[(size_t)orow * DM + col]), ng = bf2f(NG[(size_t)orow * DM + col]);
            const float v = (occ + o[d0][r] + ow) * silu_f(ng);
            *yp = (bf16_t)(cvt_pk_bf16(v, 0.f) & 0xffffu); } }
    __syncthreads();
}

__device__ __forceinline__ void compress_unit(const Args& a, LAS unsigned char* lds, int task) {
    unsigned char* ws = a.ws;
    int tid = threadIdx.x; asm volatile("" : "+v"(tid));
    const int wid = __builtin_amdgcn_readfirstlane(tid >> 6), lane = tid & 63, r32 = lane & 31, hi = lane >> 5;
    const int mb = task & 3, bg = (task >> 2) & 15, kv = task >> 6;
    const bf16_t* X = (const bf16_t*)(ws + WS_KV) + (size_t)kv * KV_ELEMS + (size_t)bg * SEQ * HD;
    const bf16_t* W1T = (const bf16_t*)(ws + WS_W1T) + (size_t)kv * 128 * 4096;
    const bf16_t* W2T = (const bf16_t*)(ws + WS_W2T) + (size_t)kv * 128 * 128;
    int cc = 32 * mb + r32; if (cc > NCMP - 1) cc = NCMP - 1;
    f32x16 acc[4] = {};
#pragma unroll 1
    for (int l = 4 * wid; l < 4 * wid + 4; ++l) {
        const bf16_t* xr = X + (size_t)(16 * cc + l) * HD + hi * 8;
        const bf16_t* wr = W1T + (size_t)r32 * 4096 + l * 128 + hi * 8;
#pragma unroll
        for (int ks = 0; ks < 8; ++ks) {
            const bf16x8 af = *(const bf16x8*)(xr + 16 * ks);
#pragma unroll
            for (int nb = 0; nb < 4; ++nb) { const bf16x8 bfr = *(const bf16x8*)(wr + (size_t)nb * 32 * 4096 + 16 * ks);
                acc[nb] = __builtin_amdgcn_mfma_f32_32x32x16_bf16(af, bfr, acc[nb], 0, 0, 0); }
        }
    }
    LAS float* part = (LAS float*)lds;
    LAS bf16_t* hid = (LAS bf16_t*)(lds + 131072);
#pragma unroll
    for (int nb = 0; nb < 4; ++nb)
#pragma unroll
        for (int r = 0; r < 16; ++r) part[wid * 4096 + crow(r, hi) * 128 + nb * 32 + r32] = acc[nb][r];
    __syncthreads();
    {
        const float* PBP = (const float*)(ws + WS_PBP) + kv * 4096; const float* b1 = a.in[kv ? 10 : 6];
        for (int e = tid; e < 32 * 128; e += NTHREADS) { const int j = e & 127, m = e >> 7;
            float s = b1[j];
            for (int q = 0; q < 32; ++q) s += PBP[q * 128 + j];
#pragma unroll
            for (int w = 0; w < 8; ++w) s += part[w * 4096 + e];
            hid[m * 136 + j] = (bf16_t)f2bf(silu_f(s)); }
    }
    __syncthreads();
    if (wid < 4) {
        f32x16 o2 = {};
#pragma unroll
        for (int ks = 0; ks < 8; ++ks) {
            const bf16x8 af = *(const LAS bf16x8*)(hid + r32 * 136 + 16 * ks + hi * 8);
            const bf16x8 bfr = *(const bf16x8*)(W2T + (size_t)(32 * wid + r32) * 128 + 16 * ks + hi * 8);
            o2 = __builtin_amdgcn_mfma_f32_32x32x16_bf16(af, bfr, o2, 0, 0, 0);
        }
        bf16_t* dst = (bf16_t*)(ws + (kv ? WS_VC : WS_KC)) + (size_t)bg * 128 * 128;
#pragma unroll
        for (int r = 0; r < 16; ++r) { const int c2 = 32 * mb + crow(r, hi);
            dst[(size_t)c2 * 128 + 32 * wid + r32] = (bf16_t)(c2 < NCMP ? f2bf(o2[r]) : 0u); }
    }
    __syncthreads();
}

__device__ __forceinline__ void sgu_unit(const Args& a, LAS unsigned char* lds, int ch, int h, bool dry = false) {
    unsigned char* ws = a.ws;
    int tid = threadIdx.x; asm volatile("" : "+v"(tid));
    const int wid = __builtin_amdgcn_readfirstlane(tid >> 6), lane = tid & 63, r32 = lane & 31, hi = lane >> 5;
    const int tb = wid & 3, dh = wid >> 2, row0 = ch * 128;
    bf16_t* Z1 = (bf16_t*)(ws + WS_Z1); const float* LNS = (const float*)(ws + WS_LNS);
    const float* lng = a.in[15]; const float* lnb = a.in[16]; const float* bsp = a.in[18];
    {
        const int sr = tid >> 4, sc = (tid & 15) * 8;
#pragma unroll
        for (int dhh = 0; dhh < 2; ++dhh) {
            const int col = h * 256 + dhh * 128 + sc;
            const f32x4 g0 = *(const f32x4*)(lng + col), g1 = *(const f32x4*)(lng + col + 4), b0 = *(const f32x4*)(lnb + col), b1 = *(const f32x4*)(lnb + col + 4);
#pragma unroll
            for (int q = 0; q < 4; ++q) {
                const int s = 32 * q + sr, row = row0 + s;
                const float sum = LNS[2 * row], sq = LNS[2 * row + 1]; const float mu = sum * (1.0f / MIXW);
                const float rstd = __builtin_amdgcn_rsqf(fmaxf(sq * (1.0f / MIXW) - mu * mu, 0.f) + EPS);
                const u32x4 vv = *(const u32x4*)(Z1 + (size_t)row * N1 + MIXW + col);
                f32x4 x0 = {bf_lo(vv.x), bf_hi(vv.x), bf_lo(vv.y), bf_hi(vv.y)}, x1 = {bf_lo(vv.z), bf_hi(vv.z), bf_lo(vv.w), bf_hi(vv.w)};
                x0 = (x0 - mu) * rstd * g0 + b0; x1 = (x1 - mu) * rstd * g1 + b1;
                *(LAS bf16x8*)(lds + L_V + ((q >> 1) * 2 + dhh) * SHM + v_st(32 * (q & 1) + sr, sc)) = pack8(x0, x1);
            }
        }
    }
    __syncthreads();
    f32x16 o[4] = {};
    {
        const bf16_t* wp = (const bf16_t*)(ws + WS_SW) + (size_t)(h * 128 + 32 * tb + r32) * 128 + hi * 8;
        const int vb0 = (int)(unsigned)(uintptr_t)lds + v_rd_base(lane);
        bf16x8 pa0 = *(const bf16x8*)(wp), pa1 = *(const bf16x8*)(wp + 16), pa2 = *(const bf16x8*)(wp + 32), pa3 = *(const bf16x8*)(wp + 48);
        if (dh == 0) pv_tile<0>(o, vb0, pa0, pa1, pa2, pa3); else pv_tile<1>(o, vb0, pa0, pa1, pa2, pa3);
        if (tb >= 2) {
            pa0 = *(const bf16x8*)(wp + 64); pa1 = *(const bf16x8*)(wp + 80); pa2 = *(const bf16x8*)(wp + 96); pa3 = *(const bf16x8*)(wp + 112);
            if (dh == 0) pv_tile<2>(o, vb0, pa0, pa1, pa2, pa3); else pv_tile<3>(o, vb0, pa0, pa1, pa2, pa3);
        }
    }
#pragma unroll
    for (int r = 0; r < 16; ++r) { const int t = 32 * tb + crow(r, hi); const float bias = bsp[h * 128 + t];
        bf16_t* up = Z1 + (size_t)(row0 + t) * N1 + h * 256 + dh * 128 + r32;
#pragma unroll
        for (int d0 = 0; d0 < 4; ++d0) {
            const float u = bf2f(up[d0 * 32]), zg = bf2f(up[d0 * 32 + 2 * MIXW]);
            const float y = u * (o[d0][r] + bias) * silu_f(zg);
            const float yn = __shfl_xor(y, 1);
            if ((r32 & 1) == 0) *(unsigned*)(dry ? (bf16_t*)(ws + WS_DUMMY) + tid * 2 : up + d0 * 32) = cvt_pk_bf16(y, yn); } }
    __syncthreads();
}
}

__device__ __forceinline__ void p6_sgu_naive(const Args& a, LAS unsigned char* lds, int blk, int G, int tid) {
    LAS float* vn = (LAS float*)lds;
    LAS float* Wt = (LAS float*)(lds + 65536);
    bf16_t* Z1 = (bf16_t*)(a.ws + WS_Z1); const float* LNS = (const float*)(a.ws + WS_LNS);
    const float* lng = a.in[15]; const float* lnb = a.in[16]; const float* wsp = a.in[17]; const float* bsp = a.in[18];
    const int d = tid & 127, tq = tid >> 7;
    for (int unit = blk; unit < 64 * 16 * 2; unit += G) {
        const int dh = unit & 1, h = (unit >> 1) & 15, ch = unit >> 5;
        const int row0 = ch * 128, col = h * 256 + dh * 128;
        __syncthreads();
        for (int i = tid; i < 128 * 128; i += NTHREADS) { const int s = i >> 7, dd = i & 127; const int row = row0 + s;
            const float sum = LNS[2 * row], sq = LNS[2 * row + 1]; const float mu = sum * (1.0f / MIXW); const float var = sq * (1.0f / MIXW) - mu * mu;
            const float rstd = 1.0f / sqrtf(fmaxf(var, 0.f) + EPS);
            const float v = bf2f(Z1[(size_t)row * N1 + MIXW + col + dd]);
            vn[i] = (v - mu) * rstd * lng[col + dd] + lnb[col + dd];
            Wt[i] = wsp[(size_t)h * 16384 + i]; }
        __syncthreads();
        for (int tt = 0; tt < 32; ++tt) {
            const int t = tq + 4 * tt;
            float mix = 0.f;
            for (int s = 0; s <= t; ++s) mix += Wt[t * 128 + s] * vn[s * 128 + d];
            mix += bsp[h * 128 + t];
            const size_t off = (size_t)(row0 + t) * N1 + col + d;
            const float u = bf2f(Z1[off]), zg = bf2f(Z1[off + 2 * MIXW]);
            Z1[off] = (bf16_t)f2bf(u * mix * silu_f(zg));
        }
    }
    __syncthreads();
}

__device__ __forceinline__ void p8_final(const Args& a, int gw, int NGW, int lane, bool dry = false) {
    const float* gf = a.in[20];
    for (int m = gw; m < MTOK; m += NGW) {
        f32x4* xr = (f32x4*)(a.out + (size_t)m * DM) + lane;
        f32x4 v[8]; float s = 0.f;
#pragma unroll
        for (int j = 0; j < 8; ++j) { v[j] = xr[64 * j]; s += (v[j].x * v[j].x + v[j].y * v[j].y) + (v[j].z * v[j].z + v[j].w * v[j].w); }
        s = wave_sum(s);
        const float rs = 1.0f / sqrtf(s * (1.0f / DM) + EPS);
#pragma unroll
        for (int j = 0; j < 8; ++j) { const f32x4 gg = *((const f32x4*)gf + lane + 64 * j); if (dry) *((f32x4*)(a.ws + WS_DUMMY) + lane) = v[j] * rs * gg; else xr[64 * j] = v[j] * rs * gg; }
    }
}

#define GAS __attribute__((address_space(1)))
typedef GAS unsigned gu32;
#define XB_TMO      128
#define XB_XCNT(j)  (256  + 64 * (j))
#define XB_XSUB(j)  (1280 + 64 * (j))
#define XB_XGEN(j)  (2304 + 64 * (j))
#define XB_TOP      3328
#define XB_TOPGEN   3392
#define XCD_BAR_WORDS 3456
#define XB_SPIN_CAP (1u << 18)

__device__ __forceinline__ unsigned xb_ld(unsigned* p)              { return __hip_atomic_load(p, __ATOMIC_RELAXED, __HIP_MEMORY_SCOPE_AGENT); }
__device__ __forceinline__ unsigned xb_add(unsigned* p, unsigned v) { return __hip_atomic_fetch_add(p, v, __ATOMIC_RELAXED, __HIP_MEMORY_SCOPE_AGENT); }
__device__ __forceinline__ unsigned xb_xcc_id() { return (unsigned)__builtin_amdgcn_s_getreg((3 << 11) | 20) & 0xFu; }
#define XB_SPIN(cond, bar) do { unsigned _sp = 0; while (cond) { __builtin_amdgcn_s_sleep(1); \
    if ((++_sp & 255u) == 0u) { if (xb_ld(&(bar)[XB_TMO])) break; if (_sp > XB_SPIN_CAP) { atomicAdd(&(bar)[XB_TMO], 1u); break; } } } } while (0)

struct XcdBarrier {
    unsigned* bar; unsigned x;
    volatile LAS unsigned* st;
};

__device__ __forceinline__ XcdBarrier xcd_barrier_post(unsigned* bar, volatile LAS unsigned* st) {
    XcdBarrier b; b.bar = bar; b.x = xb_xcc_id(); b.st = st;
    if (threadIdx.x == 0) (void)xb_add(&bar[XB_XCNT(b.x)], 1u);
    return b;
}
__device__ __forceinline__ void xcd_barrier_complete(unsigned* bar, unsigned x, unsigned& nloc, unsigned& nx) {
    const unsigned G = gridDim.x * gridDim.y * gridDim.z;
    unsigned sum, cnt, mine, sp = 0u;
    for (;;) {
        sum = 0u; cnt = 0u; mine = 0u;
#pragma unroll
        for (unsigned j = 0; j < 16; ++j) { const unsigned c = xb_ld(&bar[XB_XCNT(j)]); sum += c; cnt += (c > 0u) ? 1u : 0u; mine = (j == x) ? c : mine; }
        if (sum == G) break;
        __builtin_amdgcn_s_sleep(1);
        if ((++sp & 255u) == 0u) { if (xb_ld(&bar[XB_TMO])) break; if (sp > XB_SPIN_CAP) { atomicAdd(&bar[XB_TMO], 1u); break; } }
    }
    nloc = mine > 0u ? mine : 1u; nx = cnt > 0u ? cnt : 1u;
}

__device__ __forceinline__ void xcd_barrier(const XcdBarrier& b) {
    asm volatile("s_waitcnt vmcnt(0)" ::: "memory");
    __syncthreads();
    if (threadIdx.x == 0) {
        unsigned* bar = b.bar;
        __builtin_amdgcn_s_waitcnt(0);
        unsigned nloc = b.st[0], nx = b.st[1];
        if (nloc == 0u) { xcd_barrier_complete(bar, b.x, nloc, nx); b.st[0] = nloc; b.st[1] = nx; }
        const unsigned old = xb_add(&bar[XB_XSUB(b.x)], 1u);
        const unsigned gen = old / nloc;
        if (old + 1u == (gen + 1u) * nloc) {
            __builtin_amdgcn_fence(__ATOMIC_RELEASE, "agent");
            asm volatile("s_waitcnt vmcnt(0)" ::: "memory");
            const unsigned og = xb_add(&bar[XB_TOP], 1u);
            const unsigned tg = og / nx;
            if (og + 1u == (tg + 1u) * nx) xb_add(&bar[XB_TOPGEN], 1u);
            else XB_SPIN(xb_ld(&bar[XB_TOPGEN]) == tg, bar);
            __builtin_amdgcn_fence(__ATOMIC_ACQUIRE, "agent");
            xb_add(&bar[XB_XGEN(b.x)], 1u);
            asm volatile("s_waitcnt vmcnt(0)" ::: "memory");
        } else {
            XB_SPIN(xb_ld(&bar[XB_XGEN(b.x)]) == gen, bar);
            __builtin_amdgcn_fence(__ATOMIC_ACQUIRE, "agent");
            asm volatile("s_waitcnt vmcnt(0)" ::: "memory");
        }
    }
    __syncthreads();
}

constexpr int NPHASE = 9;
template <bool COOP>
__global__ void __launch_bounds__(NTHREADS, 2) fwd_kernel(Args args) {
    extern __shared__ __attribute__((aligned(16))) unsigned char lds_raw[];
    LAS unsigned char* lds = (LAS unsigned char*)lds_raw;
    const int tid = threadIdx.x, lane = tid & 63, wave = __builtin_amdgcn_readfirstlane(tid >> 6);
    const int G = gridDim.x, bx = blockIdx.x;
    const int vcu = (G % 8 == 0) ? (bx % 8) * (G / 8) + bx / 8 : bx;
    const int gw = vcu * NWAVES + wave, NGW = G * NWAVES, gt = gw * 64 + lane, NGT = NGW * 64;
    const int lo = args.ph_lo, hi = args.ph_hi;
    unsigned char* ws = args.ws;
#define IN(k) (lo <= (k) && (k) < hi)
    unsigned* barw = (unsigned*)(ws + WS_BAR);
    volatile LAS unsigned* bst = (volatile LAS unsigned*)(lds + LDS_BYTES - 64);
    XcdBarrier bar; bar.bar = barw; bar.x = 0; bar.st = bst;
#define SEAM(k) do { if (COOP) { if (IN(k) && IN((k) + 1)) { xcd_barrier(bar); } } } while (0)

    if (IN(0)) {
#ifdef REP_P0
        p0_prologue(args, lds, vcu, G, wave, lane); __syncthreads();
#endif
        if (COOP) { if (tid == 0) { bst[0] = 0u; bst[1] = 0u; }
            if (bx == 0) for (int i = tid; i < XCD_BAR_WORDS; i += NTHREADS) barw[i] = 0u; }
        p0_prologue(args, lds, vcu, G, wave, lane);
    }
    if (COOP) { if (IN(0) && IN(1)) { __threadfence(); cg::this_grid().sync(); __threadfence(); bar = xcd_barrier_post(barw, bst); } }
#define P1_BODY do { \
        pg8::Gemm g{(const bf16_t*)(ws + WS_XB), (const bf16_t*)(ws + WS_WT0), MTOK, N0, DM, DM}; \
        pg8::StaticOrder S; S.init(MTOK, N0, G, bx); \
        pg8::Epi0 E{(const float*)(ws + WS_RSTD0), (bf16_t*)(ws + WS_ZC), (bf16_t*)(ws + WS_Q), (bf16_t*)(ws + WS_KV), (bf16_t*)(ws + WS_NG), (float*)(ws + WS_GL), \
                    (const float*)(ws + WS_COS), (const float*)(ws + WS_SIN)}; \
        pg8::gemm_phase<pg8::Epi0, pg8::StaticOrder, true, true>(lds, g, S, E); } while (0)
    if (IN(1)) {
#ifdef REP_P1
        P1_BODY; __syncthreads();
#endif
#ifdef REP_P1DRY
        { pg8::Gemm g{(const bf16_t*)(ws + WS_XB), (const bf16_t*)(ws + WS_WT0), MTOK, N0, DM, DM}; pg8::StaticOrder S; S.init(MTOK, N0, G, bx);
          pg8::EpiNull E{(float*)(ws + WS_PBP)}; pg8::gemm_phase<pg8::EpiNull, pg8::StaticOrder, true, true>(lds, g, S, E); __syncthreads(); }
#endif
        P1_BODY;
    }
    SEAM(1);
    if (IN(2)) {
#ifdef REP_P2C
        for (int task = vcu; task < 128; task += G) nsa::compress_unit(args, lds, task);
#endif
#ifdef REP_P2W
        for (int item = vcu; item < 256; item += G) { const int bg = item >> 4, p = item & 15; for (int k = 0; k < 2; ++k) nsa::window_unit(args, lds, bg, k ? 31 - p : p); }
#endif
        for (int task = vcu; task < 128; task += G) nsa::compress_unit(args, lds, task);
        for (int item = vcu; item < 256; item += G) { const int bg = item >> 4, p = item & 15;
#ifndef NO_WINDOW
            for (int k = 0; k < 2; ++k) nsa::window_unit(args, lds, bg, k ? 31 - p : p);
#endif
        }
#ifdef REP_CONV
        p2_conv(args, gt, NGT, true);
#endif
        p2_conv(args, gt, NGT);
    }
    SEAM(2);
    if (IN(3)) {
#ifdef REP_P3
      for (int rep = 0; rep < 2; ++rep)
#endif
        for (int item = vcu; item < 256; item += G) { const int bg = item >> 4, p = item & 15;
#ifndef NO_CMPSEL
            for (int k = 0; k < 2; ++k) nsa::cmpsel_unit(args, lds, bg, k ? 31 - p : p);
#endif
        }
    }
    SEAM(3);
    if (IN(4)) {
#ifdef REP_P4DRY
        { pg8::Gemm g{(const bf16_t*)(ws + WS_ZC), (const bf16_t*)(ws + WS_WTO0), MTOK, DM, MIXW, ZC_LD}; pg8::StaticOrder S; S.init(MTOK, DM, G, bx);
          pg8::EpiNull E{(float*)(ws + WS_PBP)}; pg8::gemm_phase<pg8::EpiNull, pg8::StaticOrder, true, true>(lds, g, S, E); __syncthreads(); }
#endif
        pg8::Gemm g{(const bf16_t*)(ws + WS_ZC), (const bf16_t*)(ws + WS_WTO0), MTOK, DM, MIXW, ZC_LD};
        pg8::StaticOrder S; S.init(MTOK, DM, G, bx);
        pg8::EpiOut0 E{args.in[0], args.out, (bf16_t*)(ws + WS_XB), (float*)(ws + WS_SS1)};
        pg8::gemm_phase<pg8::EpiOut0, pg8::StaticOrder, true, true>(lds, g, S, E);
    }
    SEAM(4);
    if (IN(5)) {
        pg8::Gemm g{(const bf16_t*)(ws + WS_XB), (const bf16_t*)(ws + WS_WT1), MTOK, N1, DM, DM};
        pg8::StaticOrder S; S.init(MTOK, N1, G, bx);
        pg8::Epi1 E{(const float*)(ws + WS_SS1), (bf16_t*)(ws + WS_Z1), (float*)(ws + WS_LNS)};
        pg8::gemm_phase<pg8::Epi1, pg8::StaticOrder, true, true>(lds, g, S, E);
    }
    SEAM(5);
    if (IN(6)) {
#ifdef REP_P6
        for (int unit = vcu; unit < 1024; unit += G) nsa::sgu_unit(args, lds, unit >> 4, unit & 15, true);
#endif
        for (int unit = vcu; unit < 1024; unit += G) nsa::sgu_unit(args, lds, unit >> 4, unit & 15); }
    SEAM(6);
    if (IN(7)) {
        pg8::Gemm g{(const bf16_t*)(ws + WS_Z1), (const bf16_t*)(ws + WS_WTO1), MTOK, DM, MIXW, N1};
        pg8::StaticOrder S; S.init(MTOK, DM, G, bx);
        pg8::EpiOut1 E{args.out};
        pg8::gemm_phase<pg8::EpiOut1, pg8::StaticOrder, true, true>(lds, g, S, E);
    }
    SEAM(7);
#ifdef REP_P8
    if (IN(8)) { p8_final(args, gw, NGW, lane, true); }
#endif
    if (IN(8)) { p8_final(args, gw, NGW, lane); }
#undef IN
#undef SEAM
}

#ifndef MK_COOP
#define MK_COOP 1
#endif

extern "C" void kernel_launch(void* const* d_in, const int* in_sizes, int n_in, void* d_out, int out_size, void* d_ws, size_t ws_size, hipStream_t stream) {
    static int grid = 0;
    if (grid == 0) {
        if (n_in != 21 || out_size != MTOK * DM || ws_size < WS_END) { fprintf(stderr, "kernel_launch: unexpected shapes (n_in %d out %d ws %zu)\n", n_in, out_size, ws_size); grid = -1; return; }
        int dev = 0, cus = 0, per_cu = 0;
        (void)hipGetDevice(&dev); (void)hipDeviceGetAttribute(&cus, hipDeviceAttributeMultiprocessorCount, dev);
        (void)hipFuncSetAttribute((const void*)fwd_kernel<true>, hipFuncAttributeMaxDynamicSharedMemorySize, LDS_BYTES);
        (void)hipFuncSetAttribute((const void*)fwd_kernel<false>, hipFuncAttributeMaxDynamicSharedMemorySize, LDS_BYTES);
        (void)hipOccupancyMaxActiveBlocksPerMultiprocessor(&per_cu, (const void*)fwd_kernel<true>, NTHREADS, LDS_BYTES);
        if (per_cu < 1) { fprintf(stderr, "kernel_launch: occupancy query says %d blocks per CU\n", per_cu); per_cu = 1; }
        (void)hipGetLastError();
        grid = cus;
        fprintf(stderr, "kernel_launch: grid %d (per_cu %d)\n", grid, per_cu);
    }
    if (grid < 0) return;
    Args a{};
    for (int i = 0; i < 21; ++i) a.in[i] = (const float*)d_in[i];
    a.out = (float*)d_out; a.ws = (unsigned char*)d_ws;
#if MK_COOP
    a.ph_lo = 0; a.ph_hi = NPHASE;
    void* kargs[] = {&a};
    hipError_t e = hipLaunchCooperativeKernel((const void*)fwd_kernel<true>, dim3(grid), dim3(NTHREADS), kargs, LDS_BYTES, stream);
    if (e != hipSuccess) fprintf(stderr, "cooperative launch failed: %s (grid %d)\n", hipGetErrorString(e), grid);
#else
    for (int p = 0; p < NPHASE; ++p) {
        a.ph_lo = p; a.ph_hi = p + 1;
        hipLaunchKernelGGL(fwd_kernel<false>, dim3(grid), dim3(NTHREADS), LDS_BYTES, stream, a);
    }
#endif
}
```

```cpp
#include <hip/hip_runtime.h>
#include <hip/hip_cooperative_groups.h>
#include <cstdio>
#include <cstdint>
namespace cg = cooperative_groups;

#define LAS __attribute__((address_space(3)))
typedef unsigned short bf16_t;
typedef short bf16x8 __attribute__((ext_vector_type(8)));
typedef float f32x4 __attribute__((ext_vector_type(4)));
typedef float f32x2 __attribute__((ext_vector_type(2)));
typedef unsigned u32x4 __attribute__((ext_vector_type(4)));
typedef unsigned u32x2 __attribute__((ext_vector_type(2)));

constexpr int DM = 2048, NB = 4, SEQ = 2048, MTOK = NB * SEQ;
constexpr int N0 = 15616, N0_SRC = 15408;
constexpr int N1 = 12288, MIXW = 4096;
constexpr int ZC_LD = 8192;
constexpr float EPS = 1e-6f;
constexpr int NKV = 4, HD = 128, NH = 16;
constexpr int NCMP = 127;

constexpr size_t MiB = 1u << 20;
constexpr size_t WS_BAR = 0;
constexpr size_t WS_RSTD0 = 1 * MiB, WS_SS1 = WS_RSTD0 + 32768, WS_LNS = WS_SS1 + 32768, WS_COS = WS_LNS + 65536, WS_SIN = WS_COS + 131072;
constexpr size_t WS_KC = 2 * MiB, WS_VC = 2 * MiB + 524288;
constexpr size_t WS_GL = 3 * MiB;
constexpr size_t WS_W1T = 5 * MiB;
constexpr size_t WS_W2T = 7 * MiB;
constexpr size_t WS_PBP = 7 * MiB + 65536;
constexpr size_t WS_DUMMY = 7 * MiB + 131072;
constexpr size_t WS_SW = 7 * MiB + 524288;
constexpr size_t WS_WT0 = 8 * MiB, WS_WTO0 = 69 * MiB, WS_WT1 = 85 * MiB, WS_WTO1 = 133 * MiB;
constexpr size_t WS_XB = 149 * MiB;
constexpr size_t WS_NG = 181 * MiB;
constexpr size_t WS_ZC = 213 * MiB;
constexpr size_t WS_Q = 341 * MiB;
constexpr size_t WS_KV = 373 * MiB;
constexpr size_t KV_ELEMS = (size_t)MTOK * 512;
constexpr size_t WS_END = 421 * MiB;
constexpr size_t WS_Z1 = WS_ZC;
static_assert(WS_Z1 + (size_t)MTOK * N1 * 2 <= WS_END, "z1 overlay");

constexpr int NWAVES = 8, NTHREADS = 512;
constexpr int LDS_BYTES = 147456;

struct Args { const float* in[21]; float* out; unsigned char* ws; int ph_lo, ph_hi; };

__device__ __forceinline__ float bf_lo(unsigned u) { return __uint_as_float(u << 16); }
__device__ __forceinline__ float bf_hi(unsigned u) { return __uint_as_float(u & 0xffff0000u); }
__device__ __forceinline__ float bf2f(bf16_t b) { return __uint_as_float((unsigned)b << 16); }
__device__ __forceinline__ unsigned f2bf(float f) { unsigned u = __float_as_uint(f); return (u + 0x7fffu + ((u >> 16) & 1u)) >> 16; }
__device__ __forceinline__ unsigned pk2(float lo, float hi) { return f2bf(lo) | (f2bf(hi) << 16); }
__device__ __forceinline__ unsigned cvt_pk_bf16(float lo, float hi) { unsigned r; asm volatile("v_cvt_pk_bf16_f32 %0, %1, %2" : "=v"(r) : "v"(lo), "v"(hi)); return r; }
__device__ __forceinline__ float silu_f(float x) { return x / (1.f + __expf(-x)); }
__device__ __forceinline__ float sigmoid_f(float x) { return 1.f / (1.f + __expf(-x)); }
__device__ __forceinline__ float wave_sum(float v) {
#pragma unroll
    for (int o = 1; o < 64; o <<= 1) v += __shfl_xor(v, o);
    return v;
}
__device__ __forceinline__ float wave_max(float v) {
#pragma unroll
    for (int o = 1; o < 64; o <<= 1) v = fmaxf(v, __shfl_xor(v, o));
    return v;
}
__device__ __forceinline__ int colmap0(int nd) { return nd < 13312 ? nd : (nd < 15360 ? nd + 48 : (nd < 15408 ? nd - 2048 : -1)); }

namespace pg8 {
#define PG8_LAS __attribute__((address_space(3)))
constexpr int BM = 256, BK = 64, HALF = 128, HTB = HALF * BK * 2  , STAGE_BYTES = 8 * HTB, NXCD = 8, WGM = 8;

__host__ __device__ __forceinline__ int lds_byte(int r, int c) { const int st = (r >> 4) * 2 + (c >> 5), rr = r & 15, cc = c & 31, ob = rr * 64 + cc * 2; return st * 1024 + (ob ^ (((ob >> 9) & 1) << 5)); }
__host__ __device__ __forceinline__ void stage_rc(int b, int& R, int& C) { const int st = b / 1024, sb = b % 1024, swz = sb ^ (((sb >> 9) & 1) << 5); R = (st >> 1) * 16 + swz / 64; C = (st & 1) * 32 + (swz % 64) / 2; }
__host__ __device__ __forceinline__ int perm32(int rho) { const int n = rho >> 4, i = rho & 15; return 8 * (i >> 2) + 4 * n + (i & 3); }

struct Unit { int pm, pn; };
struct Gemm { const bf16_t* A; const bf16_t* Bt; int M, N, K, lda; };

struct StaticOrder {
    int nM, nN, nwg, G, c;
    __host__ __device__ void init(int M, int N, int G_, int c_) { nM = M / BM; nN = N / BM; nwg = nM * nN; G = G_; c = c_; }
    __host__ __device__ bool next(int i, Unit& u) const {
        const long L = (long)i * G + c; if (L >= nwg) return false;
        int wgid = (int)L; { const int q = nwg / NXCD, r = nwg % NXCD, xcd = wgid % NXCD, off = wgid / NXCD; wgid = (xcd < r ? xcd * (q + 1) : r * (q + 1) + (xcd - r) * q) + off; }
        const int nig = WGM * nN, gid = wgid / nig, fm = gid * WGM, gsz = (nM - fm) < WGM ? (nM - fm) : WGM;
        u.pm = fm + ((wgid % nig) % gsz); u.pn = (wgid % nig) / gsz; return true;
    }
    __device__ __forceinline__ void a_ready(const Unit&) const {}
    __device__ __forceinline__ void done(const Unit&) const {}
};


#define EPI_LOADS_DONE() asm volatile("s_waitcnt vmcnt(0)" ::: "memory")
__device__ __forceinline__ void st16(void* p, u32x4 v) { asm volatile("global_store_dwordx4 %0, %1, off\n\ts_nop 1" :: "v"(p), "v"(v) : "memory"); }
__device__ __forceinline__ void st16f(void* p, f32x4 v) { asm volatile("global_store_dwordx4 %0, %1, off\n\ts_nop 1" :: "v"(p), "v"(v) : "memory"); }
__device__ __forceinline__ void st8(void* p, u32x2 v) { asm volatile("global_store_dwordx2 %0, %1, off\n\ts_nop 1" :: "v"(p), "v"(v) : "memory"); }

template <int DRY = 0> struct Epi0T {
    static constexpr bool PERM = true, AFTER_DRAIN = false;
    const float* rstd; bf16_t* ZC; bf16_t* Q; bf16_t* KV; bf16_t* NG; float* GL; const float* COS; const float* SIN;
    __device__ __forceinline__ void operator()(const f32x4 (&acc)[2][2][4][2], const Unit& u, int wr, int wc, int fr, int fq) const {
        const int pn = u.pn;
        const int rowb = u.pm * BM + wr * 64 + fr;
        const int cl = wc * 32 + 8 * fq;
        float rs[8];
#pragma unroll
        for (int i = 0; i < 8; ++i) rs[i] = rstd[rowb + (i >> 2) * HALF + (i & 3) * 16];
        EPI_LOADS_DONE();
#pragma unroll
        for (int i = 0; i < 8; ++i) asm volatile("" :: "v"(rs[i]));
        if (pn == 60) {
            if (cl < 48) {
#pragma unroll
                for (int ai = 0; ai < 2; ++ai)
#pragma unroll
                    for (int m = 0; m < 4; ++m) { const int row = rowb + ai * HALF + m * 16; float* gp = GL + (size_t)row * 48 + cl;
                        st16f(gp, acc[ai][0][m][0] * rs[ai * 4 + m]); st16f(gp + 4, acc[ai][0][m][1] * rs[ai * 4 + m]); }
            }
            return;
        }
        bf16_t* base; int ld, bjoff; bool rot = false;
        if (pn < 32) { base = ZC + pn * BM; ld = ZC_LD; bjoff = HALF; }
        else if (pn < 40) { base = Q + (pn - 32) * BM; ld = DM; bjoff = HALF; }
        else if (pn < 52) { const int which = (pn - 40) >> 1, g0 = ((pn - 40) & 1) * 2, b = u.pm >> 3;
            base = KV + (size_t)which * KV_ELEMS + (size_t)(b * 6144 + g0 * SEQ) * HD; ld = HD; bjoff = SEQ * HD; rot = (which == 2 || which == 4) && (wc == 0); }
        else { base = NG + (pn - 52) * BM; ld = DM; bjoff = HALF; }
        bf16_t* lanep = base + (size_t)rowb * ld + cl;
        if (DRY != 0) { const int tl = DRY == 1 ? (u.pm * 61 + pn) % 251 : (u.pm * 61 + pn) % 1900; rot = false; ld = 256; bjoff = 128;
            lanep = NG + (size_t)tl * 65536 + (size_t)(wr * 64 + fr) * 256 + cl; }
        if (!rot) {
#pragma unroll
            for (int ai = 0; ai < 2; ++ai)
#pragma unroll
                for (int m = 0; m < 4; ++m) {
                    const float rsv = rs[ai * 4 + m];
                    bf16_t* rp = lanep + (size_t)(ai * HALF + m * 16) * ld;
#pragma unroll
                    for (int bj = 0; bj < 2; ++bj) {
                        const f32x4 v0 = acc[ai][bj][m][0] * rsv, v1 = acc[ai][bj][m][1] * rsv;
                        u32x4 w; w.x = cvt_pk_bf16(v0[0], v0[1]); w.y = cvt_pk_bf16(v0[2], v0[3]); w.z = cvt_pk_bf16(v1[0], v1[1]); w.w = cvt_pk_bf16(v1[2], v1[3]);
                        st16(rp + (size_t)bj * bjoff, w);
                    }
                }
        } else {
#pragma unroll
            for (int ai = 0; ai < 2; ++ai)
#pragma unroll
                for (int m = 0; m < 4; ++m) {
                    const int row = rowb + ai * HALF + m * 16, t = row & (SEQ - 1);
                    const float rsv = rs[ai * 4 + m];
                    const float* cp = COS + t * 16 + 8 * (fq & 1); const float* sp = SIN + t * 16 + 8 * (fq & 1);
                    const f32x4 cs0 = *(const f32x4*)cp, cs1 = *(const f32x4*)(cp + 4), sn0 = *(const f32x4*)sp, sn1 = *(const f32x4*)(sp + 4);
                    bf16_t* rp = lanep + (size_t)(ai * HALF + m * 16) * ld;
#pragma unroll
                    for (int bj = 0; bj < 2; ++bj) {
                        f32x4 v0 = acc[ai][bj][m][0] * rsv, v1 = acc[ai][bj][m][1] * rsv, p0, p1;
#pragma unroll
                        for (int j = 0; j < 4; ++j) { p0[j] = __shfl_xor(v0[j], 32); p1[j] = __shfl_xor(v1[j], 32); }
                        if (fq < 2) { v0 = v0 * cs0 - p0 * sn0; v1 = v1 * cs1 - p1 * sn1; }
                        else        { v0 = v0 * cs0 + p0 * sn0; v1 = v1 * cs1 + p1 * sn1; }
                        u32x4 w; w.x = cvt_pk_bf16(v0[0], v0[1]); w.y = cvt_pk_bf16(v0[2], v0[3]); w.z = cvt_pk_bf16(v1[0], v1[1]); w.w = cvt_pk_bf16(v1[2], v1[3]);
                        st16(rp + (size_t)bj * bjoff, w);
                    }
                }
        }
    }
};

typedef Epi0T<0> Epi0;
struct EpiOut0 {
    static constexpr bool PERM = false, AFTER_DRAIN = false;
    const float* X; float* X1; bf16_t* X1B; float* SS;
    __device__ __forceinline__ void operator()(f32x4 (&acc)[2][2][4][2], const Unit& u, int wr, int wc, int fr, int fq) const {
        const int rowb = u.pm * BM + wr * 64 + fr, colb = u.pn * BM + wc * 32 + 4 * fq;
#pragma unroll
        for (int q = 0; q < 8; ++q) {
            const int ai = q >> 2, m = q & 3;
            f32x4 xr[2][2];
#pragma unroll
            for (int bj = 0; bj < 2; ++bj)
#pragma unroll
                for (int n = 0; n < 2; ++n) xr[bj][n] = *(const f32x4*)(X + (size_t)(rowb + ai * HALF + m * 16) * DM + colb + bj * HALF + n * 16);
            EPI_LOADS_DONE();
#pragma unroll
            for (int bj = 0; bj < 2; ++bj)
#pragma unroll
                for (int n = 0; n < 2; ++n) acc[ai][bj][m][n] += xr[bj][n];
            asm volatile("" : "+v"(acc[ai][0][m][0]), "+v"(acc[ai][0][m][1]), "+v"(acc[ai][1][m][0]), "+v"(acc[ai][1][m][1]) :: "memory");
        }
#pragma unroll
        for (int ai = 0; ai < 2; ++ai)
#pragma unroll
            for (int m = 0; m < 4; ++m) {
                const int row = rowb + ai * HALF + m * 16; float ss = 0.f;
#pragma unroll
                for (int bj = 0; bj < 2; ++bj)
#pragma unroll
                    for (int n = 0; n < 2; ++n) {
                        const size_t off = (size_t)row * DM + colb + bj * HALF + n * 16;
                        const f32x4 x1 = acc[ai][bj][m][n];
                        st16f(X1 + off, x1);
                        u32x2 w; w.x = cvt_pk_bf16(x1[0], x1[1]); w.y = cvt_pk_bf16(x1[2], x1[3]); st8(X1B + off, w);
                        ss += (x1[0] * x1[0] + x1[1] * x1[1]) + (x1[2] * x1[2] + x1[3] * x1[3]);
                    }
                ss += __shfl_xor(ss, 16); ss += __shfl_xor(ss, 32);
                if (fq == 0) atomicAdd(SS + row, ss);
            }
    }
};

struct Epi1 {
    static constexpr bool PERM = true, AFTER_DRAIN = false;
    const float* SS; bf16_t* Z1; float* LNS;
    __device__ __forceinline__ void operator()(const f32x4 (&acc)[2][2][4][2], const Unit& u, int wr, int wc, int fr, int fq) const {
        const int rowb = u.pm * BM + wr * 64 + fr, colb = u.pn * BM + wc * 32 + 8 * fq;
        const bool isv = (u.pn >= 16 && u.pn < 32);
        float rsq[8];
#pragma unroll
        for (int i = 0; i < 8; ++i) rsq[i] = SS[rowb + (i >> 2) * HALF + (i & 3) * 16];
        EPI_LOADS_DONE();
#pragma unroll
        for (int i = 0; i < 8; ++i) asm volatile("" :: "v"(rsq[i]));
#pragma unroll
        for (int ai = 0; ai < 2; ++ai)
#pragma unroll
            for (int m = 0; m < 4; ++m) {
                const int row = rowb + ai * HALF + m * 16;
                const float rs = __builtin_amdgcn_rsqf(rsq[ai * 4 + m] * (1.0f / DM) + EPS);
                float s1 = 0.f, s2 = 0.f;
#pragma unroll
                for (int bj = 0; bj < 2; ++bj) {
                    const f32x4 v0 = acc[ai][bj][m][0] * rs, v1 = acc[ai][bj][m][1] * rs;
                    u32x4 w; w.x = cvt_pk_bf16(v0[0], v0[1]); w.y = cvt_pk_bf16(v0[2], v0[3]); w.z = cvt_pk_bf16(v1[0], v1[1]); w.w = cvt_pk_bf16(v1[2], v1[3]);
                    st16(Z1 + (size_t)row * N1 + colb + bj * HALF, w);
                    s1 += (v0[0] + v0[1]) + (v0[2] + v0[3]) + (v1[0] + v1[1]) + (v1[2] + v1[3]);
                    s2 += (v0[0] * v0[0] + v0[1] * v0[1]) + (v0[2] * v0[2] + v0[3] * v0[3]) + (v1[0] * v1[0] + v1[1] * v1[1]) + (v1[2] * v1[2] + v1[3] * v1[3]);
                }
                if (isv) {
                    s1 += __shfl_xor(s1, 16); s1 += __shfl_xor(s1, 32); s2 += __shfl_xor(s2, 16); s2 += __shfl_xor(s2, 32);
                    if (fq == 0) { atomicAdd(LNS + 2 * row, s1); atomicAdd(LNS + 2 * row + 1, s2); }
                }
            }
    }
};

struct EpiNull {
    static constexpr bool PERM = true, AFTER_DRAIN = false; float* dummy;
    __device__ __forceinline__ void operator()(const f32x4 (&acc)[2][2][4][2], const Unit& u, int wr, int wc, int fr, int fq) const {
        float s = 0.f;
#pragma unroll
        for (int ai = 0; ai < 2; ++ai)
#pragma unroll
            for (int bj = 0; bj < 2; ++bj)
#pragma unroll
                for (int m = 0; m < 4; ++m)
#pragma unroll
                    for (int n = 0; n < 2; ++n) s += acc[ai][bj][m][n][0] + acc[ai][bj][m][n][1] + acc[ai][bj][m][n][2] + acc[ai][bj][m][n][3];
        if (s == 1.2345678f) dummy[0] = s;
    }
};

struct EpiOut1 {
    static constexpr bool PERM = false, AFTER_DRAIN = false;
    float* OUT;
    __device__ __forceinline__ void operator()(f32x4 (&acc)[2][2][4][2], const Unit& u, int wr, int wc, int fr, int fq) const {
        const int rowb = u.pm * BM + wr * 64 + fr, colb = u.pn * BM + wc * 32 + 4 * fq;
#pragma unroll
        for (int q = 0; q < 8; ++q) {
            const int ai = q >> 2, m = q & 3;
            f32x4 xr[2][2];
#pragma unroll
            for (int bj = 0; bj < 2; ++bj)
#pragma unroll
                for (int n = 0; n < 2; ++n) xr[bj][n] = *(const f32x4*)(OUT + (size_t)(rowb + ai * HALF + m * 16) * DM + colb + bj * HALF + n * 16);
            EPI_LOADS_DONE();
#pragma unroll
            for (int bj = 0; bj < 2; ++bj)
#pragma unroll
                for (int n = 0; n < 2; ++n) acc[ai][bj][m][n] += xr[bj][n];
            asm volatile("" : "+v"(acc[ai][0][m][0]), "+v"(acc[ai][0][m][1]), "+v"(acc[ai][1][m][0]), "+v"(acc[ai][1][m][1]) :: "memory");
        }
#pragma unroll
        for (int ai = 0; ai < 2; ++ai)
#pragma unroll
            for (int m = 0; m < 4; ++m)
#pragma unroll
                for (int bj = 0; bj < 2; ++bj)
#pragma unroll
                    for (int n = 0; n < 2; ++n) st16f(OUT + (size_t)(rowb + ai * HALF + m * 16) * DM + colb + bj * HALF + n * 16, acc[ai][bj][m][n]);
    }
};


template <class Epi, class Sched, bool ALIGN_EPI = false, bool SP2 = false>
__device__ __forceinline__ void gemm_phase(PG8_LAS unsigned char* lds, const Gemm g, const Sched& S, const Epi& E) {
    const int tid = threadIdx.x, wid = __builtin_amdgcn_readfirstlane(tid >> 6), lane = tid & 63, wr = wid >> 2, wc = wid & 3, fr = lane & 15, fq = lane >> 4;
    const int K = g.K, nt = K / BK;
    unsigned voffA[2], voffB[2];
#pragma unroll
    for (int i = 0; i < 2; ++i) { int R, C; stage_rc(tid * 16 + i * 8192, R, C); const int Rb = Epi::PERM ? ((R & ~31) + perm32(R & 31)) : R;
        voffA[i] = (unsigned)(R * g.lda + C) * 2u; voffB[i] = (unsigned)(Rb * K + C) * 2u; }
    const size_t kstep = (size_t)(BK * 2);
    const size_t hstepA = (size_t)HALF * g.lda * 2, hstepB = (size_t)HALF * K * 2;
    const size_t tstepA = 2 * hstepA, tstepB = 2 * hstepB;
    const unsigned ldsw = (unsigned)wid * 1024u;
    const int aoff = lds_byte(wr * 64 + fr, fq * 8), boff = lds_byte(wc * 32 + fr, fq * 8);
#define PG8_SA(b, h) (((b) * 2 + (h)) * HTB)
#define PG8_SB(b, h) ((4 + (b) * 2 + (h)) * HTB)
#define PG8_STAGE(bufoff, gbase, voff) do { _Pragma("unroll") for (int _i = 0; _i < 2; ++_i) \
        __builtin_amdgcn_global_load_lds((const unsigned*)((const char*)(gbase) + (voff)[_i]), (PG8_LAS unsigned*)(lds + (bufoff) + ldsw + _i * 8192), 16, 0, 0); } while (0)
#define PG8_LDA(dst, b, h) do { _Pragma("unroll") for (int m = 0; m < 4; ++m) _Pragma("unroll") for (int k = 0; k < 2; ++k) dst[m][k] = *(const PG8_LAS bf16x8*)(lds + PG8_SA(b, h) + aoff + m * 2048 + k * 1024); } while (0)
#define PG8_LDB(dst, b, h) do { _Pragma("unroll") for (int n = 0; n < 2; ++n) _Pragma("unroll") for (int k = 0; k < 2; ++k) dst[n][k] = *(const PG8_LAS bf16x8*)(lds + PG8_SB(b, h) + boff + n * 2048 + k * 1024); } while (0)
#define PG8_MMA(ai, bj, At, Bt) do { __builtin_amdgcn_s_setprio(1); _Pragma("unroll") for (int m = 0; m < 4; ++m) _Pragma("unroll") for (int n = 0; n < 2; ++n) _Pragma("unroll") for (int k = 0; k < 2; ++k) \
        acc[ai][bj][m][n] = __builtin_amdgcn_mfma_f32_16x16x32_bf16(Bt[n][k], At[m][k], acc[ai][bj][m][n], 0, 0, 0); __builtin_amdgcn_s_setprio(0); } while (0)
#define PG8_WAIT_V(n) asm volatile("s_waitcnt vmcnt(" #n ")" ::: "memory")
#define PG8_WAIT_L(n) asm volatile("s_waitcnt lgkmcnt(" #n ")" ::: "memory")
#define PG8_BAR __builtin_amdgcn_s_barrier()
#define PG8_SCHED __builtin_amdgcn_sched_barrier(0)
    Unit cur, nxt; int ui = 0;
    if (!S.next(0, cur)) return;
    f32x4 acc[2][2][4][2];
#pragma unroll
    for (int a = 0; a < 2; ++a)
#pragma unroll
        for (int b = 0; b < 2; ++b)
#pragma unroll
            for (int m = 0; m < 4; ++m)
#pragma unroll
                for (int n = 0; n < 2; ++n) acc[a][b][m][n] = (f32x4){0.f, 0.f, 0.f, 0.f};
    bf16x8 At[4][2], B0[2][2], B1[2][2];
    const char* cA = (const char*)g.A + (size_t)cur.pm * tstepA; const char* cB = (const char*)g.Bt + (size_t)cur.pn * tstepB;
    S.a_ready(cur);
    if constexpr (SP2) {
        PG8_STAGE(PG8_SB(0, 0), cB, voffB); PG8_STAGE(PG8_SB(0, 1), cB + hstepB, voffB); PG8_STAGE(PG8_SA(0, 0), cA, voffA); PG8_STAGE(PG8_SA(0, 1), cA + hstepA, voffA);
        if (wr == 1) PG8_BAR;
        PG8_WAIT_V(2); PG8_BAR;
        PG8_STAGE(PG8_SB(1, 0), cB + kstep, voffB); PG8_STAGE(PG8_SA(1, 0), cA + kstep, voffA); PG8_STAGE(PG8_SB(1, 1), cB + hstepB + kstep, voffB);
        PG8_WAIT_V(6); PG8_BAR;
    } else {
        PG8_STAGE(PG8_SB(0, 0), cB, voffB); PG8_STAGE(PG8_SA(0, 0), cA, voffA); PG8_STAGE(PG8_SB(0, 1), cB + hstepB, voffB); PG8_STAGE(PG8_SA(0, 1), cA + hstepA, voffA);
        if (wr == 1) PG8_BAR;
        PG8_WAIT_V(4); PG8_BAR;
        PG8_STAGE(PG8_SB(1, 0), cB + kstep, voffB); PG8_STAGE(PG8_SA(1, 0), cA + kstep, voffA); PG8_STAGE(PG8_SB(1, 1), cB + hstepB + kstep, voffB);
        PG8_WAIT_V(6); PG8_BAR;
    }
    for (;;) {
        const bool has_next = S.next(ui + 1, nxt);
        const char* nA = has_next ? (const char*)g.A + (size_t)nxt.pm * tstepA : cA; const char* nB = has_next ? (const char*)g.Bt + (size_t)nxt.pn * tstepB : cB;
        for (int t = 0; t < nt; t += 2) {
            const bool last = (t == nt - 2);
            const char* a1 = cA + (size_t)(t + 1) * kstep;
            const char* a2 = last ? nA : cA + (size_t)(t + 2) * kstep; const char* b2 = last ? nB : cB + (size_t)(t + 2) * kstep;
            const char* a3 = a2 + kstep; const char* b3 = b2 + kstep;
            if (last && has_next) S.a_ready(nxt);
            if constexpr (SP2) {
            PG8_LDB(B0, 0, 0); PG8_LDB(B1, 0, 1); PG8_SCHED; PG8_LDA(At, 0, 0); PG8_STAGE(PG8_SA(1, 1), a1 + hstepA, voffA);
            PG8_WAIT_V(8); PG8_WAIT_L(0); PG8_BAR; PG8_MMA(0, 0, At, B0); PG8_MMA(0, 1, At, B1); PG8_BAR; PG8_SCHED;
            PG8_LDA(At, 0, 1); PG8_STAGE(PG8_SB(0, 0), b2, voffB); PG8_STAGE(PG8_SB(0, 1), b2 + hstepB, voffB); PG8_STAGE(PG8_SA(0, 0), a2, voffA);
            PG8_WAIT_V(8); PG8_WAIT_L(0); PG8_BAR; PG8_MMA(1, 0, At, B0); PG8_MMA(1, 1, At, B1); PG8_BAR; PG8_SCHED;
            PG8_LDB(B0, 1, 0); PG8_LDB(B1, 1, 1); PG8_SCHED; PG8_LDA(At, 1, 0); PG8_STAGE(PG8_SA(0, 1), a2 + hstepA, voffA);
            PG8_WAIT_V(8); PG8_WAIT_L(0); PG8_BAR; PG8_MMA(0, 0, At, B0); PG8_MMA(0, 1, At, B1); PG8_BAR; PG8_SCHED;
            PG8_LDA(At, 1, 1); PG8_STAGE(PG8_SB(1, 0), b3, voffB); PG8_STAGE(PG8_SB(1, 1), b3 + hstepB, voffB); PG8_STAGE(PG8_SA(1, 0), a3, voffA);
            PG8_WAIT_V(8); PG8_WAIT_L(0); PG8_BAR; PG8_MMA(1, 0, At, B0); PG8_MMA(1, 1, At, B1); PG8_BAR; PG8_SCHED;
            } else {
            PG8_LDB(B0, 0, 0); PG8_SCHED; PG8_LDA(At, 0, 0); PG8_STAGE(PG8_SA(1, 1), a1 + hstepA, voffA);
            PG8_WAIT_L(8); PG8_BAR; PG8_WAIT_L(0); PG8_MMA(0, 0, At, B0); PG8_BAR; PG8_SCHED;
            PG8_LDB(B1, 0, 1); PG8_STAGE(PG8_SB(0, 0), b2, voffB);
            PG8_BAR; PG8_WAIT_L(0); PG8_MMA(0, 1, At, B1); PG8_BAR;
            PG8_LDA(At, 0, 1); PG8_STAGE(PG8_SA(0, 0), a2, voffA);
            PG8_BAR; PG8_WAIT_L(0); PG8_MMA(1, 0, At, B0); PG8_BAR; PG8_SCHED;
            PG8_STAGE(PG8_SB(0, 1), b2 + hstepB, voffB);
            PG8_WAIT_V(6); PG8_BAR; PG8_MMA(1, 1, At, B1); PG8_BAR;
            PG8_LDB(B0, 1, 0); PG8_SCHED; PG8_LDA(At, 1, 0); PG8_STAGE(PG8_SA(0, 1), a2 + hstepA, voffA);
            PG8_WAIT_L(8); PG8_BAR; PG8_WAIT_L(0); PG8_MMA(0, 0, At, B0); PG8_BAR; PG8_SCHED;
            PG8_LDB(B1, 1, 1); PG8_STAGE(PG8_SB(1, 0), b3, voffB);
            PG8_BAR; PG8_WAIT_L(0); PG8_MMA(0, 1, At, B1); PG8_BAR;
            PG8_LDA(At, 1, 1); PG8_STAGE(PG8_SA(1, 0), a3, voffA);
            PG8_BAR; PG8_WAIT_L(0); PG8_MMA(1, 0, At, B0); PG8_BAR; PG8_SCHED;
            PG8_STAGE(PG8_SB(1, 1), b3 + hstepB, voffB);
            PG8_WAIT_V(6); PG8_BAR; PG8_MMA(1, 1, At, B1); PG8_BAR;
            }
        }
        if constexpr (ALIGN_EPI) { if (wr == 0) PG8_BAR; }
        if constexpr (!Epi::AFTER_DRAIN) { E(acc, cur, wr, wc, fr, fq); S.done(cur); }
        if (!has_next) break;
#pragma unroll
        for (int a = 0; a < 2; ++a)
#pragma unroll
            for (int b = 0; b < 2; ++b)
#pragma unroll
                for (int m = 0; m < 4; ++m)
#pragma unroll
                    for (int n = 0; n < 2; ++n) acc[a][b][m][n] = (f32x4){0.f, 0.f, 0.f, 0.f};
        cur = nxt; cA = nA; cB = nB; ++ui;
        if constexpr (ALIGN_EPI) { if (wr == 1) PG8_BAR; }
    }
    PG8_WAIT_V(0);
    if constexpr (!ALIGN_EPI) { if (wr == 0) PG8_BAR; }
    PG8_BAR;
    if constexpr (Epi::AFTER_DRAIN) { E.fused(acc, cur, wr, wc, fr, fq, lds, wid, lane); S.done(cur); }
#undef PG8_SA
#undef PG8_SB
#undef PG8_STAGE
#undef PG8_LDA
#undef PG8_LDB
#undef PG8_MMA
#undef PG8_WAIT_V
#undef PG8_WAIT_L
#undef PG8_BAR
#undef PG8_SCHED
}
}

template <int MODE>
__device__ __forceinline__ void p0_transpose_item(const float* W, int K, int Nsrc, int nblk, bf16_t* WT, const float* gvec, LAS float* scr, int item, int lane) {
    const int kb = item / nblk, nb = item % nblk, k0 = 64 * kb, n0 = 64 * nb;
    const int nd = n0 + lane;
    const int col = (MODE == 0) ? colmap0(nd) : nd;
    const float* src = W + (size_t)k0 * Nsrc + (col >= 0 ? col : 0);
    float v[64];
#pragma unroll
    for (int i = 0; i < 64; ++i) v[i] = src[(size_t)i * Nsrc];
#pragma unroll
    for (int i = 0; i < 64; ++i) { float x = (col >= 0) ? v[i] : 0.f; if (MODE != 1) x *= gvec[k0 + i]; scr[i * 65 + lane] = x; }
    asm volatile("s_waitcnt lgkmcnt(0)" ::: "memory");
    const int c = lane & 7;
#pragma unroll
    for (int j = 0; j < 8; ++j) { const int n = (lane >> 3) + 8 * j; const LAS float* s = scr + (8 * c) * 65 + n;
        u32x4 o; o.x = pk2(s[0 * 65], s[1 * 65]); o.y = pk2(s[2 * 65], s[3 * 65]); o.z = pk2(s[4 * 65], s[5 * 65]); o.w = pk2(s[6 * 65], s[7 * 65]);
        *(u32x4*)(WT + (size_t)(n0 + n) * K + k0 + 8 * c) = o; }
    asm volatile("s_waitcnt lgkmcnt(0)" ::: "memory");
}

__device__ __forceinline__ void p0_prologue(const Args& a, LAS unsigned char* lds, int vcu, int G, int wave, int lane) {
    unsigned char* ws = a.ws;
    LAS float* scr = (LAS float*)(lds + wave * 16640);
    const int gw = vcu * NWAVES + wave, NGW = G * NWAVES;
    constexpr int I0 = (DM / 64) * (N0 / 64), IO = (MIXW / 64) * (DM / 64), I1 = (DM / 64) * (N1 / 64);
    constexpr int NITEMS = I0 + IO + I1 + IO;
    for (int it = gw; it < NITEMS; it += NGW) {
        int r = it;
        if (r < I0) { p0_transpose_item<0>(a.in[2], DM, N0_SRC, N0 / 64, (bf16_t*)(ws + WS_WT0), a.in[1], scr, r, lane); continue; } r -= I0;
        if (r < IO) { p0_transpose_item<1>(a.in[12], MIXW, DM, DM / 64, (bf16_t*)(ws + WS_WTO0), nullptr, scr, r, lane); continue; } r -= IO;
        if (r < I1) { p0_transpose_item<2>(a.in[14], DM, N1, N1 / 64, (bf16_t*)(ws + WS_WT1), a.in[13], scr, r, lane); continue; } r -= I1;
        p0_transpose_item<1>(a.in[19], MIXW, DM, DM / 64, (bf16_t*)(ws + WS_WTO1), nullptr, scr, r, lane);
    }
    for (int it = gw; it < 2 * (128 + 4); it += NGW) {
        const int kv = it / 132, r = it % 132;
        if (r < 128) p0_transpose_item<1>(a.in[kv ? 9 : 5], 4096, 128, 2, (bf16_t*)(ws + WS_W1T) + (size_t)kv * 128 * 4096, nullptr, scr, r, lane);
        else p0_transpose_item<1>(a.in[kv ? 11 : 7], 128, 128, 2, (bf16_t*)(ws + WS_W2T) + (size_t)kv * 128 * 128, nullptr, scr, r - 128, lane);
    }
    {
        const int gt0 = gw * 64 + lane, NGT0 = NGW * 64;
        bf16_t* SW = (bf16_t*)(ws + WS_SW); const float* wsp = a.in[17];
        for (int i = gt0; i < 16 * 128 * 128; i += NGT0) { const int s = i & 127, t = (i >> 7) & 127; SW[i] = (bf16_t)(s <= t ? f2bf(wsp[i]) : 0u); }
        float* PBP = (float*)(ws + WS_PBP);
        for (int i = gt0; i < 2 * 32 * 128; i += NGT0) { const int j = i & 127, ic = (i >> 7) & 31, kv = i >> 12;
            const float* pos = a.in[kv ? 8 : 4] + ic * 128; const float* w1 = a.in[kv ? 9 : 5] + (size_t)ic * 128 * 128 + j; float s = 0.f;
            for (int q = 0; q < 128; ++q) s += pos[q] * w1[(size_t)q * 128]; PBP[i] = s; }
    }
    const float* x = a.in[0]; bf16_t* XB = (bf16_t*)(ws + WS_XB); float* rstd0 = (float*)(ws + WS_RSTD0);
    for (int m = gw; m < MTOK; m += NGW) {
        const f32x4* xr = (const f32x4*)(x + (size_t)m * DM) + lane;
        u32x2* o8 = (u32x2*)(XB + (size_t)m * DM) + lane;
        float s = 0.f;
#pragma unroll
        for (int j = 0; j < 8; ++j) { const f32x4 v = xr[64 * j]; s += (v.x * v.x + v.y * v.y) + (v.z * v.z + v.w * v.w);
            u32x2 w; w.x = pk2(v.x, v.y); w.y = pk2(v.z, v.w); o8[64 * j] = w; }
        s = wave_sum(s);
        if (lane == 0) rstd0[m] = 1.0f / sqrtf(s * (1.0f / DM) + EPS);
    }
    const int gt = gw * 64 + lane, NGT = NGW * 64;
    float* SS1 = (float*)(ws + WS_SS1); float* LNS = (float*)(ws + WS_LNS);
    for (int i = gt; i < MTOK; i += NGT) { SS1[i] = 0.f; LNS[2 * i] = 0.f; LNS[2 * i + 1] = 0.f; }
    float* COS = (float*)(ws + WS_COS); float* SIN = (float*)(ws + WS_SIN);
    for (int i = gt; i < SEQ * 16; i += NGT) { const int t = i >> 4, f = i & 15;
        const float inv = powf(500000.0f, -((float)f * 2.0f) / 32.0f); const float ang = (float)t * inv;
        COS[i] = cosf(ang); SIN[i] = sinf(ang); }
}

__device__ __forceinline__ void p2_conv(const Args& a, int i0, int i1, int istep, bool dry = false) {
    bf16_t* ZC = (bf16_t*)(a.ws + WS_ZC); const float* cw = a.in[3];
    for (int idx = i0; idx < i1; idx += istep) {
        const int row = idx >> 8, c8 = (idx & 255) * 8, t = row & (SEQ - 1);
        bf16_t* base = ZC + (size_t)row * ZC_LD + c8;
        const u32x4 cb = *(const u32x4*)base, cg = *(const u32x4*)(base + 6144);
        const u32x4 cc0 = *(const u32x4*)(base + 2048), ch0 = *(const u32x4*)(base + 4096);
        u32x4 cc1 = {0, 0, 0, 0}, ch1 = {0, 0, 0, 0}, cc2 = {0, 0, 0, 0}, ch2 = {0, 0, 0, 0};
        if (t >= 1) { cc1 = *(const u32x4*)(base - ZC_LD + 2048); ch1 = *(const u32x4*)(base - ZC_LD + 4096); }
        if (t >= 2) { cc2 = *(const u32x4*)(base - 2 * ZC_LD + 2048); ch2 = *(const u32x4*)(base - 2 * ZC_LD + 4096); }
        float w0[8], w1[8], w2[8];
#pragma unroll
        for (int j = 0; j < 8; ++j) { w0[j] = cw[c8 + j]; w1[j] = cw[DM + c8 + j]; w2[j] = cw[2 * DM + c8 + j]; }
        u32x4 o;
#pragma unroll
        for (int q = 0; q < 4; ++q) {
            float r[2];
#pragma unroll
            for (int hh = 0; hh < 2; ++hh) {
                const int j = 2 * q + hh;
                const float p0 = hh ? bf_hi(cc0[q]) * bf_hi(ch0[q]) : bf_lo(cc0[q]) * bf_lo(ch0[q]);
                const float p1 = hh ? bf_hi(cc1[q]) * bf_hi(ch1[q]) : bf_lo(cc1[q]) * bf_lo(ch1[q]);
                const float p2 = hh ? bf_hi(cc2[q]) * bf_hi(ch2[q]) : bf_lo(cc2[q]) * bf_lo(ch2[q]);
                const float conv = w0[j] * p2 + w1[j] * p1 + w2[j] * p0;
                const float b = hh ? bf_hi(cb[q]) : bf_lo(cb[q]); const float g = hh ? bf_hi(cg[q]) : bf_lo(cg[q]);
                r[hh] = b * conv * silu_f(g);
            }
            o[q] = pk2(r[0], r[1]);
        }
        *(u32x4*)(dry ? (bf16_t*)(a.ws + WS_DUMMY) + (threadIdx.x * 8) : base) = o;
    }
}

__device__ __forceinline__ void p2_compress(const Args& a, LAS unsigned char* lds, int blk, int G, int tid) {
    LAS float* tok = (LAS float*)lds;
    LAS float* pos = (LAS float*)(lds + 73728);
    LAS float* red = (LAS float*)(lds + 73728 + 16384);
    LAS float* hid = (LAS float*)(lds + 73728 + 32768);
    const int j = tid & 127, iq = tid >> 7;
    for (int unit = blk; unit < 2 * 16 * 16; unit += G) {
        const int kv = unit >> 8, bg = (unit >> 4) & 15, cg8 = unit & 15;
        const bf16_t* src = (const bf16_t*)(a.ws + WS_KV) + (size_t)kv * KV_ELEMS + ((size_t)bg * SEQ + 128 * cg8) * HD;
        const float* posg = a.in[kv ? 8 : 4]; const float* w1 = a.in[kv ? 9 : 5]; const float* b1 = a.in[kv ? 10 : 6]; const float* w2 = a.in[kv ? 11 : 7];
        const int ntok = (cg8 == 15) ? 128 : 144;
        __syncthreads();
        for (int i = tid; i < ntok * 128; i += NTHREADS) tok[i] = bf2f(src[i]);
        for (int i = tid; i < 4096; i += NTHREADS) pos[i] = posg[i];
        __syncthreads();
        float acc[8];
#pragma unroll
        for (int cc = 0; cc < 8; ++cc) acc[cc] = 0.f;
        const int ncc = (cg8 == 15) ? 7 : 8;
        for (int i = iq * 1024; i < iq * 1024 + 1024; ++i) {
            const float w = w1[(size_t)i * 128 + j]; const float p = pos[i];
#pragma unroll
            for (int cc = 0; cc < 8; ++cc) if (cc < ncc) acc[cc] += (tok[cc * 2048 + i] + p) * w;
        }
#pragma unroll
        for (int cc = 0; cc < 8; ++cc) red[(iq * 8 + cc) * 128 + j] = acc[cc];
        __syncthreads();
        for (int i = tid; i < 8 * 128; i += NTHREADS) { const int jj = i & 127;
            const float h = red[i] + red[1024 + i] + red[2048 + i] + red[3072 + i] + b1[jj]; hid[i] = silu_f(h); }
        __syncthreads();
        bf16_t* dst = (bf16_t*)(a.ws + (kv ? WS_VC : WS_KC)) + (size_t)bg * 128 * 128;
        for (int o = tid; o < 8 * 128; o += NTHREADS) { const int cc = o >> 7, d = o & 127;
            if (cc >= ncc) { if (cg8 == 15 && cc == 7) dst[(size_t)127 * 128 + d] = 0; }
            else { float s = 0.f;
                for (int jj = 0; jj < 128; ++jj) s += hid[cc * 128 + jj] * w2[jj * 128 + d];
                dst[(size_t)(8 * cg8 + cc) * 128 + d] = (bf16_t)f2bf(s); } }
    }
    __syncthreads();
}

__device__ __forceinline__ void attn_batch(const bf16_t* Kb, const bf16_t* Vb, int first, int lo, int hi, bool valid, const LAS float* qs,
                                           float (&m)[4], float (&l)[4], float (&o)[4][2], int lane) {
    int kr = first + lane; kr = kr < lo ? lo : (kr > hi ? hi : kr);
    const u32x4* kp = (const u32x4*)(Kb + (size_t)kr * HD);
    float s[4] = {0.f, 0.f, 0.f, 0.f};
#pragma unroll 4
    for (int c = 0; c < 16; ++c) { const u32x4 kv = kp[c];
        float kf[8]; kf[0] = bf_lo(kv.x); kf[1] = bf_hi(kv.x); kf[2] = bf_lo(kv.y); kf[3] = bf_hi(kv.y); kf[4] = bf_lo(kv.z); kf[5] = bf_hi(kv.z); kf[6] = bf_lo(kv.w); kf[7] = bf_hi(kv.w);
#pragma unroll
        for (int h = 0; h < 4; ++h) { const LAS f32x4* q4 = (const LAS f32x4*)(qs + h * HD + c * 8); const f32x4 qa = q4[0], qb = q4[1];
            s[h] += (qa[0] * kf[0] + qa[1] * kf[1]) + (qa[2] * kf[2] + qa[3] * kf[3]) + (qb[0] * kf[4] + qb[1] * kf[5]) + (qb[2] * kf[6] + qb[3] * kf[7]); }
    }
    float ps[4];
#pragma unroll
    for (int h = 0; h < 4; ++h) {
        const float sv = valid ? s[h] : -INFINITY;
        const float bm = wave_max(sv); const float mn = fmaxf(m[h], bm);
        float p = 0.f, alpha = 1.f;
        if (mn > -INFINITY) { p = valid ? __expf(sv - mn) : 0.f; alpha = (m[h] > -INFINITY) ? __expf(m[h] - mn) : 0.f; }
        l[h] = l[h] * alpha + wave_sum(p); o[h][0] *= alpha; o[h][1] *= alpha; m[h] = mn; ps[h] = p;
    }
    for (int jj = 0; jj < 64; ++jj) {
        int vr = first + jj; vr = vr < lo ? lo : (vr > hi ? hi : vr);
        const unsigned vv = *(const unsigned*)(Vb + (size_t)vr * HD + 2 * lane);
        const float v0 = bf_lo(vv), v1 = bf_hi(vv);
#pragma unroll
        for (int h = 0; h < 4; ++h) { const float pj = __shfl(ps[h], jj); o[h][0] += pj * v0; o[h][1] += pj * v1; }
    }
}

__device__ __forceinline__ void p3_nsa_naive(const Args& a, LAS unsigned char* lds, int gw, int NGW, int wave, int lane) {
    unsigned char* ws = a.ws;
    LAS float* qs = (LAS float*)(lds + wave * 8192);
    LAS float* qr = qs + 512;
    LAS float* Pc = qr + 512;
    const bf16_t* Q = (const bf16_t*)(ws + WS_Q); const bf16_t* KVb = (const bf16_t*)(ws + WS_KV);
    const bf16_t* KC = (const bf16_t*)(ws + WS_KC); const bf16_t* VC = (const bf16_t*)(ws + WS_VC);
    const float* GL = (const float*)(ws + WS_GL); const bf16_t* NG = (const bf16_t*)(ws + WS_NG);
    const float* COS = (const float*)(ws + WS_COS); const float* SIN = (const float*)(ws + WS_SIN);
    bf16_t* ZC = (bf16_t*)(ws + WS_ZC);
    const float scale = 0.08838834764831845f;
    for (int task = gw; task < NB * NKV * SEQ; task += NGW) {
        const int t = task & (SEQ - 1), bg = task >> 11, b = bg >> 2, g = bg & 3;
        const int row = b * SEQ + t;
        { const u32x4 qv = *(const u32x4*)(Q + (size_t)row * DM + g * 512 + lane * 8);
          float f[8]; f[0] = bf_lo(qv.x); f[1] = bf_hi(qv.x); f[2] = bf_lo(qv.y); f[3] = bf_hi(qv.y); f[4] = bf_lo(qv.z); f[5] = bf_hi(qv.z); f[6] = bf_lo(qv.w); f[7] = bf_hi(qv.w);
#pragma unroll
          for (int j = 0; j < 8; ++j) { qs[lane * 8 + j] = f[j] * scale; qr[lane * 8 + j] = f[j] * scale; } }
        asm volatile("s_waitcnt lgkmcnt(0)" ::: "memory");
        { const int h = lane >> 4, i = lane & 15; const float x1 = qs[h * HD + i], x2 = qs[h * HD + 16 + i]; const float c = COS[t * 16 + i], s = SIN[t * 16 + i];
          qr[h * HD + i] = x1 * c - x2 * s; qr[h * HD + 16 + i] = x2 * c + x1 * s; }
        asm volatile("s_waitcnt lgkmcnt(0)" ::: "memory");
        float oc[4][2], Pl0 = 0.f, Pl1 = 0.f;
        {
            const bf16_t* Kc = KC + (size_t)bg * 128 * 128; const bf16_t* Vc = VC + (size_t)bg * 128 * 128;
            const int c0 = lane, c1 = 64 + lane;
            const bool v0 = (16 * c0 + 31 <= t), v1 = (c1 < NCMP) && (16 * c1 + 31 <= t);
            const int r1 = c1 < NCMP ? c1 : NCMP - 1;
            float s0[4] = {0.f, 0.f, 0.f, 0.f}, s1[4] = {0.f, 0.f, 0.f, 0.f};
            const u32x4* k0p = (const u32x4*)(Kc + (size_t)c0 * HD); const u32x4* k1p = (const u32x4*)(Kc + (size_t)r1 * HD);
#pragma unroll 2
            for (int c = 0; c < 16; ++c) { const u32x4 ka = k0p[c], kb = k1p[c];
                float fa[8], fb[8];
                fa[0] = bf_lo(ka.x); fa[1] = bf_hi(ka.x); fa[2] = bf_lo(ka.y); fa[3] = bf_hi(ka.y); fa[4] = bf_lo(ka.z); fa[5] = bf_hi(ka.z); fa[6] = bf_lo(ka.w); fa[7] = bf_hi(ka.w);
                fb[0] = bf_lo(kb.x); fb[1] = bf_hi(kb.x); fb[2] = bf_lo(kb.y); fb[3] = bf_hi(kb.y); fb[4] = bf_lo(kb.z); fb[5] = bf_hi(kb.z); fb[6] = bf_lo(kb.w); fb[7] = bf_hi(kb.w);
#pragma unroll
                for (int h = 0; h < 4; ++h)
#pragma unroll
                    for (int jj = 0; jj < 8; ++jj) { const float qv = qs[h * HD + c * 8 + jj]; s0[h] += qv * fa[jj]; s1[h] += qv * fb[jj]; } }
            float p0[4], p1[4];
#pragma unroll
            for (int h = 0; h < 4; ++h) {
                const float a0 = v0 ? s0[h] : -INFINITY, a1 = v1 ? s1[h] : -INFINITY;
                const float mx = wave_max(fmaxf(a0, a1));
                float e0 = 0.f, e1 = 0.f;
                if (mx > -INFINITY) { e0 = v0 ? __expf(a0 - mx) : 0.f; e1 = v1 ? __expf(a1 - mx) : 0.f; }
                const float den = wave_sum(e0 + e1); const float inv = den > 0.f ? 1.0f / den : 1.0f;
                p0[h] = e0 * inv; p1[h] = e1 * inv; Pl0 += p0[h]; Pl1 += p1[h];
                oc[h][0] = 0.f; oc[h][1] = 0.f;
            }
            for (int jj = 0; jj < 64; ++jj) {
                const unsigned va = *(const unsigned*)(Vc + (size_t)jj * HD + 2 * lane);
                const int rr = (64 + jj) < NCMP ? (64 + jj) : NCMP - 1;
                const unsigned vb = *(const unsigned*)(Vc + (size_t)rr * HD + 2 * lane);
#pragma unroll
                for (int h = 0; h < 4; ++h) { const float pa = __shfl(p0[h], jj), pb = __shfl(p1[h], jj);
                    oc[h][0] += pa * bf_lo(va) + pb * bf_lo(vb); oc[h][1] += pa * bf_hi(va) + pb * bf_hi(vb); }
            }
            Pc[lane] = Pl0; Pc[64 + lane] = Pl1;
        }
        asm volatile("s_waitcnt lgkmcnt(0)" ::: "memory");
        unsigned selmask = 0u;
        {
            const int cur = t >> 6;
            float val = -INFINITY;
            if (lane < 32) {
                if (lane == 0 || lane == cur) val = INFINITY;
                else if (64 * lane <= t) { float s = 0.f;
                    for (int c = 4 * lane - 1; c <= 4 * lane + 3; ++c) if (c >= 0 && c < NCMP) s += Pc[c];
                    val = s; }
            }
            bool taken = (lane >= 32);
            for (int r = 0; r < 8; ++r) {
                const float cand = taken ? -INFINITY : val;
                const float mx = wave_max(cand);
                if (!(mx > -INFINITY)) break;
                const unsigned long long bal = __ballot(!taken && cand == mx);
                const int idx = __ffsll((long long)bal) - 1;
                selmask |= 1u << idx;
                if (lane == idx) taken = true;
            }
        }
        float os[4][2], ms[4], ls[4];
#pragma unroll
        for (int h = 0; h < 4; ++h) { os[h][0] = 0.f; os[h][1] = 0.f; ms[h] = -INFINITY; ls[h] = 0.f; }
        {
            const bf16_t* Ks = KVb + 2 * KV_ELEMS + (size_t)bg * SEQ * HD; const bf16_t* Vs = KVb + 3 * KV_ELEMS + (size_t)bg * SEQ * HD;
            unsigned mk = selmask;
            while (mk) { const int jb = __ffs((int)mk) - 1; mk &= mk - 1;
                attn_batch(Ks, Vs, 64 * jb, 0, SEQ - 1, (64 * jb + lane) <= t, qr, ms, ls, os, lane); }
        }
        float ow[4][2], mw[4], lw[4];
#pragma unroll
        for (int h = 0; h < 4; ++h) { ow[h][0] = 0.f; ow[h][1] = 0.f; mw[h] = -INFINITY; lw[h] = 0.f; }
        {
            const bf16_t* Kw = KVb + 4 * KV_ELEMS + (size_t)bg * SEQ * HD; const bf16_t* Vw = KVb + 5 * KV_ELEMS + (size_t)bg * SEQ * HD;
            const int first = t - 511;
            for (int b8 = 0; b8 < 8; ++b8) { const int f0 = first + 64 * b8;
                if (f0 + 63 < 0) continue;
                attn_batch(Kw, Vw, f0, 0, SEQ - 1, (f0 + lane) >= 0, qr, mw, lw, ow, lane); }
        }
#pragma unroll
        for (int h = 0; h < 4; ++h) {
            const int hh = g * 4 + h;
            const float g0 = sigmoid_f(GL[(size_t)row * 48 + hh]), g1 = sigmoid_f(GL[(size_t)row * 48 + 16 + hh]), g2 = sigmoid_f(GL[(size_t)row * 48 + 32 + hh]);
            const float is = ls[h] > 0.f ? 1.0f / ls[h] : 0.f, iw = lw[h] > 0.f ? 1.0f / lw[h] : 0.f;
            const unsigned ngv = *(const unsigned*)(NG + (size_t)row * DM + hh * HD + 2 * lane);
            const float y0 = (g0 * oc[h][0] + g1 * os[h][0] * is + g2 * ow[h][0] * iw) * silu_f(bf_lo(ngv));
            const float y1 = (g0 * oc[h][1] + g1 * os[h][1] * is + g2 * ow[h][1] * iw) * silu_f(bf_hi(ngv));
            *(unsigned*)(ZC + (size_t)row * ZC_LD + 2048 + hh * HD + 2 * lane) = pk2(y0, y1);
        }
    }
}


namespace nsa {
typedef float f32x16 __attribute__((ext_vector_type(16)));
typedef short s16x4 __attribute__((ext_vector_type(4)));
constexpr int KVBLK = 64, SHM = 16384;
constexpr float SCALE = 0.08838834764831845f, THR = 8.f;
constexpr int L_V = 0, L_K = 32768, L_WS = 65536, L_SEL = 67584, L_UNI = 67840, L_GS = 68608, L_LS = L_GS + 33792, L_IMP = L_LS + 33792, L_END = L_IMP + 8448;
static_assert(L_END <= LDS_BYTES, "nsa lds");
#define KSWZ(row, colB) ((row) * 256 + ((colB) ^ (((row) & 7) << 4)))
#define SBAR() __builtin_amdgcn_sched_barrier(0)
__device__ __forceinline__ int v_st(int k, int c) { const int kk = (k & ~0xC) | ((k & 4) << 1) | ((k & 8) >> 1); return ((kk >> 3) * 4 + (c >> 5)) * 512 + ((kk & 7) * 32 + (c & 31)) * 2; }
__device__ __forceinline__ int v_rd_base(int lane) { return ((lane & 3) << 3) | (((lane >> 2) & 3) << 6) | (((lane >> 4) & 1) << 5) | (((lane >> 5) & 1) << 8); }
constexpr int v_rd_off(int d0, int ks, int half) { return d0 * 512 + ks * 4096 + half * 2048; }
__device__ __forceinline__ int crow(int r, int hi) { return (r & 3) + 8 * (r >> 2) + 4 * hi; }
__device__ __forceinline__ bf16x8 pack8(f32x4 a, f32x4 b) {
    u32x4 w = {cvt_pk_bf16(a[0], a[1]), cvt_pk_bf16(a[2], a[3]), cvt_pk_bf16(b[0], b[1]), cvt_pk_bf16(b[2], b[3])};
    return *reinterpret_cast<bf16x8*>(&w);
}
__device__ __forceinline__ void mask_tile(f32x16& p0, f32x16& p1, int dq, unsigned W) {
    const float NEG = -__builtin_inff();
#pragma unroll
    for (int r = 0; r < 16; ++r) {
        const int c = (r & 3) + 8 * (r >> 2);
        if ((unsigned)(dq - c) >= W) p0[r] = NEG;
        if ((unsigned)(dq - c - 32) >= W) p1[r] = NEG;
    }
}
__device__ __forceinline__ void mask_all(f32x16& p0, f32x16& p1) {
    const float NEG = -__builtin_inff();
#pragma unroll
    for (int r = 0; r < 16; ++r) { p0[r] = NEG; p1[r] = NEG; }
}
__device__ __forceinline__ void partialSM(f32x16& p0, f32x16& p1, float& m_reg, float& mn, float& alpha) {
    float pmax = p0[0];
#pragma unroll
    for (int r = 1; r < 16; ++r) pmax = fmaxf(pmax, p0[r]);
#pragma unroll
    for (int r = 0; r < 16; ++r) pmax = fmaxf(pmax, p1[r]);
    { auto rr = __builtin_amdgcn_permlane32_swap(__float_as_uint(pmax), __float_as_uint(pmax), false, false);
      pmax = fmaxf(__uint_as_float(rr[0]), __uint_as_float(rr[1])); }
    constexpr float C2 = 1.4426950408889634f * SCALE;
    if (__builtin_expect(__all((pmax - m_reg) * SCALE <= THR), 1)) { mn = m_reg; alpha = 1.f; }
    else { mn = fmaxf(m_reg, pmax); alpha = __builtin_amdgcn_exp2f((m_reg - mn) * C2); m_reg = mn; }
    const float mnL = -mn * C2;
#pragma unroll
    for (int r = 0; r < 16; ++r) p0[r] = fmaf(p0[r], C2, mnL);
#pragma unroll
    for (int r = 0; r < 16; ++r) p1[r] = fmaf(p1[r], C2, mnL);
#pragma unroll
    for (int r = 0; r < 16; ++r) p0[r] = __builtin_amdgcn_exp2f(p0[r]);
}
#define NSA_PK4(P, B_, OUT) do { unsigned a0 = cvt_pk_bf16(P[B_+0], P[B_+1]), a1 = cvt_pk_bf16(P[B_+2], P[B_+3]);                 \
        unsigned b0 = cvt_pk_bf16(P[B_+4], P[B_+5]), b1 = cvt_pk_bf16(P[B_+6], P[B_+7]);                                         \
        auto r0 = __builtin_amdgcn_permlane32_swap(a0, b0, false, false); auto r1 = __builtin_amdgcn_permlane32_swap(a1, b1, false, false); \
        u32x4 w = {r0[0], r1[0], r0[1], r1[1]}; OUT = *reinterpret_cast<bf16x8*>(&w); } while (0)
__device__ __forceinline__ void pack_p(const f32x16& p0, const f32x16& p1, bf16x8& pa0, bf16x8& pa1, bf16x8& pa2, bf16x8& pa3) {
    NSA_PK4(p0, 0, pa0); NSA_PK4(p0, 8, pa1); NSA_PK4(p1, 0, pa2); NSA_PK4(p1, 8, pa3);
}
__device__ __forceinline__ void finishSM(f32x16& p0, f32x16& p1, float alpha, float& l_reg, bf16x8& pa0, bf16x8& pa1, bf16x8& pa2, bf16x8& pa3) {
#pragma unroll
    for (int r = 0; r < 16; ++r) p1[r] = __builtin_amdgcn_exp2f(p1[r]);
    float ps = 0;
#pragma unroll
    for (int r = 0; r < 16; ++r) ps += p0[r];
#pragma unroll
    for (int r = 0; r < 16; ++r) ps += p1[r];
    { auto rr = __builtin_amdgcn_permlane32_swap(__float_as_uint(ps), __float_as_uint(ps), false, false);
      ps = __uint_as_float(rr[0]) + __uint_as_float(rr[1]); }
    l_reg = l_reg * alpha + ps;
    pack_p(p0, p1, pa0, pa1, pa2, pa3);
}
template <int KB>
__device__ __forceinline__ void qkt(f32x16& p0, f32x16& p1, const LAS unsigned char* lds, int r32, int hi, const bf16x8* qr) {
    p0 = f32x16{}; p1 = f32x16{};
    const LAS unsigned char* kb[4];
#pragma unroll
    for (int dd = 0; dd < 4; ++dd) kb[dd] = lds + L_K + KB * SHM + KSWZ(r32, (dd * 16 + hi * 8) * 2);
#pragma unroll
    for (int d0 = 0; d0 < 8; ++d0) { const LAS unsigned char* a = kb[d0 & 3] + (d0 >> 2) * 128;
        const bf16x8 b0 = *reinterpret_cast<const LAS bf16x8*>(a);
        const bf16x8 b1 = *reinterpret_cast<const LAS bf16x8*>(a + 32 * 256);
        p0 = __builtin_amdgcn_mfma_f32_32x32x16_bf16(b0, qr[d0], p0, 0, 0, 0);
        p1 = __builtin_amdgcn_mfma_f32_32x32x16_bf16(b1, qr[d0], p1, 0, 0, 0); }
}
template <int VB>
__device__ __forceinline__ void pv_tile(f32x16* o, int vb0, bf16x8 pa0, bf16x8 pa1, bf16x8 pa2, bf16x8 pa3) {
#define TRRD(dst, off) asm volatile("ds_read_b64_tr_b16 %0, %1 offset:%2" : "=&v"(dst) : "v"(vb0), "i"(off) : "memory")
#define PV_D0(d0) do { s16x4 l0, l1, l2, l3, h0, h1, h2, h3; constexpr int b_ = L_V + VB * SHM + v_rd_off(d0, 0, 0); \
        TRRD(l0, b_); TRRD(h0, b_ + 2048); TRRD(l1, b_ + 4096); TRRD(h1, b_ + 6144); TRRD(l2, b_ + 8192); TRRD(h2, b_ + 10240); TRRD(l3, b_ + 12288); TRRD(h3, b_ + 14336); \
        asm volatile("s_waitcnt lgkmcnt(0)" ::: "memory"); SBAR();   \
        o[d0] = __builtin_amdgcn_mfma_f32_32x32x16_bf16(pa0, (bf16x8){l0[0], l0[1], l0[2], l0[3], h0[0], h0[1], h0[2], h0[3]}, o[d0], 0, 0, 0);   \
        o[d0] = __builtin_amdgcn_mfma_f32_32x32x16_bf16(pa1, (bf16x8){l1[0], l1[1], l1[2], l1[3], h1[0], h1[1], h1[2], h1[3]}, o[d0], 0, 0, 0);   \
        o[d0] = __builtin_amdgcn_mfma_f32_32x32x16_bf16(pa2, (bf16x8){l2[0], l2[1], l2[2], l2[3], h2[0], h2[1], h2[2], h2[3]}, o[d0], 0, 0, 0);   \
        o[d0] = __builtin_amdgcn_mfma_f32_32x32x16_bf16(pa3, (bf16x8){l3[0], l3[1], l3[2], l3[3], h3[0], h3[1], h3[2], h3[3]}, o[d0], 0, 0, 0); } while (0)
    PV_D0(0); PV_D0(1); PV_D0(2); PV_D0(3);
#undef PV_D0
#undef TRRD
}

struct Ctx {
    LAS unsigned char* lds; int tid, wid, lane, r32, hi, sr, sc, vst0, vst1, kws, vb0;
    LAS float* li_l; LAS float* al_l;
};
__device__ __forceinline__ Ctx make_ctx(LAS unsigned char* lds) {
    Ctx c; c.lds = lds; c.tid = threadIdx.x; asm volatile("" : "+v"(c.tid));
    c.wid = __builtin_amdgcn_readfirstlane(c.tid >> 6); c.lane = c.tid & 63; c.r32 = c.lane & 31; c.hi = c.lane >> 5;
    c.sr = c.tid >> 4; c.sc = (c.tid & 15) * 8; c.vst0 = v_st(c.sr, c.sc); c.vst1 = v_st(32 + c.sr, c.sc); c.kws = KSWZ(c.sr, c.sc * 2);
    c.vb0 = (int)(unsigned)(uintptr_t)lds + v_rd_base(c.lane);
    LAS float* wsf = (LAS float*)(lds + L_WS) + c.wid * 64; c.li_l = wsf; c.al_l = wsf + 32;
    return c;
}
struct Stage { bf16x8 k0, k1, v0, v1; };
__device__ __forceinline__ void sload(Stage& S, const bf16_t* Kh, const bf16_t* Vh, int k0, const Ctx& c) {
    S.v0 = *(const bf16x8*)(Vh + (size_t)(k0 + c.sr) * HD + c.sc); S.v1 = *(const bf16x8*)(Vh + (size_t)(k0 + 32 + c.sr) * HD + c.sc);
    S.k0 = *(const bf16x8*)(Kh + (size_t)(k0 + c.sr) * HD + c.sc); S.k1 = *(const bf16x8*)(Kh + (size_t)(k0 + 32 + c.sr) * HD + c.sc);
}
__device__ __forceinline__ void swrite(const Stage& S, int bf, const Ctx& c) {
    *(LAS bf16x8*)(c.lds + L_V + bf * SHM + c.vst0) = S.v0; *(LAS bf16x8*)(c.lds + L_V + bf * SHM + c.vst1) = S.v1;
    *(LAS bf16x8*)(c.lds + L_K + bf * SHM + c.kws) = S.k0; *(LAS bf16x8*)(c.lds + L_K + bf * SHM + c.kws + 32 * 256) = S.k1;
}
__device__ __forceinline__ void rescale_rows(f32x16 (&o)[4], float a, const Ctx& c) {
    if (c.hi == 0) c.al_l[c.r32] = a;
    asm volatile("s_waitcnt lgkmcnt(0)" ::: "memory");
    float s[16];
#pragma unroll
    for (int r = 0; r < 16; ++r) s[r] = c.al_l[crow(r, c.hi)];
#pragma unroll
    for (int d = 0; d < 4; ++d)
#pragma unroll
        for (int r = 0; r < 16; ++r) o[d][r] *= s[r];
    asm volatile("s_waitcnt lgkmcnt(0)" ::: "memory");
}
template <int BUF, int MK>
__device__ __forceinline__ void tile_step(f32x16 (&o)[4], float& m_reg, float& l_reg, const bf16x8* qf, const Ctx& c, int j, int tpos, unsigned sel, int jcur) {
    f32x16 p0, p1; float mn, alpha; bf16x8 pa0, pa1, pa2, pa3;
    if (MK == 1) { const bool act = __any((sel >> j) & 1u); if (!act) return; }
    qkt<BUF>(p0, p1, c.lds, c.r32, c.hi, qf);
    const int dq = tpos - KVBLK * j - 4 * c.hi;
    if (MK == 0) { if (j == jcur || j == jcur - 8) mask_tile(p0, p1, dq, 512u); }
    else { if (j == jcur) mask_tile(p0, p1, dq, 0x7fffffffu);
        const bool on = (sel >> j) & 1u; const float NEG = -__builtin_inff();
#pragma unroll
        for (int r = 0; r < 16; ++r) { p0[r] = on ? p0[r] : NEG; p1[r] = on ? p1[r] : NEG; } }
    partialSM(p0, p1, m_reg, mn, alpha);
    if (__any(alpha < 1.f)) rescale_rows(o, alpha, c);
    finishSM(p0, p1, alpha, l_reg, pa0, pa1, pa2, pa3); SBAR();
    pv_tile<BUF>(o, c.vb0, pa0, pa1, pa2, pa3);
}
template <int MK>
__device__ __forceinline__ void run_tiles(f32x16 (&o)[4], float& m_reg, float& l_reg, const bf16x8* qf, const Ctx& c, const bf16_t* Kh, const bf16_t* Vh,
                                          unsigned tiles, int tpos, unsigned sel, int jcur) {
    Stage S;
    int j = __ffs((int)tiles) - 1; tiles &= tiles - 1;
    sload(S, Kh, Vh, KVBLK * j, c); swrite(S, 0, c);
    __syncthreads();
    for (;;) {
        int jn = tiles ? __ffs((int)tiles) - 1 : -1; tiles &= tiles - 1;
        if (jn >= 0) sload(S, Kh, Vh, KVBLK * jn, c);
        tile_step<0, MK>(o, m_reg, l_reg, qf, c, j, tpos, sel, jcur);
        if (jn >= 0) swrite(S, 1, c);
        __syncthreads();
        if (jn < 0) break;
        j = jn; jn = tiles ? __ffs((int)tiles) - 1 : -1; tiles &= tiles - 1;
        if (jn >= 0) sload(S, Kh, Vh, KVBLK * jn, c);
        tile_step<1, MK>(o, m_reg, l_reg, qf, c, j, tpos, sel, jcur);
        if (jn >= 0) swrite(S, 0, c);
        __syncthreads();
        if (jn < 0) break;
        j = jn;
    }
}
__device__ __forceinline__ void load_q(bf16x8 (&qf)[8], const bf16_t* Q, int row, int h, int hi) {
    const bf16_t* qp = Q + (size_t)row * DM + h * HD + hi * 8;
#pragma unroll
    for (int d0 = 0; d0 < 8; ++d0) qf[d0] = *(const bf16x8*)(qp + d0 * 16);
}
__device__ __forceinline__ void rotate_q(bf16x8& q0, bf16x8& q1, const float* COS, const float* SIN, int t, int hi) {
    const f32x4 c0 = *(const f32x4*)(COS + t * 16 + hi * 8), c1 = *(const f32x4*)(COS + t * 16 + hi * 8 + 4);
    const f32x4 s0 = *(const f32x4*)(SIN + t * 16 + hi * 8), s1 = *(const f32x4*)(SIN + t * 16 + hi * 8 + 4);
    f32x4 a0, a1, b0, b1;
#pragma unroll
    for (int jj = 0; jj < 4; ++jj) { a0[jj] = bf2f((bf16_t)q0[jj]); a1[jj] = bf2f((bf16_t)q0[4 + jj]); b0[jj] = bf2f((bf16_t)q1[jj]); b1[jj] = bf2f((bf16_t)q1[4 + jj]); }
    q0 = pack8(a0 * c0 - b0 * s0, a1 * c1 - b1 * s1);
    q1 = pack8(b0 * c0 + a0 * s0, b1 * c1 + a1 * s1);
}

__device__ __forceinline__ void window_unit(const Args& a, LAS unsigned char* lds, int bg, int qb) {
    unsigned char* ws = a.ws;
    const Ctx c = make_ctx(lds);
    const int n = c.wid >> 1, th = c.wid & 1, tq = 32 * th + c.r32, t = 64 * qb + tq, b = bg >> 2, g = bg & 3, h = g * 4 + n, row = b * SEQ + t;
    bf16x8 qf[8];
    load_q(qf, (const bf16_t*)(ws + WS_Q), row, h, c.hi);
    rotate_q(qf[0], qf[1], (const float*)(ws + WS_COS), (const float*)(ws + WS_SIN), t, c.hi);
    const bf16_t* Kh = (const bf16_t*)(ws + WS_KV) + 4 * KV_ELEMS + (size_t)bg * SEQ * HD; const bf16_t* Vh = (const bf16_t*)(ws + WS_KV) + 5 * KV_ELEMS + (size_t)bg * SEQ * HD;
    f32x16 o[4] = {}; float m_reg = -1e30f, l_reg = 0.f;
    const int jlo = qb >= 8 ? qb - 8 : 0;
    const unsigned tiles = (qb == 31 ? 0xffffffffu : ((1u << (qb + 1)) - 1u)) & ~((1u << jlo) - 1u);
    run_tiles<0>(o, m_reg, l_reg, qf, c, Kh, Vh, tiles, t, 0u, qb);
    const float g2 = sigmoid_f(((const float*)(ws + WS_GL))[(size_t)row * 48 + 32 + h]);
    rescale_rows(o, l_reg > 0.f ? g2 / l_reg : 0.f, c);
    bf16_t* OW = (bf16_t*)(ws + WS_XB);
    const int rbase = b * SEQ + 64 * qb + 32 * th;
#pragma unroll
    for (int r = 0; r < 16; ++r) { const int orow = rbase + crow(r, c.hi);
#pragma unroll
        for (int d0 = 0; d0 < 4; ++d0) { const float v = o[d0][r]; const float vn = __shfl_xor(v, 1);
            if ((c.r32 & 1) == 0) *(unsigned*)(OW + (size_t)orow * DM + h * HD + d0 * 32 + c.r32) = cvt_pk_bf16(v, vn); } }
}

__device__ __forceinline__ void cmpsel_unit(const Args& a, LAS unsigned char* lds, int bg, int qb) {
    unsigned char* ws = a.ws;
    const Ctx c = make_ctx(lds);
    const int n = c.wid >> 1, th = c.wid & 1, tq = 32 * th + c.r32, t = 64 * qb + tq, b = bg >> 2, g = bg & 3, h = g * 4 + n, row = b * SEQ + t;
    const float* GL = (const float*)(ws + WS_GL);
    LAS float* GS = (LAS float*)(lds + L_GS); LAS float* LS = (LAS float*)(lds + L_LS);
    LAS unsigned* SEL = (LAS unsigned*)(lds + L_SEL); LAS unsigned* UNI = (LAS unsigned*)(lds + L_UNI);
    bf16x8 qf[8];
    load_q(qf, (const bf16_t*)(ws + WS_Q), row, h, c.hi);
    f32x16 o[4] = {};
    float l_c;
    {
        const bf16_t* Kc = (const bf16_t*)(ws + WS_KC) + (size_t)bg * 128 * HD; const bf16_t* Vc = (const bf16_t*)(ws + WS_VC) + (size_t)bg * 128 * HD;
        { Stage S0; sload(S0, Kc, Vc, 0, c); swrite(S0, 0, c); }
        { Stage S1; sload(S1, Kc, Vc, 64, c); swrite(S1, 1, c); }
        __syncthreads();
        f32x16 pA0, pA1, pB0, pB1;
        qkt<0>(pA0, pA1, c.lds, c.r32, c.hi, qf); qkt<1>(pB0, pB1, c.lds, c.r32, c.hi, qf);
        const int cmax = t >= 31 ? ((t - 31) >> 4) : -1;
        const float NEG = -__builtin_inff();
#pragma unroll
        for (int r = 0; r < 16; ++r) { const int cc = crow(r, c.hi);
            if (cc > cmax) pA0[r] = NEG; if (cc + 32 > cmax) pA1[r] = NEG; if (cc + 64 > cmax) pB0[r] = NEG; if (cc + 96 > cmax) pB1[r] = NEG; }
        float mx = -1e30f;
#pragma unroll
        for (int r = 0; r < 16; ++r) mx = fmaxf(fmaxf(mx, fmaxf(pA0[r], pA1[r])), fmaxf(pB0[r], pB1[r]));
        { auto rr = __builtin_amdgcn_permlane32_swap(__float_as_uint(mx), __float_as_uint(mx), false, false); mx = fmaxf(__uint_as_float(rr[0]), __uint_as_float(rr[1])); }
        constexpr float C2 = 1.4426950408889634f * SCALE;
        const float mnL = -mx * C2; float ps = 0.f;
#pragma unroll
        for (int r = 0; r < 16; ++r) { pA0[r] = __builtin_amdgcn_exp2f(fmaf(pA0[r], C2, mnL)); pA1[r] = __builtin_amdgcn_exp2f(fmaf(pA1[r], C2, mnL));
            pB0[r] = __builtin_amdgcn_exp2f(fmaf(pB0[r], C2, mnL)); pB1[r] = __builtin_amdgcn_exp2f(fmaf(pB1[r], C2, mnL)); ps += (pA0[r] + pA1[r]) + (pB0[r] + pB1[r]); }
        { auto rr = __builtin_amdgcn_permlane32_swap(__float_as_uint(ps), __float_as_uint(ps), false, false); ps = __uint_as_float(rr[0]) + __uint_as_float(rr[1]); }
        l_c = ps;
        const float inv = ps > 0.f ? 1.0f / ps : 0.f;
        LAS float* gsr = GS + (n * 64 + tq) * 33; LAS float* lsr = LS + (n * 64 + tq) * 33;
#pragma unroll
        for (int k = 0; k < 4; ++k) {
            const int jb = 2 * k + c.hi;
            gsr[jb]      = ((pA0[4 * k] + pA0[4 * k + 1]) + (pA0[4 * k + 2] + pA0[4 * k + 3])) * inv; lsr[jb]      = pA0[4 * k + 3] * inv;
            gsr[8 + jb]  = ((pA1[4 * k] + pA1[4 * k + 1]) + (pA1[4 * k + 2] + pA1[4 * k + 3])) * inv; lsr[8 + jb]  = pA1[4 * k + 3] * inv;
            gsr[16 + jb] = ((pB0[4 * k] + pB0[4 * k + 1]) + (pB0[4 * k + 2] + pB0[4 * k + 3])) * inv; lsr[16 + jb] = pB0[4 * k + 3] * inv;
            gsr[24 + jb] = ((pB1[4 * k] + pB1[4 * k + 1]) + (pB1[4 * k + 2] + pB1[4 * k + 3])) * inv; lsr[24 + jb] = pB1[4 * k + 3] * inv;
        }
        bf16x8 pa0, pa1, pa2, pa3;
        pack_p(pA0, pA1, pa0, pa1, pa2, pa3); SBAR(); pv_tile<0>(o, c.vb0, pa0, pa1, pa2, pa3);
        pack_p(pB0, pB1, pa0, pa1, pa2, pa3); SBAR(); pv_tile<1>(o, c.vb0, pa0, pa1, pa2, pa3);
    }
    __syncthreads();
    {
        LAS float* IMP = (LAS float*)(lds + L_IMP);
        const int tk = c.tid & 63, j0 = c.wid * 4;
        const LAS float* gb = GS + tk * 33 + j0; const LAS float* lb = LS + tk * 33 + j0 - 1;
#pragma unroll
        for (int jj = 0; jj < 4; ++jj) { float s = 0.f;
#pragma unroll
            for (int nn = 0; nn < 4; ++nn) { s += gb[nn * 2112 + jj]; const float lv = lb[nn * 2112 + jj]; s += (j0 + jj > 0) ? lv : 0.f; }
            IMP[tk * 33 + j0 + jj] = s; }
    }
    __syncthreads();
    if (c.wid == 0) {
        const LAS float* IMP = (const LAS float*)(lds + L_IMP);
        const int tk = c.lane;
        unsigned selm = 1u | (1u << qb);
        if (qb >= 2) {
            const int nfree = qb - 1;
            if (nfree <= 6) selm |= ((1u << qb) - 1u) & ~1u;
            else {
                float v[32];
#pragma unroll
                for (int jj = 1; jj < 31; ++jj) { const float s = IMP[tk * 33 + jj]; v[jj] = (jj < qb) ? s : -1.0f; }
                unsigned taken = 0u;
                for (int rnd = 0; rnd < 6; ++rnd) {
                    float best = -0.5f; int bi = -1;
#pragma unroll
                    for (int jj = 1; jj < 31; ++jj) { const bool ok = !((taken >> jj) & 1u) && v[jj] > best; best = ok ? v[jj] : best; bi = ok ? jj : bi; }
                    if (bi >= 0) taken |= 1u << bi;
                }
                selm |= taken;
            }
        }
        SEL[tk] = selm;
        unsigned u = selm;
#pragma unroll
        for (int off = 1; off < 64; off <<= 1) u |= (unsigned)__shfl_xor((int)u, off);
        if (c.lane == 0) UNI[0] = u;
    }
    bf16_t* ZC = (bf16_t*)(ws + WS_ZC);
    const int rbase = b * SEQ + 64 * qb + 32 * th;
    {
        const float g0 = sigmoid_f(GL[(size_t)row * 48 + h]);
        rescale_rows(o, l_c > 0.f ? g0 / l_c : 0.f, c);
#pragma unroll
        for (int r = 0; r < 16; ++r) { const int orow = rbase + crow(r, c.hi);
#pragma unroll
            for (int d0 = 0; d0 < 4; ++d0) ZC[(size_t)orow * ZC_LD + 2048 + h * HD + d0 * 32 + c.r32] = (bf16_t)(cvt_pk_bf16(o[d0][r], 0.f) & 0xffffu); }
#pragma unroll
        for (int d = 0; d < 4; ++d) o[d] = f32x16{};
    }
    __syncthreads();
    const unsigned sel = SEL[tq]; const unsigned uni = (unsigned)__builtin_amdgcn_readfirstlane((int)UNI[0]);
    rotate_q(qf[0], qf[1], (const float*)(ws + WS_COS), (const float*)(ws + WS_SIN), t, c.hi);
    float m_reg = -1e30f, l_reg = 0.f;
    {
        const bf16_t* Kh = (const bf16_t*)(ws + WS_KV) + 2 * KV_ELEMS + (size_t)bg * SEQ * HD; const bf16_t* Vh = (const bf16_t*)(ws + WS_KV) + 3 * KV_ELEMS + (size_t)bg * SEQ * HD;
        run_tiles<1>(o, m_reg, l_reg, qf, c, Kh, Vh, uni, t, sel, qb);
    }
    const float g1 = sigmoid_f(GL[(size_t)row * 48 + 16 + h]);
    rescale_rows(o, l_reg > 0.f ? g1 / l_reg : 0.f, c);
    const bf16_t* OW = (const bf16_t*)(ws + WS_XB); const bf16_t* NG = (const bf16_t*)(ws + WS_NG);
    int rbase2 = rbase; asm volatile("" : "+v"(rbase2));
#pragma unroll
    for (int r = 0; r < 16; ++r) { const int orow = rbase2 + crow(r, c.hi);
#pragma unroll
        for (int d0 = 0; d0 < 4; ++d0) {
            const size_t col = (size_t)h * HD + d0 * 32 + c.r32;
            bf16_t* yp = ZC + (size_t)orow * ZC_LD + 2048 + col;
            const float occ = bf2f(*yp);
            const float ow = bf2f(OW[(size_t)orow * DM + col]), ng = bf2f(NG[(size_t)orow * DM + col]);
            const float v = (occ + o[d0][r] + ow) * silu_f(ng);
            *yp = (bf16_t)(cvt_pk_bf16(v, 0.f) & 0xffffu); } }
    __syncthreads();
}

__device__ __forceinline__ void compress_unit(const Args& a, LAS unsigned char* lds, int task) {
    unsigned char* ws = a.ws;
    int tid = threadIdx.x; asm volatile("" : "+v"(tid));
    const int wid = __builtin_amdgcn_readfirstlane(tid >> 6), lane = tid & 63, r32 = lane & 31, hi = lane >> 5;
    const int mb = task & 3, bg = (task >> 2) & 15, kv = task >> 6;
    const bf16_t* X = (const bf16_t*)(ws + WS_KV) + (size_t)kv * KV_ELEMS + (size_t)bg * SEQ * HD;
    const bf16_t* W1T = (const bf16_t*)(ws + WS_W1T) + (size_t)kv * 128 * 4096;
    const bf16_t* W2T = (const bf16_t*)(ws + WS_W2T) + (size_t)kv * 128 * 128;
    int cc = 32 * mb + r32; if (cc > NCMP - 1) cc = NCMP - 1;
    f32x16 acc[4] = {};
#pragma unroll 1
    for (int l = 4 * wid; l < 4 * wid + 4; ++l) {
        const bf16_t* xr = X + (size_t)(16 * cc + l) * HD + hi * 8;
        const bf16_t* wr = W1T + (size_t)r32 * 4096 + l * 128 + hi * 8;
#pragma unroll
        for (int ks = 0; ks < 8; ++ks) {
            const bf16x8 af = *(const bf16x8*)(xr + 16 * ks);
#pragma unroll
            for (int nb = 0; nb < 4; ++nb) { const bf16x8 bfr = *(const bf16x8*)(wr + (size_t)nb * 32 * 4096 + 16 * ks);
                acc[nb] = __builtin_amdgcn_mfma_f32_32x32x16_bf16(af, bfr, acc[nb], 0, 0, 0); }
        }
    }
    LAS float* part = (LAS float*)lds;
    LAS bf16_t* hid = (LAS bf16_t*)(lds + 131072);
#pragma unroll
    for (int nb = 0; nb < 4; ++nb)
#pragma unroll
        for (int r = 0; r < 16; ++r) part[wid * 4096 + crow(r, hi) * 128 + nb * 32 + r32] = acc[nb][r];
    __syncthreads();
    {
        const float* PBP = (const float*)(ws + WS_PBP) + kv * 4096; const float* b1 = a.in[kv ? 10 : 6];
        for (int e = tid; e < 32 * 128; e += NTHREADS) { const int j = e & 127, m = e >> 7;
            float s = b1[j];
            for (int q = 0; q < 32; ++q) s += PBP[q * 128 + j];
#pragma unroll
            for (int w = 0; w < 8; ++w) s += part[w * 4096 + e];
            hid[m * 136 + j] = (bf16_t)f2bf(silu_f(s)); }
    }
    __syncthreads();
    if (wid < 4) {
        f32x16 o2 = {};
#pragma unroll
        for (int ks = 0; ks < 8; ++ks) {
            const bf16x8 af = *(const LAS bf16x8*)(hid + r32 * 136 + 16 * ks + hi * 8);
            const bf16x8 bfr = *(const bf16x8*)(W2T + (size_t)(32 * wid + r32) * 128 + 16 * ks + hi * 8);
            o2 = __builtin_amdgcn_mfma_f32_32x32x16_bf16(af, bfr, o2, 0, 0, 0);
        }
        bf16_t* dst = (bf16_t*)(ws + (kv ? WS_VC : WS_KC)) + (size_t)bg * 128 * 128;
#pragma unroll
        for (int r = 0; r < 16; ++r) { const int c2 = 32 * mb + crow(r, hi);
            dst[(size_t)c2 * 128 + 32 * wid + r32] = (bf16_t)(c2 < NCMP ? f2bf(o2[r]) : 0u); }
    }
    __syncthreads();
}

constexpr int SGU_UZ = 65536, SGU_UZ_LD = 264;
__device__ __forceinline__ void sgu_unit(const Args& a, LAS unsigned char* lds, int ch, int h, bool dry = false) {
    unsigned char* ws = a.ws;
    int tid = threadIdx.x; asm volatile("" : "+v"(tid));
    const int wid = __builtin_amdgcn_readfirstlane(tid >> 6), lane = tid & 63, r32 = lane & 31, hi = lane >> 5;
    const int tb = wid & 3, dh = wid >> 2, row0 = ch * 128;
    bf16_t* Z1 = (bf16_t*)(ws + WS_Z1); const float* LNS = (const float*)(ws + WS_LNS);
    const float* lng = a.in[15]; const float* lnb = a.in[16]; const float* bsp = a.in[18];
    LAS bf16_t* UZ = (LAS bf16_t*)(lds + SGU_UZ);
    const int sr = tid >> 4, sc = (tid & 15) * 8;
    {
#pragma unroll
        for (int dhh = 0; dhh < 2; ++dhh) {
            const int col = h * 256 + dhh * 128 + sc;
            const f32x4 g0 = *(const f32x4*)(lng + col), g1 = *(const f32x4*)(lng + col + 4), b0 = *(const f32x4*)(lnb + col), b1 = *(const f32x4*)(lnb + col + 4);
#pragma unroll
            for (int q = 0; q < 4; ++q) {
                const int s = 32 * q + sr, row = row0 + s;
                const bf16_t* zp = Z1 + (size_t)row * N1 + col;
                const u32x4 uu = *(const u32x4*)zp, vv = *(const u32x4*)(zp + MIXW), zz = *(const u32x4*)(zp + 2 * MIXW);
                const float sum = LNS[2 * row], sq = LNS[2 * row + 1]; const float mu = sum * (1.0f / MIXW);
                const float rstd = __builtin_amdgcn_rsqf(fmaxf(sq * (1.0f / MIXW) - mu * mu, 0.f) + EPS);
                f32x4 x0 = {bf_lo(vv.x), bf_hi(vv.x), bf_lo(vv.y), bf_hi(vv.y)}, x1 = {bf_lo(vv.z), bf_hi(vv.z), bf_lo(vv.w), bf_hi(vv.w)};
                x0 = (x0 - mu) * rstd * g0 + b0; x1 = (x1 - mu) * rstd * g1 + b1;
                *(LAS bf16x8*)(lds + L_V + ((q >> 1) * 2 + dhh) * SHM + v_st(32 * (q & 1) + sr, sc)) = pack8(x0, x1);
                f32x4 y0 = {bf_lo(uu.x) * silu_f(bf_lo(zz.x)), bf_hi(uu.x) * silu_f(bf_hi(zz.x)), bf_lo(uu.y) * silu_f(bf_lo(zz.y)), bf_hi(uu.y) * silu_f(bf_hi(zz.y))};
                f32x4 y1 = {bf_lo(uu.z) * silu_f(bf_lo(zz.z)), bf_hi(uu.z) * silu_f(bf_hi(zz.z)), bf_lo(uu.w) * silu_f(bf_lo(zz.w)), bf_hi(uu.w) * silu_f(bf_hi(zz.w))};
                *(LAS bf16x8*)(UZ + s * SGU_UZ_LD + dhh * 128 + sc) = pack8(y0, y1);
            }
        }
    }
    __syncthreads();
    f32x16 o[4] = {};
    {
        const bf16_t* wp = (const bf16_t*)(ws + WS_SW) + (size_t)(h * 128 + 32 * tb + r32) * 128 + hi * 8;
        const int vb0 = (int)(unsigned)(uintptr_t)lds + v_rd_base(lane);
        bf16x8 pa0 = *(const bf16x8*)(wp), pa1 = *(const bf16x8*)(wp + 16), pa2 = *(const bf16x8*)(wp + 32), pa3 = *(const bf16x8*)(wp + 48);
        if (dh == 0) pv_tile<0>(o, vb0, pa0, pa1, pa2, pa3); else pv_tile<1>(o, vb0, pa0, pa1, pa2, pa3);
        if (tb >= 2) {
            pa0 = *(const bf16x8*)(wp + 64); pa1 = *(const bf16x8*)(wp + 80); pa2 = *(const bf16x8*)(wp + 96); pa3 = *(const bf16x8*)(wp + 112);
            if (dh == 0) pv_tile<2>(o, vb0, pa0, pa1, pa2, pa3); else pv_tile<3>(o, vb0, pa0, pa1, pa2, pa3);
        }
    }
#pragma unroll
    for (int r = 0; r < 16; ++r) { const int t = 32 * tb + crow(r, hi); const float bias = bsp[h * 128 + t];
        LAS bf16_t* up = UZ + t * SGU_UZ_LD + dh * 128 + r32;
#pragma unroll
        for (int d0 = 0; d0 < 4; ++d0) up[d0 * 32] = (bf16_t)f2bf(bf2f(up[d0 * 32]) * (o[d0][r] + bias)); }
    __syncthreads();
#pragma unroll
    for (int dhh = 0; dhh < 2; ++dhh)
#pragma unroll
        for (int q = 0; q < 4; ++q) { const int s = 32 * q + sr;
            const u32x4 yv = *(const LAS u32x4*)(UZ + s * SGU_UZ_LD + dhh * 128 + sc);
            *(u32x4*)(dry ? (bf16_t*)(ws + WS_DUMMY) + tid * 8 : Z1 + (size_t)(row0 + s) * N1 + h * 256 + dhh * 128 + sc) = yv; }
    __syncthreads();
}
}

__device__ __forceinline__ void p6_sgu_naive(const Args& a, LAS unsigned char* lds, int blk, int G, int tid) {
    LAS float* vn = (LAS float*)lds;
    LAS float* Wt = (LAS float*)(lds + 65536);
    bf16_t* Z1 = (bf16_t*)(a.ws + WS_Z1); const float* LNS = (const float*)(a.ws + WS_LNS);
    const float* lng = a.in[15]; const float* lnb = a.in[16]; const float* wsp = a.in[17]; const float* bsp = a.in[18];
    const int d = tid & 127, tq = tid >> 7;
    for (int unit = blk; unit < 64 * 16 * 2; unit += G) {
        const int dh = unit & 1, h = (unit >> 1) & 15, ch = unit >> 5;
        const int row0 = ch * 128, col = h * 256 + dh * 128;
        __syncthreads();
        for (int i = tid; i < 128 * 128; i += NTHREADS) { const int s = i >> 7, dd = i & 127; const int row = row0 + s;
            const float sum = LNS[2 * row], sq = LNS[2 * row + 1]; const float mu = sum * (1.0f / MIXW); const float var = sq * (1.0f / MIXW) - mu * mu;
            const float rstd = 1.0f / sqrtf(fmaxf(var, 0.f) + EPS);
            const float v = bf2f(Z1[(size_t)row * N1 + MIXW + col + dd]);
            vn[i] = (v - mu) * rstd * lng[col + dd] + lnb[col + dd];
            Wt[i] = wsp[(size_t)h * 16384 + i]; }
        __syncthreads();
        for (int tt = 0; tt < 32; ++tt) {
            const int t = tq + 4 * tt;
            float mix = 0.f;
            for (int s = 0; s <= t; ++s) mix += Wt[t * 128 + s] * vn[s * 128 + d];
            mix += bsp[h * 128 + t];
            const size_t off = (size_t)(row0 + t) * N1 + col + d;
            const float u = bf2f(Z1[off]), zg = bf2f(Z1[off + 2 * MIXW]);
            Z1[off] = (bf16_t)f2bf(u * mix * silu_f(zg));
        }
    }
    __syncthreads();
}

__device__ __forceinline__ void p8_final(const Args& a, int gw, int NGW, int lane, bool dry = false) {
    const float* gf = a.in[20];
    for (int m = gw; m < MTOK; m += NGW) {
        f32x4* xr = (f32x4*)(a.out + (size_t)m * DM) + lane;
        f32x4 v[8]; float s = 0.f;
#pragma unroll
        for (int j = 0; j < 8; ++j) { v[j] = xr[64 * j]; s += (v[j].x * v[j].x + v[j].y * v[j].y) + (v[j].z * v[j].z + v[j].w * v[j].w); }
        s = wave_sum(s);
        const float rs = 1.0f / sqrtf(s * (1.0f / DM) + EPS);
#pragma unroll
        for (int j = 0; j < 8; ++j) { const f32x4 gg = *((const f32x4*)gf + lane + 64 * j); if (dry) *((f32x4*)(a.ws + WS_DUMMY) + lane) = v[j] * rs * gg; else xr[64 * j] = v[j] * rs * gg; }
    }
}

#define GAS __attribute__((address_space(1)))
typedef GAS unsigned gu32;
#define XB_TMO      128
#define XB_XCNT(j)  (256  + 64 * (j))
#define XB_XSUB(j)  (1280 + 64 * (j))
#define XB_XGEN(j)  (2304 + 64 * (j))
#define XB_TOP      3328
#define XB_TOPGEN   3392
#define XCD_BAR_WORDS 3456
#define XB_SPIN_CAP (1u << 18)

__device__ __forceinline__ unsigned xb_ld(unsigned* p)              { return __hip_atomic_load(p, __ATOMIC_RELAXED, __HIP_MEMORY_SCOPE_AGENT); }
__device__ __forceinline__ unsigned xb_add(unsigned* p, unsigned v) { return __hip_atomic_fetch_add(p, v, __ATOMIC_RELAXED, __HIP_MEMORY_SCOPE_AGENT); }
__device__ __forceinline__ unsigned xb_xcc_id() { return (unsigned)__builtin_amdgcn_s_getreg((3 << 11) | 20) & 0xFu; }
#define XB_SPIN(cond, bar) do { unsigned _sp = 0; while (cond) { __builtin_amdgcn_s_sleep(1); \
    if ((++_sp & 255u) == 0u) { if (xb_ld(&(bar)[XB_TMO])) break; if (_sp > XB_SPIN_CAP) { atomicAdd(&(bar)[XB_TMO], 1u); break; } } } } while (0)

struct XcdBarrier {
    unsigned* bar; unsigned x;
    volatile LAS unsigned* st;
};

__device__ __forceinline__ XcdBarrier xcd_barrier_post(unsigned* bar, volatile LAS unsigned* st) {
    XcdBarrier b; b.bar = bar; b.x = xb_xcc_id(); b.st = st;
    if (threadIdx.x == 0) (void)xb_add(&bar[XB_XCNT(b.x)], 1u);
    return b;
}
__device__ __forceinline__ void xcd_barrier_complete(unsigned* bar, unsigned x, unsigned& nloc, unsigned& nx) {
    const unsigned G = gridDim.x * gridDim.y * gridDim.z;
    unsigned sum, cnt, mine, sp = 0u;
    for (;;) {
        sum = 0u; cnt = 0u; mine = 0u;
#pragma unroll
        for (unsigned j = 0; j < 16; ++j) { const unsigned c = xb_ld(&bar[XB_XCNT(j)]); sum += c; cnt += (c > 0u) ? 1u : 0u; mine = (j == x) ? c : mine; }
        if (sum == G) break;
        __builtin_amdgcn_s_sleep(1);
        if ((++sp & 255u) == 0u) { if (xb_ld(&bar[XB_TMO])) break; if (sp > XB_SPIN_CAP) { atomicAdd(&bar[XB_TMO], 1u); break; } }
    }
    nloc = mine > 0u ? mine : 1u; nx = cnt > 0u ? cnt : 1u;
}

__device__ __forceinline__ void xcd_barrier(const XcdBarrier& b) {
    asm volatile("s_waitcnt vmcnt(0)" ::: "memory");
    __syncthreads();
    if (threadIdx.x == 0) {
        unsigned* bar = b.bar;
        __builtin_amdgcn_s_waitcnt(0);
        unsigned nloc = b.st[0], nx = b.st[1];
        if (nloc == 0u) { xcd_barrier_complete(bar, b.x, nloc, nx); b.st[0] = nloc; b.st[1] = nx; }
        const unsigned old = xb_add(&bar[XB_XSUB(b.x)], 1u);
        const unsigned gen = old / nloc;
        if (old + 1u == (gen + 1u) * nloc) {
            __builtin_amdgcn_fence(__ATOMIC_RELEASE, "agent");
            asm volatile("s_waitcnt vmcnt(0)" ::: "memory");
            const unsigned og = xb_add(&bar[XB_TOP], 1u);
            const unsigned tg = og / nx;
            if (og + 1u == (tg + 1u) * nx) xb_add(&bar[XB_TOPGEN], 1u);
            else XB_SPIN(xb_ld(&bar[XB_TOPGEN]) == tg, bar);
            __builtin_amdgcn_fence(__ATOMIC_ACQUIRE, "agent");
            xb_add(&bar[XB_XGEN(b.x)], 1u);
            asm volatile("s_waitcnt vmcnt(0)" ::: "memory");
        } else {
            XB_SPIN(xb_ld(&bar[XB_XGEN(b.x)]) == gen, bar);
            __builtin_amdgcn_fence(__ATOMIC_ACQUIRE, "agent");
            asm volatile("s_waitcnt vmcnt(0)" ::: "memory");
        }
    }
    __syncthreads();
}

#ifndef STAG_TICKS
#define STAG_TICKS 250
#endif
__device__ __forceinline__ void stagger_ticks(unsigned d) {
    const unsigned long long t0 = __builtin_amdgcn_s_memrealtime();
    while (__builtin_amdgcn_s_memrealtime() - t0 < (unsigned long long)d) __builtin_amdgcn_s_sleep(16);
}
__device__ __forceinline__ void stagger(int vcu) { stagger_ticks((unsigned)((vcu & 7) * STAG_TICKS)); }
__device__ __forceinline__ void stagger_p1(int bx) {
    const unsigned d = bx < 160 ? (unsigned)(((bx >> 3) % 5) * 250) : (unsigned)(1500 + (((bx - 160) >> 3) % 3) * 1000);
    stagger_ticks(d);
}

constexpr int NPHASE = 9;
template <bool COOP>
__global__ void __launch_bounds__(NTHREADS, 2) fwd_kernel(Args args) {
    extern __shared__ __attribute__((aligned(16))) unsigned char lds_raw[];
    LAS unsigned char* lds = (LAS unsigned char*)lds_raw;
    const int tid = threadIdx.x, lane = tid & 63, wave = __builtin_amdgcn_readfirstlane(tid >> 6);
    const int G = gridDim.x, bx = blockIdx.x;
    const int vcu = (G % 8 == 0) ? (bx % 8) * (G / 8) + bx / 8 : bx;
    const int gw = vcu * NWAVES + wave, NGW = G * NWAVES, gt = gw * 64 + lane, NGT = NGW * 64;
    const int lo = args.ph_lo, hi = args.ph_hi;
    unsigned char* ws = args.ws;
#define IN(k) (lo <= (k) && (k) < hi)
    unsigned* barw = (unsigned*)(ws + WS_BAR);
    volatile LAS unsigned* bst = (volatile LAS unsigned*)(lds + LDS_BYTES - 64);
    XcdBarrier bar; bar.bar = barw; bar.x = 0; bar.st = bst;
    if (COOP) {
        if (args.ph_lo < 0) cg::this_grid().sync();
        if (tid == 0) { bst[0] = 0u; bst[1] = 0u; }
        __syncthreads();
        bar = xcd_barrier_post(barw, bst);
    }
#define SEAM(k) do { if (COOP) { if (IN(k) && IN((k) + 1)) { xcd_barrier(bar); } } } while (0)

    if (IN(0)) {
#ifdef REP_P0
        p0_prologue(args, lds, vcu, G, wave, lane); __syncthreads();
#endif
        p0_prologue(args, lds, vcu, G, wave, lane);
    }
    SEAM(0);
#define P1_BODY do { \
        pg8::Gemm g{(const bf16_t*)(ws + WS_XB), (const bf16_t*)(ws + WS_WT0), MTOK, N0, DM, DM}; \
        pg8::StaticOrder S; S.init(MTOK, N0, G, bx); \
        pg8::Epi0 E{(const float*)(ws + WS_RSTD0), (bf16_t*)(ws + WS_ZC), (bf16_t*)(ws + WS_Q), (bf16_t*)(ws + WS_KV), (bf16_t*)(ws + WS_NG), (float*)(ws + WS_GL), \
                    (const float*)(ws + WS_COS), (const float*)(ws + WS_SIN)}; \
        pg8::gemm_phase<pg8::Epi0, pg8::StaticOrder, true, true>(lds, g, S, E); } while (0)
    if (IN(1)) {
#ifdef REP_P1
        P1_BODY; __syncthreads();
#endif
#if defined(REP_P1SLAB) || defined(REP_P1LIN)
        { pg8::Gemm g{(const bf16_t*)(ws + WS_XB), (const bf16_t*)(ws + WS_WT0), MTOK, N0, DM, DM}; pg8::StaticOrder S; S.init(MTOK, N0, G, bx);
#ifdef REP_P1SLAB
          typedef pg8::Epi0T<1> EP;
#else
          typedef pg8::Epi0T<2> EP;
#endif
          EP E{(const float*)(ws + WS_RSTD0), (bf16_t*)(ws + WS_ZC), (bf16_t*)(ws + WS_Q), (bf16_t*)(ws + WS_KV), (bf16_t*)(ws + WS_NG), (float*)(ws + WS_GL), (const float*)(ws + WS_COS), (const float*)(ws + WS_SIN)};
          pg8::gemm_phase<EP, pg8::StaticOrder, true, true>(lds, g, S, E); __syncthreads(); xcd_barrier(bar); }
#endif
#ifdef REP_P1DRY2
        { pg8::Gemm g{(const bf16_t*)(ws + WS_XB), (const bf16_t*)(ws + WS_WT0), MTOK, N0, DM, DM}; pg8::StaticOrder S; S.init(MTOK, N0, G, bx);
          pg8::EpiNull E{(float*)(ws + WS_PBP)}; pg8::gemm_phase<pg8::EpiNull, pg8::StaticOrder, true, true>(lds, g, S, E); __syncthreads(); }
#define REP_P1DRY 1
#endif
#ifdef REP_P1DRY
        { pg8::Gemm g{(const bf16_t*)(ws + WS_XB), (const bf16_t*)(ws + WS_WT0), MTOK, N0, DM, DM}; pg8::StaticOrder S; S.init(MTOK, N0, G, bx);
          pg8::EpiNull E{(float*)(ws + WS_PBP)}; pg8::gemm_phase<pg8::EpiNull, pg8::StaticOrder, true, true>(lds, g, S, E); __syncthreads(); }
#endif
        P1_BODY;
    }
    SEAM(1);
    if (IN(2)) {
#ifdef REP_P2C
        for (int task = vcu; task < 128; task += G) nsa::compress_unit(args, lds, task);
#endif
#ifdef REP_P2W
        for (int item = vcu; item < 256; item += G) { const int bg = item >> 4, p = item & 15; for (int k = 0; k < 2; ++k) nsa::window_unit(args, lds, bg, k ? 31 - p : p); }
#endif
        for (int task = vcu; task < 128; task += G) nsa::compress_unit(args, lds, task);
        if (G == 256) {
            const int u0 = vcu < 128 ? vcu : 128 + 3 * (vcu - 128), nu = vcu < 128 ? 1 : 3;
            for (int k = 0; k < nu; ++k) { const int u = u0 + k; nsa::window_unit(args, lds, u >> 5, u & 31); }
        } else {
            for (int item = vcu; item < 256; item += G) { const int bg = item >> 4, p = item & 15; for (int k = 0; k < 2; ++k) nsa::window_unit(args, lds, bg, k ? 31 - p : p); }
        }
#ifdef REP_CONV
        p2_conv(args, gt, MTOK * 256, NGT, true);
#endif
        p2_conv(args, gt, MTOK * 256, NGT);
    }
    SEAM(2);
    if (IN(3)) {
#ifdef REP_P3
      for (int rep = 0; rep < 2; ++rep)
#endif
        for (int item = vcu; item < 256; item += G) { const int bg = item >> 4, p = item & 15;
#ifndef NO_CMPSEL
            for (int k = 0; k < 2; ++k) nsa::cmpsel_unit(args, lds, bg, k ? 31 - p : p);
#endif
        }
    }
    SEAM(3);
    if (IN(4)) {
#ifdef REP_P4DRY
        { pg8::Gemm g{(const bf16_t*)(ws + WS_ZC), (const bf16_t*)(ws + WS_WTO0), MTOK, DM, MIXW, ZC_LD}; pg8::StaticOrder S; S.init(MTOK, DM, G, bx);
          pg8::EpiNull E{(float*)(ws + WS_PBP)}; pg8::gemm_phase<pg8::EpiNull, pg8::StaticOrder, true, true>(lds, g, S, E); __syncthreads(); }
#endif
        pg8::Gemm g{(const bf16_t*)(ws + WS_ZC), (const bf16_t*)(ws + WS_WTO0), MTOK, DM, MIXW, ZC_LD};
        pg8::StaticOrder S; S.init(MTOK, DM, G, bx);
        pg8::EpiOut0 E{args.in[0], args.out, (bf16_t*)(ws + WS_XB), (float*)(ws + WS_SS1)};
        pg8::gemm_phase<pg8::EpiOut0, pg8::StaticOrder, true, true>(lds, g, S, E);
    }
    SEAM(4);
    if (IN(5)) {
        pg8::Gemm g{(const bf16_t*)(ws + WS_XB), (const bf16_t*)(ws + WS_WT1), MTOK, N1, DM, DM};
        pg8::StaticOrder S; S.init(MTOK, N1, G, bx);
        pg8::Epi1 E{(const float*)(ws + WS_SS1), (bf16_t*)(ws + WS_Z1), (float*)(ws + WS_LNS)};
        pg8::gemm_phase<pg8::Epi1, pg8::StaticOrder, true, true>(lds, g, S, E);
    }
    SEAM(5);
    if (IN(6)) {
#ifdef REP_P6
        for (int unit = vcu; unit < 1024; unit += G) nsa::sgu_unit(args, lds, unit >> 4, unit & 15, true);
#endif
        for (int unit = vcu; unit < 1024; unit += G) nsa::sgu_unit(args, lds, unit >> 4, unit & 15); }
    SEAM(6);
    if (IN(7)) {
        pg8::Gemm g{(const bf16_t*)(ws + WS_Z1), (const bf16_t*)(ws + WS_WTO1), MTOK, DM, MIXW, N1};
        pg8::StaticOrder S; S.init(MTOK, DM, G, bx);
        pg8::EpiOut1 E{args.out};
        pg8::gemm_phase<pg8::EpiOut1, pg8::StaticOrder, true, true>(lds, g, S, E);
    }
    SEAM(7);
#ifdef REP_P8
    if (IN(8)) { p8_final(args, gw, NGW, lane, true); }
#endif
    if (IN(8)) { p8_final(args, gw, NGW, lane); }
#undef IN
#undef SEAM
}

#ifndef MK_COOP
#define MK_COOP 1
#endif

extern "C" void kernel_launch(void* const* d_in, const int* in_sizes, int n_in, void* d_out, int out_size, void* d_ws, size_t ws_size, hipStream_t stream) {
    static int grid = 0;
    if (grid == 0) {
        if (n_in != 21 || out_size != MTOK * DM || ws_size < WS_END) { fprintf(stderr, "kernel_launch: unexpected shapes (n_in %d out %d ws %zu)\n", n_in, out_size, ws_size); grid = -1; return; }
        int dev = 0, cus = 0, per_cu = 0;
        (void)hipGetDevice(&dev); (void)hipDeviceGetAttribute(&cus, hipDeviceAttributeMultiprocessorCount, dev);
        (void)hipFuncSetAttribute((const void*)fwd_kernel<true>, hipFuncAttributeMaxDynamicSharedMemorySize, LDS_BYTES);
        (void)hipFuncSetAttribute((const void*)fwd_kernel<false>, hipFuncAttributeMaxDynamicSharedMemorySize, LDS_BYTES);
        (void)hipOccupancyMaxActiveBlocksPerMultiprocessor(&per_cu, (const void*)fwd_kernel<true>, NTHREADS, LDS_BYTES);
        if (per_cu < 1) { fprintf(stderr, "kernel_launch: occupancy query says %d blocks per CU\n", per_cu); per_cu = 1; }
        (void)hipGetLastError();
        grid = cus;
        fprintf(stderr, "kernel_launch: grid %d (per_cu %d)\n", grid, per_cu);
    }
    if (grid < 0) return;
    Args a{};
    for (int i = 0; i < 21; ++i) a.in[i] = (const float*)d_in[i];
    a.out = (float*)d_out; a.ws = (unsigned char*)d_ws;
#if MK_COOP
    if (hipMemsetAsync((char*)d_ws + WS_BAR, 0, 16384, stream) != hipSuccess) { fprintf(stderr, "kernel_launch: memset of the barrier words failed\n"); return; }
    a.ph_lo = 0; a.ph_hi = NPHASE;
    void* kargs[] = {&a};
    hipError_t e = hipLaunchCooperativeKernel((const void*)fwd_kernel<true>, dim3(grid), dim3(NTHREADS), kargs, LDS_BYTES, stream);
    if (e != hipSuccess) fprintf(stderr, "cooperative launch failed: %s (grid %d)\n", hipGetErrorString(e), grid);
#else
    for (int p = 0; p < NPHASE; ++p) {
        a.ph_lo = p; a.ph_hi = p + 1;
        hipLaunchKernelGGL(fwd_kernel<false>, dim3(grid), dim3(NTHREADS), LDS_BYTES, stream, a);
    }
#endif
}
```

```cpp
#include <hip/hip_runtime.h>
#include <hip/hip_cooperative_groups.h>
#include <cstdio>
#include <cstdint>
namespace cg = cooperative_groups;

#define LAS __attribute__((address_space(3)))
typedef unsigned short bf16_t;
typedef short bf16x8 __attribute__((ext_vector_type(8)));
typedef float f32x4 __attribute__((ext_vector_type(4)));
typedef float f32x2 __attribute__((ext_vector_type(2)));
typedef unsigned u32x4 __attribute__((ext_vector_type(4)));
typedef unsigned u32x2 __attribute__((ext_vector_type(2)));

constexpr int DM = 2048, NB = 4, SEQ = 2048, MTOK = NB * SEQ;
constexpr int N0 = 15616, N0_SRC = 15408;
constexpr int N1 = 12288, MIXW = 4096;
constexpr int ZC_LD = 8192;
constexpr float EPS = 1e-6f;
constexpr int NKV = 4, HD = 128, NH = 16;
constexpr int NCMP = 127;

constexpr size_t MiB = 1u << 20;
constexpr size_t WS_BAR = 0;
constexpr size_t WS_RSTD0 = 1 * MiB, WS_SS1 = WS_RSTD0 + 32768, WS_LNS = WS_SS1 + 32768, WS_COS = WS_LNS + 65536, WS_SIN = WS_COS + 131072;
constexpr size_t WS_KC = 2 * MiB, WS_VC = 2 * MiB + 524288;
constexpr size_t WS_GL = 3 * MiB;
constexpr size_t WS_W1T = 5 * MiB;
constexpr size_t WS_W2T = 7 * MiB;
constexpr size_t WS_PBP = 7 * MiB + 65536;
constexpr size_t WS_DUMMY = 7 * MiB + 131072;
constexpr size_t WS_SW = 7 * MiB + 524288;
constexpr size_t WS_WT0 = 8 * MiB, WS_WTO0 = 69 * MiB, WS_WT1 = 85 * MiB, WS_WTO1 = 133 * MiB;
constexpr size_t WS_XB = 149 * MiB;
constexpr size_t WS_NG = 181 * MiB;
constexpr size_t WS_ZC = 213 * MiB;
constexpr size_t WS_Q = 341 * MiB;
constexpr size_t WS_KV = 373 * MiB;
constexpr size_t KV_ELEMS = (size_t)MTOK * 512;
constexpr size_t WS_END = 421 * MiB;
constexpr size_t WS_Z1 = WS_ZC;
static_assert(WS_Z1 + (size_t)MTOK * N1 * 2 <= WS_END, "z1 overlay");

constexpr int NWAVES = 8, NTHREADS = 512;
constexpr int LDS_BYTES = 147456;

struct Args { const float* in[21]; float* out; unsigned char* ws; int ph_lo, ph_hi; };

__device__ __forceinline__ float bf_lo(unsigned u) { return __uint_as_float(u << 16); }
__device__ __forceinline__ float bf_hi(unsigned u) { return __uint_as_float(u & 0xffff0000u); }
__device__ __forceinline__ float bf2f(bf16_t b) { return __uint_as_float((unsigned)b << 16); }
__device__ __forceinline__ unsigned f2bf(float f) { unsigned u = __float_as_uint(f); return (u + 0x7fffu + ((u >> 16) & 1u)) >> 16; }
__device__ __forceinline__ unsigned pk2(float lo, float hi) { return f2bf(lo) | (f2bf(hi) << 16); }
__device__ __forceinline__ unsigned cvt_pk_bf16(float lo, float hi) { unsigned r; asm volatile("v_cvt_pk_bf16_f32 %0, %1, %2" : "=v"(r) : "v"(lo), "v"(hi)); return r; }
__device__ __forceinline__ float silu_f(float x) { return x / (1.f + __expf(-x)); }
__device__ __forceinline__ float sigmoid_f(float x) { return 1.f / (1.f + __expf(-x)); }
__device__ __forceinline__ float wave_sum(float v) {
#pragma unroll
    for (int o = 1; o < 64; o <<= 1) v += __shfl_xor(v, o);
    return v;
}
__device__ __forceinline__ float wave_max(float v) {
#pragma unroll
    for (int o = 1; o < 64; o <<= 1) v = fmaxf(v, __shfl_xor(v, o));
    return v;
}
__device__ __forceinline__ int colmap0(int nd) { return nd < 13312 ? nd : (nd < 15360 ? nd + 48 : (nd < 15408 ? nd - 2048 : -1)); }

namespace pg8 {
#define PG8_LAS __attribute__((address_space(3)))
constexpr int BM = 256, BK = 64, HALF = 128, HTB = HALF * BK * 2  , STAGE_BYTES = 8 * HTB, NXCD = 8, WGM = 8;

__host__ __device__ __forceinline__ int lds_byte(int r, int c) { const int st = (r >> 4) * 2 + (c >> 5), rr = r & 15, cc = c & 31, ob = rr * 64 + cc * 2; return st * 1024 + (ob ^ (((ob >> 9) & 1) << 5)); }
__host__ __device__ __forceinline__ void stage_rc(int b, int& R, int& C) { const int st = b / 1024, sb = b % 1024, swz = sb ^ (((sb >> 9) & 1) << 5); R = (st >> 1) * 16 + swz / 64; C = (st & 1) * 32 + (swz % 64) / 2; }
__host__ __device__ __forceinline__ int perm32(int rho) { const int n = rho >> 4, i = rho & 15; return 8 * (i >> 2) + 4 * n + (i & 3); }

struct Unit { int pm, pn; };
struct Gemm { const bf16_t* A; const bf16_t* Bt; int M, N, K, lda; };

struct StaticOrder {
    int nM, nN, nwg, G, c;
    __host__ __device__ void init(int M, int N, int G_, int c_) { nM = M / BM; nN = N / BM; nwg = nM * nN; G = G_; c = c_; }
    __host__ __device__ bool next(int i, Unit& u) const {
        const long L = (long)i * G + c; if (L >= nwg) return false;
        int wgid = (int)L; { const int q = nwg / NXCD, r = nwg % NXCD, xcd = wgid % NXCD, off = wgid / NXCD; wgid = (xcd < r ? xcd * (q + 1) : r * (q + 1) + (xcd - r) * q) + off; }
        const int nig = WGM * nN, gid = wgid / nig, fm = gid * WGM, gsz = (nM - fm) < WGM ? (nM - fm) : WGM;
        u.pm = fm + ((wgid % nig) % gsz); u.pn = (wgid % nig) / gsz; return true;
    }
    __device__ __forceinline__ void a_ready(const Unit&) const {}
    __device__ __forceinline__ void done(const Unit&) const {}
};


#define EPI_LOADS_DONE() asm volatile("s_waitcnt vmcnt(0)" ::: "memory")
__device__ __forceinline__ void st16(void* p, u32x4 v) { asm volatile("global_store_dwordx4 %0, %1, off\n\ts_nop 1" :: "v"(p), "v"(v) : "memory"); }
__device__ __forceinline__ void st16f(void* p, f32x4 v) { asm volatile("global_store_dwordx4 %0, %1, off\n\ts_nop 1" :: "v"(p), "v"(v) : "memory"); }
__device__ __forceinline__ void st8(void* p, u32x2 v) { asm volatile("global_store_dwordx2 %0, %1, off\n\ts_nop 1" :: "v"(p), "v"(v) : "memory"); }

template <int DRY = 0> struct Epi0T {
    static constexpr bool PERM = true, AFTER_DRAIN = false;
    const float* rstd; bf16_t* ZC; bf16_t* Q; bf16_t* KV; bf16_t* NG; float* GL; const float* COS; const float* SIN;
    __device__ __forceinline__ void operator()(const f32x4 (&acc)[2][2][4][2], const Unit& u, int wr, int wc, int fr, int fq) const {
        const int pn = u.pn;
        const int rowb = u.pm * BM + wr * 64 + fr;
        const int cl = wc * 32 + 8 * fq;
        float rs[8];
#pragma unroll
        for (int i = 0; i < 8; ++i) rs[i] = rstd[rowb + (i >> 2) * HALF + (i & 3) * 16];
        EPI_LOADS_DONE();
#pragma unroll
        for (int i = 0; i < 8; ++i) asm volatile("" :: "v"(rs[i]));
        if (pn == 60) {
            if (cl < 48) {
#pragma unroll
                for (int ai = 0; ai < 2; ++ai)
#pragma unroll
                    for (int m = 0; m < 4; ++m) { const int row = rowb + ai * HALF + m * 16; float* gp = GL + (size_t)row * 48 + cl;
                        st16f(gp, acc[ai][0][m][0] * rs[ai * 4 + m]); st16f(gp + 4, acc[ai][0][m][1] * rs[ai * 4 + m]); }
            }
            return;
        }
        bf16_t* base; int ld, bjoff; bool rot = false;
        if (pn < 32) { base = ZC + pn * BM; ld = ZC_LD; bjoff = HALF; }
        else if (pn < 40) { base = Q + (pn - 32) * BM; ld = DM; bjoff = HALF; }
        else if (pn < 52) { const int which = (pn - 40) >> 1, g0 = ((pn - 40) & 1) * 2, b = u.pm >> 3;
            base = KV + (size_t)which * KV_ELEMS + (size_t)(b * 6144 + g0 * SEQ) * HD; ld = HD; bjoff = SEQ * HD; rot = (which == 2 || which == 4) && (wc == 0); }
        else { base = NG + (pn - 52) * BM; ld = DM; bjoff = HALF; }
        bf16_t* lanep = base + (size_t)rowb * ld + cl;
        if (DRY != 0) { const int tl = DRY == 1 ? (u.pm * 61 + pn) % 251 : (u.pm * 61 + pn) % 1900; rot = false; ld = 256; bjoff = 128;
            lanep = NG + (size_t)tl * 65536 + (size_t)(wr * 64 + fr) * 256 + cl; }
        if (!rot) {
#pragma unroll
            for (int ai = 0; ai < 2; ++ai)
#pragma unroll
                for (int m = 0; m < 4; ++m) {
                    const float rsv = rs[ai * 4 + m];
                    bf16_t* rp = lanep + (size_t)(ai * HALF + m * 16) * ld;
#pragma unroll
                    for (int bj = 0; bj < 2; ++bj) {
                        const f32x4 v0 = acc[ai][bj][m][0] * rsv, v1 = acc[ai][bj][m][1] * rsv;
                        u32x4 w; w.x = cvt_pk_bf16(v0[0], v0[1]); w.y = cvt_pk_bf16(v0[2], v0[3]); w.z = cvt_pk_bf16(v1[0], v1[1]); w.w = cvt_pk_bf16(v1[2], v1[3]);
                        st16(rp + (size_t)bj * bjoff, w);
                    }
                }
        } else {
#pragma unroll
            for (int ai = 0; ai < 2; ++ai)
#pragma unroll
                for (int m = 0; m < 4; ++m) {
                    const int row = rowb + ai * HALF + m * 16, t = row & (SEQ - 1);
                    const float rsv = rs[ai * 4 + m];
                    const float* cp = COS + t * 16 + 8 * (fq & 1); const float* sp = SIN + t * 16 + 8 * (fq & 1);
                    const f32x4 cs0 = *(const f32x4*)cp, cs1 = *(const f32x4*)(cp + 4), sn0 = *(const f32x4*)sp, sn1 = *(const f32x4*)(sp + 4);
                    bf16_t* rp = lanep + (size_t)(ai * HALF + m * 16) * ld;
#pragma unroll
                    for (int bj = 0; bj < 2; ++bj) {
                        f32x4 v0 = acc[ai][bj][m][0] * rsv, v1 = acc[ai][bj][m][1] * rsv, p0, p1;
#pragma unroll
                        for (int j = 0; j < 4; ++j) { p0[j] = __shfl_xor(v0[j], 32); p1[j] = __shfl_xor(v1[j], 32); }
                        if (fq < 2) { v0 = v0 * cs0 - p0 * sn0; v1 = v1 * cs1 - p1 * sn1; }
                        else        { v0 = v0 * cs0 + p0 * sn0; v1 = v1 * cs1 + p1 * sn1; }
                        u32x4 w; w.x = cvt_pk_bf16(v0[0], v0[1]); w.y = cvt_pk_bf16(v0[2], v0[3]); w.z = cvt_pk_bf16(v1[0], v1[1]); w.w = cvt_pk_bf16(v1[2], v1[3]);
                        st16(rp + (size_t)bj * bjoff, w);
                    }
                }
        }
    }
};

typedef Epi0T<0> Epi0;
struct EpiOut0 {
    static constexpr bool PERM = false, AFTER_DRAIN = false;
    const float* X; float* X1; bf16_t* X1B; float* SS;
    __device__ __forceinline__ void operator()(f32x4 (&acc)[2][2][4][2], const Unit& u, int wr, int wc, int fr, int fq) const {
        const int rowb = u.pm * BM + wr * 64 + fr, colb = u.pn * BM + wc * 32 + 4 * fq;
#pragma unroll
        for (int q = 0; q < 8; ++q) {
            const int ai = q >> 2, m = q & 3;
            f32x4 xr[2][2];
#pragma unroll
            for (int bj = 0; bj < 2; ++bj)
#pragma unroll
                for (int n = 0; n < 2; ++n) xr[bj][n] = *(const f32x4*)(X + (size_t)(rowb + ai * HALF + m * 16) * DM + colb + bj * HALF + n * 16);
            EPI_LOADS_DONE();
#pragma unroll
            for (int bj = 0; bj < 2; ++bj)
#pragma unroll
                for (int n = 0; n < 2; ++n) acc[ai][bj][m][n] += xr[bj][n];
            asm volatile("" : "+v"(acc[ai][0][m][0]), "+v"(acc[ai][0][m][1]), "+v"(acc[ai][1][m][0]), "+v"(acc[ai][1][m][1]) :: "memory");
        }
#pragma unroll
        for (int ai = 0; ai < 2; ++ai)
#pragma unroll
            for (int m = 0; m < 4; ++m) {
                const int row = rowb + ai * HALF + m * 16; float ss = 0.f;
#pragma unroll
                for (int bj = 0; bj < 2; ++bj)
#pragma unroll
                    for (int n = 0; n < 2; ++n) {
                        const size_t off = (size_t)row * DM + colb + bj * HALF + n * 16;
                        const f32x4 x1 = acc[ai][bj][m][n];
                        st16f(X1 + off, x1);
                        u32x2 w; w.x = cvt_pk_bf16(x1[0], x1[1]); w.y = cvt_pk_bf16(x1[2], x1[3]); st8(X1B + off, w);
                        ss += (x1[0] * x1[0] + x1[1] * x1[1]) + (x1[2] * x1[2] + x1[3] * x1[3]);
                    }
                ss += __shfl_xor(ss, 16); ss += __shfl_xor(ss, 32);
                if (fq == 0) atomicAdd(SS + row, ss);
            }
    }
};

struct Epi1 {
    static constexpr bool PERM = true, AFTER_DRAIN = false;
    const float* SS; bf16_t* Z1; float* LNS;
    __device__ __forceinline__ void operator()(const f32x4 (&acc)[2][2][4][2], const Unit& u, int wr, int wc, int fr, int fq) const {
        const int rowb = u.pm * BM + wr * 64 + fr, colb = u.pn * BM + wc * 32 + 8 * fq;
        const bool isv = (u.pn >= 16 && u.pn < 32);
        float rsq[8];
#pragma unroll
        for (int i = 0; i < 8; ++i) rsq[i] = SS[rowb + (i >> 2) * HALF + (i & 3) * 16];
        EPI_LOADS_DONE();
#pragma unroll
        for (int i = 0; i < 8; ++i) asm volatile("" :: "v"(rsq[i]));
#pragma unroll
        for (int ai = 0; ai < 2; ++ai)
#pragma unroll
            for (int m = 0; m < 4; ++m) {
                const int row = rowb + ai * HALF + m * 16;
                const float rs = __builtin_amdgcn_rsqf(rsq[ai * 4 + m] * (1.0f / DM) + EPS);
                float s1 = 0.f, s2 = 0.f;
#pragma unroll
                for (int bj = 0; bj < 2; ++bj) {
                    const f32x4 v0 = acc[ai][bj][m][0] * rs, v1 = acc[ai][bj][m][1] * rs;
                    u32x4 w; w.x = cvt_pk_bf16(v0[0], v0[1]); w.y = cvt_pk_bf16(v0[2], v0[3]); w.z = cvt_pk_bf16(v1[0], v1[1]); w.w = cvt_pk_bf16(v1[2], v1[3]);
                    st16(Z1 + (size_t)row * N1 + colb + bj * HALF, w);
                    s1 += (v0[0] + v0[1]) + (v0[2] + v0[3]) + (v1[0] + v1[1]) + (v1[2] + v1[3]);
                    s2 += (v0[0] * v0[0] + v0[1] * v0[1]) + (v0[2] * v0[2] + v0[3] * v0[3]) + (v1[0] * v1[0] + v1[1] * v1[1]) + (v1[2] * v1[2] + v1[3] * v1[3]);
                }
                if (isv) {
                    s1 += __shfl_xor(s1, 16); s1 += __shfl_xor(s1, 32); s2 += __shfl_xor(s2, 16); s2 += __shfl_xor(s2, 32);
                    if (fq == 0) { atomicAdd(LNS + 2 * row, s1); atomicAdd(LNS + 2 * row + 1, s2); }
                }
            }
    }
};

struct EpiNull {
    static constexpr bool PERM = true, AFTER_DRAIN = false; float* dummy;
    __device__ __forceinline__ void operator()(const f32x4 (&acc)[2][2][4][2], const Unit& u, int wr, int wc, int fr, int fq) const {
        float s = 0.f;
#pragma unroll
        for (int ai = 0; ai < 2; ++ai)
#pragma unroll
            for (int bj = 0; bj < 2; ++bj)
#pragma unroll
                for (int m = 0; m < 4; ++m)
#pragma unroll
                    for (int n = 0; n < 2; ++n) s += acc[ai][bj][m][n][0] + acc[ai][bj][m][n][1] + acc[ai][bj][m][n][2] + acc[ai][bj][m][n][3];
        if (s == 1.2345678f) dummy[0] = s;
    }
};

struct EpiOut1 {
    static constexpr bool PERM = false, AFTER_DRAIN = false;
    float* OUT;
    __device__ __forceinline__ void operator()(f32x4 (&acc)[2][2][4][2], const Unit& u, int wr, int wc, int fr, int fq) const {
        const int rowb = u.pm * BM + wr * 64 + fr, colb = u.pn * BM + wc * 32 + 4 * fq;
#pragma unroll
        for (int q = 0; q < 8; ++q) {
            const int ai = q >> 2, m = q & 3;
            f32x4 xr[2][2];
#pragma unroll
            for (int bj = 0; bj < 2; ++bj)
#pragma unroll
                for (int n = 0; n < 2; ++n) xr[bj][n] = *(const f32x4*)(OUT + (size_t)(rowb + ai * HALF + m * 16) * DM + colb + bj * HALF + n * 16);
            EPI_LOADS_DONE();
#pragma unroll
            for (int bj = 0; bj < 2; ++bj)
#pragma unroll
                for (int n = 0; n < 2; ++n) acc[ai][bj][m][n] += xr[bj][n];
            asm volatile("" : "+v"(acc[ai][0][m][0]), "+v"(acc[ai][0][m][1]), "+v"(acc[ai][1][m][0]), "+v"(acc[ai][1][m][1]) :: "memory");
        }
#pragma unroll
        for (int ai = 0; ai < 2; ++ai)
#pragma unroll
            for (int m = 0; m < 4; ++m)
#pragma unroll
                for (int bj = 0; bj < 2; ++bj)
#pragma unroll
                    for (int n = 0; n < 2; ++n) st16f(OUT + (size_t)(rowb + ai * HALF + m * 16) * DM + colb + bj * HALF + n * 16, acc[ai][bj][m][n]);
    }
};


template <class Epi, class Sched, bool ALIGN_EPI = false, bool SP2 = false>
__device__ __forceinline__ void gemm_phase(PG8_LAS unsigned char* lds, const Gemm g, const Sched& S, const Epi& E) {
    const int tid = threadIdx.x, wid = __builtin_amdgcn_readfirstlane(tid >> 6), lane = tid & 63, wr = wid >> 2, wc = wid & 3, fr = lane & 15, fq = lane >> 4;
    const int K = g.K, nt = K / BK;
    unsigned voffA[2], voffB[2];
#pragma unroll
    for (int i = 0; i < 2; ++i) { int R, C; stage_rc(tid * 16 + i * 8192, R, C); const int Rb = Epi::PERM ? ((R & ~31) + perm32(R & 31)) : R;
        voffA[i] = (unsigned)(R * g.lda + C) * 2u; voffB[i] = (unsigned)(Rb * K + C) * 2u; }
    const size_t kstep = (size_t)(BK * 2);
    const size_t hstepA = (size_t)HALF * g.lda * 2, hstepB = (size_t)HALF * K * 2;
    const size_t tstepA = 2 * hstepA, tstepB = 2 * hstepB;
    const unsigned ldsw = (unsigned)wid * 1024u;
    const int aoff = lds_byte(wr * 64 + fr, fq * 8), boff = lds_byte(wc * 32 + fr, fq * 8);
#define PG8_SA(b, h) (((b) * 2 + (h)) * HTB)
#define PG8_SB(b, h) ((4 + (b) * 2 + (h)) * HTB)
#define PG8_STAGE(bufoff, gbase, voff) do { _Pragma("unroll") for (int _i = 0; _i < 2; ++_i) \
        __builtin_amdgcn_global_load_lds((const unsigned*)((const char*)(gbase) + (voff)[_i]), (PG8_LAS unsigned*)(lds + (bufoff) + ldsw + _i * 8192), 16, 0, 0); } while (0)
#define PG8_LDA(dst, b, h) do { _Pragma("unroll") for (int m = 0; m < 4; ++m) _Pragma("unroll") for (int k = 0; k < 2; ++k) dst[m][k] = *(const PG8_LAS bf16x8*)(lds + PG8_SA(b, h) + aoff + m * 2048 + k * 1024); } while (0)
#define PG8_LDB(dst, b, h) do { _Pragma("unroll") for (int n = 0; n < 2; ++n) _Pragma("unroll") for (int k = 0; k < 2; ++k) dst[n][k] = *(const PG8_LAS bf16x8*)(lds + PG8_SB(b, h) + boff + n * 2048 + k * 1024); } while (0)
#define PG8_MMA(ai, bj, At, Bt) do { __builtin_amdgcn_s_setprio(1); _Pragma("unroll") for (int m = 0; m < 4; ++m) _Pragma("unroll") for (int n = 0; n < 2; ++n) _Pragma("unroll") for (int k = 0; k < 2; ++k) \
        acc[ai][bj][m][n] = __builtin_amdgcn_mfma_f32_16x16x32_bf16(Bt[n][k], At[m][k], acc[ai][bj][m][n], 0, 0, 0); __builtin_amdgcn_s_setprio(0); } while (0)
#define PG8_WAIT_V(n) asm volatile("s_waitcnt vmcnt(" #n ")" ::: "memory")
#define PG8_WAIT_L(n) asm volatile("s_waitcnt lgkmcnt(" #n ")" ::: "memory")
#define PG8_BAR __builtin_amdgcn_s_barrier()
#define PG8_SCHED __builtin_amdgcn_sched_barrier(0)
    Unit cur, nxt; int ui = 0;
    if (!S.next(0, cur)) return;
    f32x4 acc[2][2][4][2];
#pragma unroll
    for (int a = 0; a < 2; ++a)
#pragma unroll
        for (int b = 0; b < 2; ++b)
#pragma unroll
            for (int m = 0; m < 4; ++m)
#pragma unroll
                for (int n = 0; n < 2; ++n) acc[a][b][m][n] = (f32x4){0.f, 0.f, 0.f, 0.f};
    bf16x8 At[4][2], B0[2][2], B1[2][2];
    const char* cA = (const char*)g.A + (size_t)cur.pm * tstepA; const char* cB = (const char*)g.Bt + (size_t)cur.pn * tstepB;
    S.a_ready(cur);
    if constexpr (SP2) {
        PG8_STAGE(PG8_SB(0, 0), cB, voffB); PG8_STAGE(PG8_SB(0, 1), cB + hstepB, voffB); PG8_STAGE(PG8_SA(0, 0), cA, voffA); PG8_STAGE(PG8_SA(0, 1), cA + hstepA, voffA);
        if (wr == 1) PG8_BAR;
        PG8_WAIT_V(2); PG8_BAR;
        PG8_STAGE(PG8_SB(1, 0), cB + kstep, voffB); PG8_STAGE(PG8_SA(1, 0), cA + kstep, voffA); PG8_STAGE(PG8_SB(1, 1), cB + hstepB + kstep, voffB);
        PG8_WAIT_V(6); PG8_BAR;
    } else {
        PG8_STAGE(PG8_SB(0, 0), cB, voffB); PG8_STAGE(PG8_SA(0, 0), cA, voffA); PG8_STAGE(PG8_SB(0, 1), cB + hstepB, voffB); PG8_STAGE(PG8_SA(0, 1), cA + hstepA, voffA);
        if (wr == 1) PG8_BAR;
        PG8_WAIT_V(4); PG8_BAR;
        PG8_STAGE(PG8_SB(1, 0), cB + kstep, voffB); PG8_STAGE(PG8_SA(1, 0), cA + kstep, voffA); PG8_STAGE(PG8_SB(1, 1), cB + hstepB + kstep, voffB);
        PG8_WAIT_V(6); PG8_BAR;
    }
    for (;;) {
        const bool has_next = S.next(ui + 1, nxt);
        const char* nA = has_next ? (const char*)g.A + (size_t)nxt.pm * tstepA : cA; const char* nB = has_next ? (const char*)g.Bt + (size_t)nxt.pn * tstepB : cB;
        for (int t = 0; t < nt; t += 2) {
            const bool last = (t == nt - 2);
            const char* a1 = cA + (size_t)(t + 1) * kstep;
            const char* a2 = last ? nA : cA + (size_t)(t + 2) * kstep; const char* b2 = last ? nB : cB + (size_t)(t + 2) * kstep;
            const char* a3 = a2 + kstep; const char* b3 = b2 + kstep;
            if (last && has_next) S.a_ready(nxt);
            if constexpr (SP2) {
            PG8_LDB(B0, 0, 0); PG8_LDB(B1, 0, 1); PG8_SCHED; PG8_LDA(At, 0, 0); PG8_STAGE(PG8_SA(1, 1), a1 + hstepA, voffA);
            PG8_WAIT_V(8); PG8_WAIT_L(0); PG8_BAR; PG8_MMA(0, 0, At, B0); PG8_MMA(0, 1, At, B1); PG8_BAR; PG8_SCHED;
            PG8_LDA(At, 0, 1); PG8_STAGE(PG8_SB(0, 0), b2, voffB); PG8_STAGE(PG8_SB(0, 1), b2 + hstepB, voffB); PG8_STAGE(PG8_SA(0, 0), a2, voffA);
            PG8_WAIT_V(8); PG8_WAIT_L(0); PG8_BAR; PG8_MMA(1, 0, At, B0); PG8_MMA(1, 1, At, B1); PG8_BAR; PG8_SCHED;
            PG8_LDB(B0, 1, 0); PG8_LDB(B1, 1, 1); PG8_SCHED; PG8_LDA(At, 1, 0); PG8_STAGE(PG8_SA(0, 1), a2 + hstepA, voffA);
            PG8_WAIT_V(8); PG8_WAIT_L(0); PG8_BAR; PG8_MMA(0, 0, At, B0); PG8_MMA(0, 1, At, B1); PG8_BAR; PG8_SCHED;
            PG8_LDA(At, 1, 1); PG8_STAGE(PG8_SB(1, 0), b3, voffB); PG8_STAGE(PG8_SB(1, 1), b3 + hstepB, voffB); PG8_STAGE(PG8_SA(1, 0), a3, voffA);
            PG8_WAIT_V(8); PG8_WAIT_L(0); PG8_BAR; PG8_MMA(1, 0, At, B0); PG8_MMA(1, 1, At, B1); PG8_BAR; PG8_SCHED;
            } else {
            PG8_LDB(B0, 0, 0); PG8_SCHED; PG8_LDA(At, 0, 0); PG8_STAGE(PG8_SA(1, 1), a1 + hstepA, voffA);
            PG8_WAIT_L(8); PG8_BAR; PG8_WAIT_L(0); PG8_MMA(0, 0, At, B0); PG8_BAR; PG8_SCHED;
            PG8_LDB(B1, 0, 1); PG8_STAGE(PG8_SB(0, 0), b2, voffB);
            PG8_BAR; PG8_WAIT_L(0); PG8_MMA(0, 1, At, B1); PG8_BAR;
            PG8_LDA(At, 0, 1); PG8_STAGE(PG8_SA(0, 0), a2, voffA);
            PG8_BAR; PG8_WAIT_L(0); PG8_MMA(1, 0, At, B0); PG8_BAR; PG8_SCHED;
            PG8_STAGE(PG8_SB(0, 1), b2 + hstepB, voffB);
            PG8_WAIT_V(6); PG8_BAR; PG8_MMA(1, 1, At, B1); PG8_BAR;
            PG8_LDB(B0, 1, 0); PG8_SCHED; PG8_LDA(At, 1, 0); PG8_STAGE(PG8_SA(0, 1), a2 + hstepA, voffA);
            PG8_WAIT_L(8); PG8_BAR; PG8_WAIT_L(0); PG8_MMA(0, 0, At, B0); PG8_BAR; PG8_SCHED;
            PG8_LDB(B1, 1, 1); PG8_STAGE(PG8_SB(1, 0), b3, voffB);
            PG8_BAR; PG8_WAIT_L(0); PG8_MMA(0, 1, At, B1); PG8_BAR;
            PG8_LDA(At, 1, 1); PG8_STAGE(PG8_SA(1, 0), a3, voffA);
            PG8_BAR; PG8_WAIT_L(0); PG8_MMA(1, 0, At, B0); PG8_BAR; PG8_SCHED;
            PG8_STAGE(PG8_SB(1, 1), b3 + hstepB, voffB);
            PG8_WAIT_V(6); PG8_BAR; PG8_MMA(1, 1, At, B1); PG8_BAR;
            }
        }
        if constexpr (ALIGN_EPI) { if (wr == 0) PG8_BAR; }
        if constexpr (!Epi::AFTER_DRAIN) { E(acc, cur, wr, wc, fr, fq); S.done(cur); }
        if (!has_next) break;
#pragma unroll
        for (int a = 0; a < 2; ++a)
#pragma unroll
            for (int b = 0; b < 2; ++b)
#pragma unroll
                for (int m = 0; m < 4; ++m)
#pragma unroll
                    for (int n = 0; n < 2; ++n) acc[a][b][m][n] = (f32x4){0.f, 0.f, 0.f, 0.f};
        cur = nxt; cA = nA; cB = nB; ++ui;
        if constexpr (ALIGN_EPI) { if (wr == 1) PG8_BAR; }
    }
    PG8_WAIT_V(0);
    if constexpr (!ALIGN_EPI) { if (wr == 0) PG8_BAR; }
    PG8_BAR;
    if constexpr (Epi::AFTER_DRAIN) { E.fused(acc, cur, wr, wc, fr, fq, lds, wid, lane); S.done(cur); }
#undef PG8_SA
#undef PG8_SB
#undef PG8_STAGE
#undef PG8_LDA
#undef PG8_LDB
#undef PG8_MMA
#undef PG8_WAIT_V
#undef PG8_WAIT_L
#undef PG8_BAR
#undef PG8_SCHED
}
}

template <int MODE>
__device__ __forceinline__ void p0_transpose_item(const float* W, int K, int Nsrc, int nblk, bf16_t* WT, const float* gvec, LAS float* scr, int item, int lane) {
    const int kb = item / nblk, nb = item % nblk, k0 = 64 * kb, n0 = 64 * nb;
    const int nd = n0 + lane;
    const int col = (MODE == 0) ? colmap0(nd) : nd;
    const float* src = W + (size_t)k0 * Nsrc + (col >= 0 ? col : 0);
    float v[64];
#pragma unroll
    for (int i = 0; i < 64; ++i) v[i] = src[(size_t)i * Nsrc];
#pragma unroll
    for (int i = 0; i < 64; ++i) { float x = (col >= 0) ? v[i] : 0.f; if (MODE != 1) x *= gvec[k0 + i]; scr[i * 65 + lane] = x; }
    asm volatile("s_waitcnt lgkmcnt(0)" ::: "memory");
    const int c = lane & 7;
#pragma unroll
    for (int j = 0; j < 8; ++j) { const int n = (lane >> 3) + 8 * j; const LAS float* s = scr + (8 * c) * 65 + n;
        u32x4 o; o.x = pk2(s[0 * 65], s[1 * 65]); o.y = pk2(s[2 * 65], s[3 * 65]); o.z = pk2(s[4 * 65], s[5 * 65]); o.w = pk2(s[6 * 65], s[7 * 65]);
        *(u32x4*)(WT + (size_t)(n0 + n) * K + k0 + 8 * c) = o; }
    asm volatile("s_waitcnt lgkmcnt(0)" ::: "memory");
}

__device__ __forceinline__ void p0_late_weights(const Args& a, LAS unsigned char* lds, int w0, int nw, int wave, int lane) {
    unsigned char* ws = a.ws;
    LAS float* scr = (LAS float*)(lds + wave * 16640);
    constexpr int IO = (MIXW / 64) * (DM / 64), I1 = (DM / 64) * (N1 / 64);
    for (int it = w0; it < IO + I1 + IO; it += nw) {
        int r = it;
        if (r < IO) { p0_transpose_item<1>(a.in[12], MIXW, DM, DM / 64, (bf16_t*)(ws + WS_WTO0), nullptr, scr, r, lane); continue; } r -= IO;
        if (r < I1) { p0_transpose_item<2>(a.in[14], DM, N1, N1 / 64, (bf16_t*)(ws + WS_WT1), a.in[13], scr, r, lane); continue; } r -= I1;
        p0_transpose_item<1>(a.in[19], MIXW, DM, DM / 64, (bf16_t*)(ws + WS_WTO1), nullptr, scr, r, lane);
    }
}
__device__ __forceinline__ void p0_prologue(const Args& a, LAS unsigned char* lds, int vcu, int G, int wave, int lane, bool defer_late) {
    unsigned char* ws = a.ws;
    LAS float* scr = (LAS float*)(lds + wave * 16640);
    const int gw = vcu * NWAVES + wave, NGW = G * NWAVES;
    constexpr int I0 = (DM / 64) * (N0 / 64);
    for (int it = gw; it < I0; it += NGW) p0_transpose_item<0>(a.in[2], DM, N0_SRC, N0 / 64, (bf16_t*)(ws + WS_WT0), a.in[1], scr, it, lane);
    if (!defer_late) p0_late_weights(a, lds, gw, NGW, wave, lane);
    for (int it = gw; it < 2 * (128 + 4); it += NGW) {
        const int kv = it / 132, r = it % 132;
        if (r < 128) p0_transpose_item<1>(a.in[kv ? 9 : 5], 4096, 128, 2, (bf16_t*)(ws + WS_W1T) + (size_t)kv * 128 * 4096, nullptr, scr, r, lane);
        else p0_transpose_item<1>(a.in[kv ? 11 : 7], 128, 128, 2, (bf16_t*)(ws + WS_W2T) + (size_t)kv * 128 * 128, nullptr, scr, r - 128, lane);
    }
    {
        const int gt0 = gw * 64 + lane, NGT0 = NGW * 64;
        bf16_t* SW = (bf16_t*)(ws + WS_SW); const float* wsp = a.in[17];
        for (int i = gt0; i < 16 * 128 * 128; i += NGT0) { const int s = i & 127, t = (i >> 7) & 127; SW[i] = (bf16_t)(s <= t ? f2bf(wsp[i]) : 0u); }
        float* PBP = (float*)(ws + WS_PBP);
        for (int i = gt0; i < 2 * 32 * 128; i += NGT0) { const int j = i & 127, ic = (i >> 7) & 31, kv = i >> 12;
            const float* pos = a.in[kv ? 8 : 4] + ic * 128; const float* w1 = a.in[kv ? 9 : 5] + (size_t)ic * 128 * 128 + j; float s = 0.f;
            for (int q = 0; q < 128; ++q) s += pos[q] * w1[(size_t)q * 128]; PBP[i] = s; }
    }
    const float* x = a.in[0]; bf16_t* XB = (bf16_t*)(ws + WS_XB); float* rstd0 = (float*)(ws + WS_RSTD0);
    for (int m = gw; m < MTOK; m += NGW) {
        const f32x4* xr = (const f32x4*)(x + (size_t)m * DM) + lane;
        u32x2* o8 = (u32x2*)(XB + (size_t)m * DM) + lane;
        float s = 0.f;
#pragma unroll
        for (int j = 0; j < 8; ++j) { const f32x4 v = xr[64 * j]; s += (v.x * v.x + v.y * v.y) + (v.z * v.z + v.w * v.w);
            u32x2 w; w.x = pk2(v.x, v.y); w.y = pk2(v.z, v.w); o8[64 * j] = w; }
        s = wave_sum(s);
        if (lane == 0) rstd0[m] = 1.0f / sqrtf(s * (1.0f / DM) + EPS);
    }
    const int gt = gw * 64 + lane, NGT = NGW * 64;
    float* SS1 = (float*)(ws + WS_SS1); float* LNS = (float*)(ws + WS_LNS);
    for (int i = gt; i < MTOK; i += NGT) { SS1[i] = 0.f; LNS[2 * i] = 0.f; LNS[2 * i + 1] = 0.f; }
    float* COS = (float*)(ws + WS_COS); float* SIN = (float*)(ws + WS_SIN);
    for (int i = gt; i < SEQ * 16; i += NGT) { const int t = i >> 4, f = i & 15;
        const float inv = powf(500000.0f, -((float)f * 2.0f) / 32.0f); const float ang = (float)t * inv;
        COS[i] = cosf(ang); SIN[i] = sinf(ang); }
}

__device__ __forceinline__ void p2_conv(const Args& a, int i0, int i1, int istep, bool dry = false) {
    bf16_t* ZC = (bf16_t*)(a.ws + WS_ZC); const float* cw = a.in[3];
    for (int idx = i0; idx < i1; idx += istep) {
        const int row = idx >> 8, c8 = (idx & 255) * 8, t = row & (SEQ - 1);
        bf16_t* base = ZC + (size_t)row * ZC_LD + c8;
        const u32x4 cb = *(const u32x4*)base, cg = *(const u32x4*)(base + 6144);
        const u32x4 cc0 = *(const u32x4*)(base + 2048), ch0 = *(const u32x4*)(base + 4096);
        u32x4 cc1 = {0, 0, 0, 0}, ch1 = {0, 0, 0, 0}, cc2 = {0, 0, 0, 0}, ch2 = {0, 0, 0, 0};
        if (t >= 1) { cc1 = *(const u32x4*)(base - ZC_LD + 2048); ch1 = *(const u32x4*)(base - ZC_LD + 4096); }
        if (t >= 2) { cc2 = *(const u32x4*)(base - 2 * ZC_LD + 2048); ch2 = *(const u32x4*)(base - 2 * ZC_LD + 4096); }
        float w0[8], w1[8], w2[8];
#pragma unroll
        for (int j = 0; j < 8; ++j) { w0[j] = cw[c8 + j]; w1[j] = cw[DM + c8 + j]; w2[j] = cw[2 * DM + c8 + j]; }
        u32x4 o;
#pragma unroll
        for (int q = 0; q < 4; ++q) {
            float r[2];
#pragma unroll
            for (int hh = 0; hh < 2; ++hh) {
                const int j = 2 * q + hh;
                const float p0 = hh ? bf_hi(cc0[q]) * bf_hi(ch0[q]) : bf_lo(cc0[q]) * bf_lo(ch0[q]);
                const float p1 = hh ? bf_hi(cc1[q]) * bf_hi(ch1[q]) : bf_lo(cc1[q]) * bf_lo(ch1[q]);
                const float p2 = hh ? bf_hi(cc2[q]) * bf_hi(ch2[q]) : bf_lo(cc2[q]) * bf_lo(ch2[q]);
                const float conv = w0[j] * p2 + w1[j] * p1 + w2[j] * p0;
                const float b = hh ? bf_hi(cb[q]) : bf_lo(cb[q]); const float g = hh ? bf_hi(cg[q]) : bf_lo(cg[q]);
                r[hh] = b * conv * silu_f(g);
            }
            o[q] = pk2(r[0], r[1]);
        }
        *(u32x4*)(dry ? (bf16_t*)(a.ws + WS_DUMMY) + (threadIdx.x * 8) : base) = o;
    }
}

__device__ __forceinline__ void p2_compress(const Args& a, LAS unsigned char* lds, int blk, int G, int tid) {
    LAS float* tok = (LAS float*)lds;
    LAS float* pos = (LAS float*)(lds + 73728);
    LAS float* red = (LAS float*)(lds + 73728 + 16384);
    LAS float* hid = (LAS float*)(lds + 73728 + 32768);
    const int j = tid & 127, iq = tid >> 7;
    for (int unit = blk; unit < 2 * 16 * 16; unit += G) {
        const int kv = unit >> 8, bg = (unit >> 4) & 15, cg8 = unit & 15;
        const bf16_t* src = (const bf16_t*)(a.ws + WS_KV) + (size_t)kv * KV_ELEMS + ((size_t)bg * SEQ + 128 * cg8) * HD;
        const float* posg = a.in[kv ? 8 : 4]; const float* w1 = a.in[kv ? 9 : 5]; const float* b1 = a.in[kv ? 10 : 6]; const float* w2 = a.in[kv ? 11 : 7];
        const int ntok = (cg8 == 15) ? 128 : 144;
        __syncthreads();
        for (int i = tid; i < ntok * 128; i += NTHREADS) tok[i] = bf2f(src[i]);
        for (int i = tid; i < 4096; i += NTHREADS) pos[i] = posg[i];
        __syncthreads();
        float acc[8];
#pragma unroll
        for (int cc = 0; cc < 8; ++cc) acc[cc] = 0.f;
        const int ncc = (cg8 == 15) ? 7 : 8;
        for (int i = iq * 1024; i < iq * 1024 + 1024; ++i) {
            const float w = w1[(size_t)i * 128 + j]; const float p = pos[i];
#pragma unroll
            for (int cc = 0; cc < 8; ++cc) if (cc < ncc) acc[cc] += (tok[cc * 2048 + i] + p) * w;
        }
#pragma unroll
        for (int cc = 0; cc < 8; ++cc) red[(iq * 8 + cc) * 128 + j] = acc[cc];
        __syncthreads();
        for (int i = tid; i < 8 * 128; i += NTHREADS) { const int jj = i & 127;
            const float h = red[i] + red[1024 + i] + red[2048 + i] + red[3072 + i] + b1[jj]; hid[i] = silu_f(h); }
        __syncthreads();
        bf16_t* dst = (bf16_t*)(a.ws + (kv ? WS_VC : WS_KC)) + (size_t)bg * 128 * 128;
        for (int o = tid; o < 8 * 128; o += NTHREADS) { const int cc = o >> 7, d = o & 127;
            if (cc >= ncc) { if (cg8 == 15 && cc == 7) dst[(size_t)127 * 128 + d] = 0; }
            else { float s = 0.f;
                for (int jj = 0; jj < 128; ++jj) s += hid[cc * 128 + jj] * w2[jj * 128 + d];
                dst[(size_t)(8 * cg8 + cc) * 128 + d] = (bf16_t)f2bf(s); } }
    }
    __syncthreads();
}

__device__ __forceinline__ void attn_batch(const bf16_t* Kb, const bf16_t* Vb, int first, int lo, int hi, bool valid, const LAS float* qs,
                                           float (&m)[4], float (&l)[4], float (&o)[4][2], int lane) {
    int kr = first + lane; kr = kr < lo ? lo : (kr > hi ? hi : kr);
    const u32x4* kp = (const u32x4*)(Kb + (size_t)kr * HD);
    float s[4] = {0.f, 0.f, 0.f, 0.f};
#pragma unroll 4
    for (int c = 0; c < 16; ++c) { const u32x4 kv = kp[c];
        float kf[8]; kf[0] = bf_lo(kv.x); kf[1] = bf_hi(kv.x); kf[2] = bf_lo(kv.y); kf[3] = bf_hi(kv.y); kf[4] = bf_lo(kv.z); kf[5] = bf_hi(kv.z); kf[6] = bf_lo(kv.w); kf[7] = bf_hi(kv.w);
#pragma unroll
        for (int h = 0; h < 4; ++h) { const LAS f32x4* q4 = (const LAS f32x4*)(qs + h * HD + c * 8); const f32x4 qa = q4[0], qb = q4[1];
            s[h] += (qa[0] * kf[0] + qa[1] * kf[1]) + (qa[2] * kf[2] + qa[3] * kf[3]) + (qb[0] * kf[4] + qb[1] * kf[5]) + (qb[2] * kf[6] + qb[3] * kf[7]); }
    }
    float ps[4];
#pragma unroll
    for (int h = 0; h < 4; ++h) {
        const float sv = valid ? s[h] : -INFINITY;
        const float bm = wave_max(sv); const float mn = fmaxf(m[h], bm);
        float p = 0.f, alpha = 1.f;
        if (mn > -INFINITY) { p = valid ? __expf(sv - mn) : 0.f; alpha = (m[h] > -INFINITY) ? __expf(m[h] - mn) : 0.f; }
        l[h] = l[h] * alpha + wave_sum(p); o[h][0] *= alpha; o[h][1] *= alpha; m[h] = mn; ps[h] = p;
    }
    for (int jj = 0; jj < 64; ++jj) {
        int vr = first + jj; vr = vr < lo ? lo : (vr > hi ? hi : vr);
        const unsigned vv = *(const unsigned*)(Vb + (size_t)vr * HD + 2 * lane);
        const float v0 = bf_lo(vv), v1 = bf_hi(vv);
#pragma unroll
        for (int h = 0; h < 4; ++h) { const float pj = __shfl(ps[h], jj); o[h][0] += pj * v0; o[h][1] += pj * v1; }
    }
}

__device__ __forceinline__ void p3_nsa_naive(const Args& a, LAS unsigned char* lds, int gw, int NGW, int wave, int lane) {
    unsigned char* ws = a.ws;
    LAS float* qs = (LAS float*)(lds + wave * 8192);
    LAS float* qr = qs + 512;
    LAS float* Pc = qr + 512;
    const bf16_t* Q = (const bf16_t*)(ws + WS_Q); const bf16_t* KVb = (const bf16_t*)(ws + WS_KV);
    const bf16_t* KC = (const bf16_t*)(ws + WS_KC); const bf16_t* VC = (const bf16_t*)(ws + WS_VC);
    const float* GL = (const float*)(ws + WS_GL); const bf16_t* NG = (const bf16_t*)(ws + WS_NG);
    const float* COS = (const float*)(ws + WS_COS); const float* SIN = (const float*)(ws + WS_SIN);
    bf16_t* ZC = (bf16_t*)(ws + WS_ZC);
    const float scale = 0.08838834764831845f;
    for (int task = gw; task < NB * NKV * SEQ; task += NGW) {
        const int t = task & (SEQ - 1), bg = task >> 11, b = bg >> 2, g = bg & 3;
        const int row = b * SEQ + t;
        { const u32x4 qv = *(const u32x4*)(Q + (size_t)row * DM + g * 512 + lane * 8);
          float f[8]; f[0] = bf_lo(qv.x); f[1] = bf_hi(qv.x); f[2] = bf_lo(qv.y); f[3] = bf_hi(qv.y); f[4] = bf_lo(qv.z); f[5] = bf_hi(qv.z); f[6] = bf_lo(qv.w); f[7] = bf_hi(qv.w);
#pragma unroll
          for (int j = 0; j < 8; ++j) { qs[lane * 8 + j] = f[j] * scale; qr[lane * 8 + j] = f[j] * scale; } }
        asm volatile("s_waitcnt lgkmcnt(0)" ::: "memory");
        { const int h = lane >> 4, i = lane & 15; const float x1 = qs[h * HD + i], x2 = qs[h * HD + 16 + i]; const float c = COS[t * 16 + i], s = SIN[t * 16 + i];
          qr[h * HD + i] = x1 * c - x2 * s; qr[h * HD + 16 + i] = x2 * c + x1 * s; }
        asm volatile("s_waitcnt lgkmcnt(0)" ::: "memory");
        float oc[4][2], Pl0 = 0.f, Pl1 = 0.f;
        {
            const bf16_t* Kc = KC + (size_t)bg * 128 * 128; const bf16_t* Vc = VC + (size_t)bg * 128 * 128;
            const int c0 = lane, c1 = 64 + lane;
            const bool v0 = (16 * c0 + 31 <= t), v1 = (c1 < NCMP) && (16 * c1 + 31 <= t);
            const int r1 = c1 < NCMP ? c1 : NCMP - 1;
            float s0[4] = {0.f, 0.f, 0.f, 0.f}, s1[4] = {0.f, 0.f, 0.f, 0.f};
            const u32x4* k0p = (const u32x4*)(Kc + (size_t)c0 * HD); const u32x4* k1p = (const u32x4*)(Kc + (size_t)r1 * HD);
#pragma unroll 2
            for (int c = 0; c < 16; ++c) { const u32x4 ka = k0p[c], kb = k1p[c];
                float fa[8], fb[8];
                fa[0] = bf_lo(ka.x); fa[1] = bf_hi(ka.x); fa[2] = bf_lo(ka.y); fa[3] = bf_hi(ka.y); fa[4] = bf_lo(ka.z); fa[5] = bf_hi(ka.z); fa[6] = bf_lo(ka.w); fa[7] = bf_hi(ka.w);
                fb[0] = bf_lo(kb.x); fb[1] = bf_hi(kb.x); fb[2] = bf_lo(kb.y); fb[3] = bf_hi(kb.y); fb[4] = bf_lo(kb.z); fb[5] = bf_hi(kb.z); fb[6] = bf_lo(kb.w); fb[7] = bf_hi(kb.w);
#pragma unroll
                for (int h = 0; h < 4; ++h)
#pragma unroll
                    for (int jj = 0; jj < 8; ++jj) { const float qv = qs[h * HD + c * 8 + jj]; s0[h] += qv * fa[jj]; s1[h] += qv * fb[jj]; } }
            float p0[4], p1[4];
#pragma unroll
            for (int h = 0; h < 4; ++h) {
                const float a0 = v0 ? s0[h] : -INFINITY, a1 = v1 ? s1[h] : -INFINITY;
                const float mx = wave_max(fmaxf(a0, a1));
                float e0 = 0.f, e1 = 0.f;
                if (mx > -INFINITY) { e0 = v0 ? __expf(a0 - mx) : 0.f; e1 = v1 ? __expf(a1 - mx) : 0.f; }
                const float den = wave_sum(e0 + e1); const float inv = den > 0.f ? 1.0f / den : 1.0f;
                p0[h] = e0 * inv; p1[h] = e1 * inv; Pl0 += p0[h]; Pl1 += p1[h];
                oc[h][0] = 0.f; oc[h][1] = 0.f;
            }
            for (int jj = 0; jj < 64; ++jj) {
                const unsigned va = *(const unsigned*)(Vc + (size_t)jj * HD + 2 * lane);
                const int rr = (64 + jj) < NCMP ? (64 + jj) : NCMP - 1;
                const unsigned vb = *(const unsigned*)(Vc + (size_t)rr * HD + 2 * lane);
#pragma unroll
                for (int h = 0; h < 4; ++h) { const float pa = __shfl(p0[h], jj), pb = __shfl(p1[h], jj);
                    oc[h][0] += pa * bf_lo(va) + pb * bf_lo(vb); oc[h][1] += pa * bf_hi(va) + pb * bf_hi(vb); }
            }
            Pc[lane] = Pl0; Pc[64 + lane] = Pl1;
        }
        asm volatile("s_waitcnt lgkmcnt(0)" ::: "memory");
        unsigned selmask = 0u;
        {
            const int cur = t >> 6;
            float val = -INFINITY;
            if (lane < 32) {
                if (lane == 0 || lane == cur) val = INFINITY;
                else if (64 * lane <= t) { float s = 0.f;
                    for (int c = 4 * lane - 1; c <= 4 * lane + 3; ++c) if (c >= 0 && c < NCMP) s += Pc[c];
                    val = s; }
            }
            bool taken = (lane >= 32);
            for (int r = 0; r < 8; ++r) {
                const float cand = taken ? -INFINITY : val;
                const float mx = wave_max(cand);
                if (!(mx > -INFINITY)) break;
                const unsigned long long bal = __ballot(!taken && cand == mx);
                const int idx = __ffsll((long long)bal) - 1;
                selmask |= 1u << idx;
                if (lane == idx) taken = true;
            }
        }
        float os[4][2], ms[4], ls[4];
#pragma unroll
        for (int h = 0; h < 4; ++h) { os[h][0] = 0.f; os[h][1] = 0.f; ms[h] = -INFINITY; ls[h] = 0.f; }
        {
            const bf16_t* Ks = KVb + 2 * KV_ELEMS + (size_t)bg * SEQ * HD; const bf16_t* Vs = KVb + 3 * KV_ELEMS + (size_t)bg * SEQ * HD;
            unsigned mk = selmask;
            while (mk) { const int jb = __ffs((int)mk) - 1; mk &= mk - 1;
                attn_batch(Ks, Vs, 64 * jb, 0, SEQ - 1, (64 * jb + lane) <= t, qr, ms, ls, os, lane); }
        }
        float ow[4][2], mw[4], lw[4];
#pragma unroll
        for (int h = 0; h < 4; ++h) { ow[h][0] = 0.f; ow[h][1] = 0.f; mw[h] = -INFINITY; lw[h] = 0.f; }
        {
            const bf16_t* Kw = KVb + 4 * KV_ELEMS + (size_t)bg * SEQ * HD; const bf16_t* Vw = KVb + 5 * KV_ELEMS + (size_t)bg * SEQ * HD;
            const int first = t - 511;
            for (int b8 = 0; b8 < 8; ++b8) { const int f0 = first + 64 * b8;
                if (f0 + 63 < 0) continue;
                attn_batch(Kw, Vw, f0, 0, SEQ - 1, (f0 + lane) >= 0, qr, mw, lw, ow, lane); }
        }
#pragma unroll
        for (int h = 0; h < 4; ++h) {
            const int hh = g * 4 + h;
            const float g0 = sigmoid_f(GL[(size_t)row * 48 + hh]), g1 = sigmoid_f(GL[(size_t)row * 48 + 16 + hh]), g2 = sigmoid_f(GL[(size_t)row * 48 + 32 + hh]);
            const float is = ls[h] > 0.f ? 1.0f / ls[h] : 0.f, iw = lw[h] > 0.f ? 1.0f / lw[h] : 0.f;
            const unsigned ngv = *(const unsigned*)(NG + (size_t)row * DM + hh * HD + 2 * lane);
            const float y0 = (g0 * oc[h][0] + g1 * os[h][0] * is + g2 * ow[h][0] * iw) * silu_f(bf_lo(ngv));
            const float y1 = (g0 * oc[h][1] + g1 * os[h][1] * is + g2 * ow[h][1] * iw) * silu_f(bf_hi(ngv));
            *(unsigned*)(ZC + (size_t)row * ZC_LD + 2048 + hh * HD + 2 * lane) = pk2(y0, y1);
        }
    }
}


namespace nsa {
typedef float f32x16 __attribute__((ext_vector_type(16)));
typedef short s16x4 __attribute__((ext_vector_type(4)));
constexpr int KVBLK = 64, SHM = 16384;
constexpr float SCALE = 0.08838834764831845f, THR = 8.f;
constexpr int L_V = 0, L_K = 32768, L_WS = 65536, L_SEL = 67584, L_UNI = 67840, L_GS = 68608, L_LS = L_GS + 33792, L_IMP = L_LS + 33792, L_END = L_IMP + 8448;
static_assert(L_END <= LDS_BYTES, "nsa lds");
#define KSWZ(row, colB) ((row) * 256 + ((colB) ^ (((row) & 7) << 4)))
#define SBAR() __builtin_amdgcn_sched_barrier(0)
__device__ __forceinline__ int v_st(int k, int c) { const int kk = (k & ~0xC) | ((k & 4) << 1) | ((k & 8) >> 1); return ((kk >> 3) * 4 + (c >> 5)) * 512 + ((kk & 7) * 32 + (c & 31)) * 2; }
__device__ __forceinline__ int v_rd_base(int lane) { return ((lane & 3) << 3) | (((lane >> 2) & 3) << 6) | (((lane >> 4) & 1) << 5) | (((lane >> 5) & 1) << 8); }
constexpr int v_rd_off(int d0, int ks, int half) { return d0 * 512 + ks * 4096 + half * 2048; }
__device__ __forceinline__ int crow(int r, int hi) { return (r & 3) + 8 * (r >> 2) + 4 * hi; }
__device__ __forceinline__ bf16x8 pack8(f32x4 a, f32x4 b) {
    u32x4 w = {cvt_pk_bf16(a[0], a[1]), cvt_pk_bf16(a[2], a[3]), cvt_pk_bf16(b[0], b[1]), cvt_pk_bf16(b[2], b[3])};
    return *reinterpret_cast<bf16x8*>(&w);
}
__device__ __forceinline__ void mask_tile(f32x16& p0, f32x16& p1, int dq, unsigned W) {
    const float NEG = -__builtin_inff();
#pragma unroll
    for (int r = 0; r < 16; ++r) {
        const int c = (r & 3) + 8 * (r >> 2);
        if ((unsigned)(dq - c) >= W) p0[r] = NEG;
        if ((unsigned)(dq - c - 32) >= W) p1[r] = NEG;
    }
}
__device__ __forceinline__ void mask_all(f32x16& p0, f32x16& p1) {
    const float NEG = -__builtin_inff();
#pragma unroll
    for (int r = 0; r < 16; ++r) { p0[r] = NEG; p1[r] = NEG; }
}
__device__ __forceinline__ void partialSM(f32x16& p0, f32x16& p1, float& m_reg, float& mn, float& alpha) {
    float pmax = p0[0];
#pragma unroll
    for (int r = 1; r < 16; ++r) pmax = fmaxf(pmax, p0[r]);
#pragma unroll
    for (int r = 0; r < 16; ++r) pmax = fmaxf(pmax, p1[r]);
    { auto rr = __builtin_amdgcn_permlane32_swap(__float_as_uint(pmax), __float_as_uint(pmax), false, false);
      pmax = fmaxf(__uint_as_float(rr[0]), __uint_as_float(rr[1])); }
    constexpr float C2 = 1.4426950408889634f * SCALE;
    if (__builtin_expect(__all((pmax - m_reg) * SCALE <= THR), 1)) { mn = m_reg; alpha = 1.f; }
    else { mn = fmaxf(m_reg, pmax); alpha = __builtin_amdgcn_exp2f((m_reg - mn) * C2); m_reg = mn; }
    const float mnL = -mn * C2;
#pragma unroll
    for (int r = 0; r < 16; ++r) p0[r] = fmaf(p0[r], C2, mnL);
#pragma unroll
    for (int r = 0; r < 16; ++r) p1[r] = fmaf(p1[r], C2, mnL);
#pragma unroll
    for (int r = 0; r < 16; ++r) p0[r] = __builtin_amdgcn_exp2f(p0[r]);
}
#define NSA_PK4(P, B_, OUT) do { unsigned a0 = cvt_pk_bf16(P[B_+0], P[B_+1]), a1 = cvt_pk_bf16(P[B_+2], P[B_+3]);                 \
        unsigned b0 = cvt_pk_bf16(P[B_+4], P[B_+5]), b1 = cvt_pk_bf16(P[B_+6], P[B_+7]);                                         \
        auto r0 = __builtin_amdgcn_permlane32_swap(a0, b0, false, false); auto r1 = __builtin_amdgcn_permlane32_swap(a1, b1, false, false); \
        u32x4 w = {r0[0], r1[0], r0[1], r1[1]}; OUT = *reinterpret_cast<bf16x8*>(&w); } while (0)
__device__ __forceinline__ void pack_p(const f32x16& p0, const f32x16& p1, bf16x8& pa0, bf16x8& pa1, bf16x8& pa2, bf16x8& pa3) {
    NSA_PK4(p0, 0, pa0); NSA_PK4(p0, 8, pa1); NSA_PK4(p1, 0, pa2); NSA_PK4(p1, 8, pa3);
}
__device__ __forceinline__ void finishSM(f32x16& p0, f32x16& p1, float alpha, float& l_reg, bf16x8& pa0, bf16x8& pa1, bf16x8& pa2, bf16x8& pa3) {
#pragma unroll
    for (int r = 0; r < 16; ++r) p1[r] = __builtin_amdgcn_exp2f(p1[r]);
    float ps = 0;
#pragma unroll
    for (int r = 0; r < 16; ++r) ps += p0[r];
#pragma unroll
    for (int r = 0; r < 16; ++r) ps += p1[r];
    { auto rr = __builtin_amdgcn_permlane32_swap(__float_as_uint(ps), __float_as_uint(ps), false, false);
      ps = __uint_as_float(rr[0]) + __uint_as_float(rr[1]); }
    l_reg = l_reg * alpha + ps;
    pack_p(p0, p1, pa0, pa1, pa2, pa3);
}
template <int KB>
__device__ __forceinline__ void qkt(f32x16& p0, f32x16& p1, const LAS unsigned char* lds, int r32, int hi, const bf16x8* qr) {
    p0 = f32x16{}; p1 = f32x16{};
    const LAS unsigned char* kb[4];
#pragma unroll
    for (int dd = 0; dd < 4; ++dd) kb[dd] = lds + L_K + KB * SHM + KSWZ(r32, (dd * 16 + hi * 8) * 2);
#pragma unroll
    for (int d0 = 0; d0 < 8; ++d0) { const LAS unsigned char* a = kb[d0 & 3] + (d0 >> 2) * 128;
        const bf16x8 b0 = *reinterpret_cast<const LAS bf16x8*>(a);
        const bf16x8 b1 = *reinterpret_cast<const LAS bf16x8*>(a + 32 * 256);
        p0 = __builtin_amdgcn_mfma_f32_32x32x16_bf16(b0, qr[d0], p0, 0, 0, 0);
        p1 = __builtin_amdgcn_mfma_f32_32x32x16_bf16(b1, qr[d0], p1, 0, 0, 0); }
}
template <int VB>
__device__ __forceinline__ void pv_tile(f32x16* o, int vb0, bf16x8 pa0, bf16x8 pa1, bf16x8 pa2, bf16x8 pa3) {
#define TRRD(dst, off) asm volatile("ds_read_b64_tr_b16 %0, %1 offset:%2" : "=&v"(dst) : "v"(vb0), "i"(off) : "memory")
#define PV_D0(d0) do { s16x4 l0, l1, l2, l3, h0, h1, h2, h3; constexpr int b_ = L_V + VB * SHM + v_rd_off(d0, 0, 0); \
        TRRD(l0, b_); TRRD(h0, b_ + 2048); TRRD(l1, b_ + 4096); TRRD(h1, b_ + 6144); TRRD(l2, b_ + 8192); TRRD(h2, b_ + 10240); TRRD(l3, b_ + 12288); TRRD(h3, b_ + 14336); \
        asm volatile("s_waitcnt lgkmcnt(0)" ::: "memory"); SBAR();   \
        o[d0] = __builtin_amdgcn_mfma_f32_32x32x16_bf16(pa0, (bf16x8){l0[0], l0[1], l0[2], l0[3], h0[0], h0[1], h0[2], h0[3]}, o[d0], 0, 0, 0);   \
        o[d0] = __builtin_amdgcn_mfma_f32_32x32x16_bf16(pa1, (bf16x8){l1[0], l1[1], l1[2], l1[3], h1[0], h1[1], h1[2], h1[3]}, o[d0], 0, 0, 0);   \
        o[d0] = __builtin_amdgcn_mfma_f32_32x32x16_bf16(pa2, (bf16x8){l2[0], l2[1], l2[2], l2[3], h2[0], h2[1], h2[2], h2[3]}, o[d0], 0, 0, 0);   \
        o[d0] = __builtin_amdgcn_mfma_f32_32x32x16_bf16(pa3, (bf16x8){l3[0], l3[1], l3[2], l3[3], h3[0], h3[1], h3[2], h3[3]}, o[d0], 0, 0, 0); } while (0)
    PV_D0(0); PV_D0(1); PV_D0(2); PV_D0(3);
#undef PV_D0
#undef TRRD
}

struct Ctx {
    LAS unsigned char* lds; int tid, wid, lane, r32, hi, sr, sc, vst0, vst1, kws, vb0;
    LAS float* li_l; LAS float* al_l;
};
__device__ __forceinline__ Ctx make_ctx(LAS unsigned char* lds) {
    Ctx c; c.lds = lds; c.tid = threadIdx.x; asm volatile("" : "+v"(c.tid));
    c.wid = __builtin_amdgcn_readfirstlane(c.tid >> 6); c.lane = c.tid & 63; c.r32 = c.lane & 31; c.hi = c.lane >> 5;
    c.sr = c.tid >> 4; c.sc = (c.tid & 15) * 8; c.vst0 = v_st(c.sr, c.sc); c.vst1 = v_st(32 + c.sr, c.sc); c.kws = KSWZ(c.sr, c.sc * 2);
    c.vb0 = (int)(unsigned)(uintptr_t)lds + v_rd_base(c.lane);
    LAS float* wsf = (LAS float*)(lds + L_WS) + c.wid * 64; c.li_l = wsf; c.al_l = wsf + 32;
    return c;
}
struct Stage { bf16x8 k0, k1, v0, v1; };
__device__ __forceinline__ void sload(Stage& S, const bf16_t* Kh, const bf16_t* Vh, int k0, const Ctx& c) {
    S.v0 = *(const bf16x8*)(Vh + (size_t)(k0 + c.sr) * HD + c.sc); S.v1 = *(const bf16x8*)(Vh + (size_t)(k0 + 32 + c.sr) * HD + c.sc);
    S.k0 = *(const bf16x8*)(Kh + (size_t)(k0 + c.sr) * HD + c.sc); S.k1 = *(const bf16x8*)(Kh + (size_t)(k0 + 32 + c.sr) * HD + c.sc);
}
__device__ __forceinline__ void swrite(const Stage& S, int bf, const Ctx& c) {
    *(LAS bf16x8*)(c.lds + L_V + bf * SHM + c.vst0) = S.v0; *(LAS bf16x8*)(c.lds + L_V + bf * SHM + c.vst1) = S.v1;
    *(LAS bf16x8*)(c.lds + L_K + bf * SHM + c.kws) = S.k0; *(LAS bf16x8*)(c.lds + L_K + bf * SHM + c.kws + 32 * 256) = S.k1;
}
__device__ __forceinline__ void rescale_rows(f32x16 (&o)[4], float a, const Ctx& c) {
    if (c.hi == 0) c.al_l[c.r32] = a;
    asm volatile("s_waitcnt lgkmcnt(0)" ::: "memory");
    float s[16];
#pragma unroll
    for (int r = 0; r < 16; ++r) s[r] = c.al_l[crow(r, c.hi)];
#pragma unroll
    for (int d = 0; d < 4; ++d)
#pragma unroll
        for (int r = 0; r < 16; ++r) o[d][r] *= s[r];
    asm volatile("s_waitcnt lgkmcnt(0)" ::: "memory");
}
template <int BUF, int MK>
__device__ __forceinline__ void tile_step(f32x16 (&o)[4], float& m_reg, float& l_reg, const bf16x8* qf, const Ctx& c, int j, int tpos, unsigned sel, int jcur) {
    f32x16 p0, p1; float mn, alpha; bf16x8 pa0, pa1, pa2, pa3;
    if (MK == 1) { const bool act = __any((sel >> j) & 1u); if (!act) return; }
    qkt<BUF>(p0, p1, c.lds, c.r32, c.hi, qf);
    const int dq = tpos - KVBLK * j - 4 * c.hi;
    if (MK == 0) { if (j == jcur || j == jcur - 8) mask_tile(p0, p1, dq, 512u); }
    else { if (j == jcur) mask_tile(p0, p1, dq, 0x7fffffffu);
        const bool on = (sel >> j) & 1u; const float NEG = -__builtin_inff();
#pragma unroll
        for (int r = 0; r < 16; ++r) { p0[r] = on ? p0[r] : NEG; p1[r] = on ? p1[r] : NEG; } }
    partialSM(p0, p1, m_reg, mn, alpha);
    if (__any(alpha < 1.f)) rescale_rows(o, alpha, c);
    finishSM(p0, p1, alpha, l_reg, pa0, pa1, pa2, pa3); SBAR();
    pv_tile<BUF>(o, c.vb0, pa0, pa1, pa2, pa3);
}
template <int MK>
__device__ __forceinline__ void run_tiles(f32x16 (&o)[4], float& m_reg, float& l_reg, const bf16x8* qf, const Ctx& c, const bf16_t* Kh, const bf16_t* Vh,
                                          unsigned tiles, int tpos, unsigned sel, int jcur) {
    Stage S;
    int j = __ffs((int)tiles) - 1; tiles &= tiles - 1;
    sload(S, Kh, Vh, KVBLK * j, c); swrite(S, 0, c);
    __syncthreads();
    for (;;) {
        int jn = tiles ? __ffs((int)tiles) - 1 : -1; tiles &= tiles - 1;
        if (jn >= 0) sload(S, Kh, Vh, KVBLK * jn, c);
        tile_step<0, MK>(o, m_reg, l_reg, qf, c, j, tpos, sel, jcur);
        if (jn >= 0) swrite(S, 1, c);
        __syncthreads();
        if (jn < 0) break;
        j = jn; jn = tiles ? __ffs((int)tiles) - 1 : -1; tiles &= tiles - 1;
        if (jn >= 0) sload(S, Kh, Vh, KVBLK * jn, c);
        tile_step<1, MK>(o, m_reg, l_reg, qf, c, j, tpos, sel, jcur);
        if (jn >= 0) swrite(S, 0, c);
        __syncthreads();
        if (jn < 0) break;
        j = jn;
    }
}
__device__ __forceinline__ void load_q(bf16x8 (&qf)[8], const bf16_t* Q, int row, int h, int hi) {
    const bf16_t* qp = Q + (size_t)row * DM + h * HD + hi * 8;
#pragma unroll
    for (int d0 = 0; d0 < 8; ++d0) qf[d0] = *(const bf16x8*)(qp + d0 * 16);
}
__device__ __forceinline__ void rotate_q(bf16x8& q0, bf16x8& q1, const float* COS, const float* SIN, int t, int hi) {
    const f32x4 c0 = *(const f32x4*)(COS + t * 16 + hi * 8), c1 = *(const f32x4*)(COS + t * 16 + hi * 8 + 4);
    const f32x4 s0 = *(const f32x4*)(SIN + t * 16 + hi * 8), s1 = *(const f32x4*)(SIN + t * 16 + hi * 8 + 4);
    f32x4 a0, a1, b0, b1;
#pragma unroll
    for (int jj = 0; jj < 4; ++jj) { a0[jj] = bf2f((bf16_t)q0[jj]); a1[jj] = bf2f((bf16_t)q0[4 + jj]); b0[jj] = bf2f((bf16_t)q1[jj]); b1[jj] = bf2f((bf16_t)q1[4 + jj]); }
    q0 = pack8(a0 * c0 - b0 * s0, a1 * c1 - b1 * s1);
    q1 = pack8(b0 * c0 + a0 * s0, b1 * c1 + a1 * s1);
}

__device__ __forceinline__ void window_unit(const Args& a, LAS unsigned char* lds, int bg, int qb) {
    unsigned char* ws = a.ws;
    const Ctx c = make_ctx(lds);
    const int n = c.wid >> 1, th = c.wid & 1, tq = 32 * th + c.r32, t = 64 * qb + tq, b = bg >> 2, g = bg & 3, h = g * 4 + n, row = b * SEQ + t;
    bf16x8 qf[8];
    load_q(qf, (const bf16_t*)(ws + WS_Q), row, h, c.hi);
    rotate_q(qf[0], qf[1], (const float*)(ws + WS_COS), (const float*)(ws + WS_SIN), t, c.hi);
    const bf16_t* Kh = (const bf16_t*)(ws + WS_KV) + 4 * KV_ELEMS + (size_t)bg * SEQ * HD; const bf16_t* Vh = (const bf16_t*)(ws + WS_KV) + 5 * KV_ELEMS + (size_t)bg * SEQ * HD;
    f32x16 o[4] = {}; float m_reg = -1e30f, l_reg = 0.f;
    const int jlo = qb >= 8 ? qb - 8 : 0;
    const unsigned tiles = (qb == 31 ? 0xffffffffu : ((1u << (qb + 1)) - 1u)) & ~((1u << jlo) - 1u);
    run_tiles<0>(o, m_reg, l_reg, qf, c, Kh, Vh, tiles, t, 0u, qb);
    const float g2 = sigmoid_f(((const float*)(ws + WS_GL))[(size_t)row * 48 + 32 + h]);
    rescale_rows(o, l_reg > 0.f ? g2 / l_reg : 0.f, c);
    bf16_t* OW = (bf16_t*)(ws + WS_XB);
    const int rbase = b * SEQ + 64 * qb + 32 * th;
#pragma unroll
    for (int r = 0; r < 16; ++r) { const int orow = rbase + crow(r, c.hi);
#pragma unroll
        for (int d0 = 0; d0 < 4; ++d0) { const float v = o[d0][r]; const float vn = __shfl_xor(v, 1);
            if ((c.r32 & 1) == 0) *(unsigned*)(OW + (size_t)orow * DM + h * HD + d0 * 32 + c.r32) = cvt_pk_bf16(v, vn); } }
}

__device__ __forceinline__ void cmpsel_unit(const Args& a, LAS unsigned char* lds, int bg, int qb) {
    unsigned char* ws = a.ws;
    const Ctx c = make_ctx(lds);
    const int n = c.wid >> 1, th = c.wid & 1, tq = 32 * th + c.r32, t = 64 * qb + tq, b = bg >> 2, g = bg & 3, h = g * 4 + n, row = b * SEQ + t;
    const float* GL = (const float*)(ws + WS_GL);
    LAS float* GS = (LAS float*)(lds + L_GS); LAS float* LS = (LAS float*)(lds + L_LS);
    LAS unsigned* SEL = (LAS unsigned*)(lds + L_SEL); LAS unsigned* UNI = (LAS unsigned*)(lds + L_UNI);
    bf16x8 qf[8];
    load_q(qf, (const bf16_t*)(ws + WS_Q), row, h, c.hi);
    f32x16 o[4] = {};
    float l_c;
    {
        const bf16_t* Kc = (const bf16_t*)(ws + WS_KC) + (size_t)bg * 128 * HD; const bf16_t* Vc = (const bf16_t*)(ws + WS_VC) + (size_t)bg * 128 * HD;
        { Stage S0; sload(S0, Kc, Vc, 0, c); swrite(S0, 0, c); }
        { Stage S1; sload(S1, Kc, Vc, 64, c); swrite(S1, 1, c); }
        __syncthreads();
        f32x16 pA0, pA1, pB0, pB1;
        qkt<0>(pA0, pA1, c.lds, c.r32, c.hi, qf); qkt<1>(pB0, pB1, c.lds, c.r32, c.hi, qf);
        const int cmax = t >= 31 ? ((t - 31) >> 4) : -1;
        const float NEG = -__builtin_inff();
#pragma unroll
        for (int r = 0; r < 16; ++r) { const int cc = crow(r, c.hi);
            if (cc > cmax) pA0[r] = NEG; if (cc + 32 > cmax) pA1[r] = NEG; if (cc + 64 > cmax) pB0[r] = NEG; if (cc + 96 > cmax) pB1[r] = NEG; }
        float mx = -1e30f;
#pragma unroll
        for (int r = 0; r < 16; ++r) mx = fmaxf(fmaxf(mx, fmaxf(pA0[r], pA1[r])), fmaxf(pB0[r], pB1[r]));
        { auto rr = __builtin_amdgcn_permlane32_swap(__float_as_uint(mx), __float_as_uint(mx), false, false); mx = fmaxf(__uint_as_float(rr[0]), __uint_as_float(rr[1])); }
        constexpr float C2 = 1.4426950408889634f * SCALE;
        const float mnL = -mx * C2; float ps = 0.f;
#pragma unroll
        for (int r = 0; r < 16; ++r) { pA0[r] = __builtin_amdgcn_exp2f(fmaf(pA0[r], C2, mnL)); pA1[r] = __builtin_amdgcn_exp2f(fmaf(pA1[r], C2, mnL));
            pB0[r] = __builtin_amdgcn_exp2f(fmaf(pB0[r], C2, mnL)); pB1[r] = __builtin_amdgcn_exp2f(fmaf(pB1[r], C2, mnL)); ps += (pA0[r] + pA1[r]) + (pB0[r] + pB1[r]); }
        { auto rr = __builtin_amdgcn_permlane32_swap(__float_as_uint(ps), __float_as_uint(ps), false, false); ps = __uint_as_float(rr[0]) + __uint_as_float(rr[1]); }
        l_c = ps;
        const float inv = ps > 0.f ? 1.0f / ps : 0.f;
        LAS float* gsr = GS + (n * 64 + tq) * 33; LAS float* lsr = LS + (n * 64 + tq) * 33;
#pragma unroll
        for (int k = 0; k < 4; ++k) {
            const int jb = 2 * k + c.hi;
            gsr[jb]      = ((pA0[4 * k] + pA0[4 * k + 1]) + (pA0[4 * k + 2] + pA0[4 * k + 3])) * inv; lsr[jb]      = pA0[4 * k + 3] * inv;
            gsr[8 + jb]  = ((pA1[4 * k] + pA1[4 * k + 1]) + (pA1[4 * k + 2] + pA1[4 * k + 3])) * inv; lsr[8 + jb]  = pA1[4 * k + 3] * inv;
            gsr[16 + jb] = ((pB0[4 * k] + pB0[4 * k + 1]) + (pB0[4 * k + 2] + pB0[4 * k + 3])) * inv; lsr[16 + jb] = pB0[4 * k + 3] * inv;
            gsr[24 + jb] = ((pB1[4 * k] + pB1[4 * k + 1]) + (pB1[4 * k + 2] + pB1[4 * k + 3])) * inv; lsr[24 + jb] = pB1[4 * k + 3] * inv;
        }
        bf16x8 pa0, pa1, pa2, pa3;
        pack_p(pA0, pA1, pa0, pa1, pa2, pa3); SBAR(); pv_tile<0>(o, c.vb0, pa0, pa1, pa2, pa3);
        pack_p(pB0, pB1, pa0, pa1, pa2, pa3); SBAR(); pv_tile<1>(o, c.vb0, pa0, pa1, pa2, pa3);
    }
    __syncthreads();
    {
        LAS float* IMP = (LAS float*)(lds + L_IMP);
        const int tk = c.tid & 63, j0 = c.wid * 4;
        const LAS float* gb = GS + tk * 33 + j0; const LAS float* lb = LS + tk * 33 + j0 - 1;
#pragma unroll
        for (int jj = 0; jj < 4; ++jj) { float s = 0.f;
#pragma unroll
            for (int nn = 0; nn < 4; ++nn) { s += gb[nn * 2112 + jj]; const float lv = lb[nn * 2112 + jj]; s += (j0 + jj > 0) ? lv : 0.f; }
            IMP[tk * 33 + j0 + jj] = s; }
    }
    __syncthreads();
    if (c.wid == 0) {
        const LAS float* IMP = (const LAS float*)(lds + L_IMP);
        const int tk = c.lane;
        unsigned selm = 1u | (1u << qb);
        if (qb >= 2) {
            const int nfree = qb - 1;
            if (nfree <= 6) selm |= ((1u << qb) - 1u) & ~1u;
            else {
                float v[32];
#pragma unroll
                for (int jj = 1; jj < 31; ++jj) { const float s = IMP[tk * 33 + jj]; v[jj] = (jj < qb) ? s : -1.0f; }
                unsigned taken = 0u;
                for (int rnd = 0; rnd < 6; ++rnd) {
                    float best = -0.5f; int bi = -1;
#pragma unroll
                    for (int jj = 1; jj < 31; ++jj) { const bool ok = !((taken >> jj) & 1u) && v[jj] > best; best = ok ? v[jj] : best; bi = ok ? jj : bi; }
                    if (bi >= 0) taken |= 1u << bi;
                }
                selm |= taken;
            }
        }
        SEL[tk] = selm;
        unsigned u = selm;
#pragma unroll
        for (int off = 1; off < 64; off <<= 1) u |= (unsigned)__shfl_xor((int)u, off);
        if (c.lane == 0) UNI[0] = u;
    }
    bf16_t* ZC = (bf16_t*)(ws + WS_ZC);
    const int rbase = b * SEQ + 64 * qb + 32 * th;
    {
        const float g0 = sigmoid_f(GL[(size_t)row * 48 + h]);
        rescale_rows(o, l_c > 0.f ? g0 / l_c : 0.f, c);
#pragma unroll
        for (int r = 0; r < 16; ++r) { const int orow = rbase + crow(r, c.hi);
#pragma unroll
            for (int d0 = 0; d0 < 4; ++d0) ZC[(size_t)orow * ZC_LD + 2048 + h * HD + d0 * 32 + c.r32] = (bf16_t)(cvt_pk_bf16(o[d0][r], 0.f) & 0xffffu); }
#pragma unroll
        for (int d = 0; d < 4; ++d) o[d] = f32x16{};
    }
    __syncthreads();
    const unsigned sel = SEL[tq]; const unsigned uni = (unsigned)__builtin_amdgcn_readfirstlane((int)UNI[0]);
    rotate_q(qf[0], qf[1], (const float*)(ws + WS_COS), (const float*)(ws + WS_SIN), t, c.hi);
    float m_reg = -1e30f, l_reg = 0.f;
    {
        const bf16_t* Kh = (const bf16_t*)(ws + WS_KV) + 2 * KV_ELEMS + (size_t)bg * SEQ * HD; const bf16_t* Vh = (const bf16_t*)(ws + WS_KV) + 3 * KV_ELEMS + (size_t)bg * SEQ * HD;
        run_tiles<1>(o, m_reg, l_reg, qf, c, Kh, Vh, uni, t, sel, qb);
    }
    const float g1 = sigmoid_f(GL[(size_t)row * 48 + 16 + h]);
    rescale_rows(o, l_reg > 0.f ? g1 / l_reg : 0.f, c);
    const bf16_t* OW = (const bf16_t*)(ws + WS_XB); const bf16_t* NG = (const bf16_t*)(ws + WS_NG);
    int rbase2 = rbase; asm volatile("" : "+v"(rbase2));
#pragma unroll
    for (int r = 0; r < 16; ++r) { const int orow = rbase2 + crow(r, c.hi);
#pragma unroll
        for (int d0 = 0; d0 < 4; ++d0) {
            const size_t col = (size_t)h * HD + d0 * 32 + c.r32;
            bf16_t* yp = ZC + (size_t)orow * ZC_LD + 2048 + col;
            const float occ = bf2f(*yp);
            const float ow = bf2f(OW[(size_t)orow * DM + col]), ng = bf2f(NG[(size_t)orow * DM + col]);
            const float v = (occ + o[d0][r] + ow) * silu_f(ng);
            *yp = (bf16_t)(cvt_pk_bf16(v, 0.f) & 0xffffu); } }
    __syncthreads();
}

__device__ __forceinline__ void compress_unit(const Args& a, LAS unsigned char* lds, int task) {
    unsigned char* ws = a.ws;
    int tid = threadIdx.x; asm volatile("" : "+v"(tid));
    const int wid = __builtin_amdgcn_readfirstlane(tid >> 6), lane = tid & 63, r32 = lane & 31, hi = lane >> 5;
    const int mb = task & 3, bg = (task >> 2) & 15, kv = task >> 6;
    const bf16_t* X = (const bf16_t*)(ws + WS_KV) + (size_t)kv * KV_ELEMS + (size_t)bg * SEQ * HD;
    const bf16_t* W1T = (const bf16_t*)(ws + WS_W1T) + (size_t)kv * 128 * 4096;
    const bf16_t* W2T = (const bf16_t*)(ws + WS_W2T) + (size_t)kv * 128 * 128;
    int cc = 32 * mb + r32; if (cc > NCMP - 1) cc = NCMP - 1;
    f32x16 acc[4] = {};
#pragma unroll 1
    for (int l = 4 * wid; l < 4 * wid + 4; ++l) {
        const bf16_t* xr = X + (size_t)(16 * cc + l) * HD + hi * 8;
        const bf16_t* wr = W1T + (size_t)r32 * 4096 + l * 128 + hi * 8;
#pragma unroll
        for (int ks = 0; ks < 8; ++ks) {
            const bf16x8 af = *(const bf16x8*)(xr + 16 * ks);
#pragma unroll
            for (int nb = 0; nb < 4; ++nb) { const bf16x8 bfr = *(const bf16x8*)(wr + (size_t)nb * 32 * 4096 + 16 * ks);
                acc[nb] = __builtin_amdgcn_mfma_f32_32x32x16_bf16(af, bfr, acc[nb], 0, 0, 0); }
        }
    }
    LAS float* part = (LAS float*)lds;
    LAS bf16_t* hid = (LAS bf16_t*)(lds + 131072);
#pragma unroll
    for (int nb = 0; nb < 4; ++nb)
#pragma unroll
        for (int r = 0; r < 16; ++r) part[wid * 4096 + crow(r, hi) * 128 + nb * 32 + r32] = acc[nb][r];
    __syncthreads();
    {
        const float* PBP = (const float*)(ws + WS_PBP) + kv * 4096; const float* b1 = a.in[kv ? 10 : 6];
        for (int e = tid; e < 32 * 128; e += NTHREADS) { const int j = e & 127, m = e >> 7;
            float s = b1[j];
            for (int q = 0; q < 32; ++q) s += PBP[q * 128 + j];
#pragma unroll
            for (int w = 0; w < 8; ++w) s += part[w * 4096 + e];
            hid[m * 136 + j] = (bf16_t)f2bf(silu_f(s)); }
    }
    __syncthreads();
    if (wid < 4) {
        f32x16 o2 = {};
#pragma unroll
        for (int ks = 0; ks < 8; ++ks) {
            const bf16x8 af = *(const LAS bf16x8*)(hid + r32 * 136 + 16 * ks + hi * 8);
            const bf16x8 bfr = *(const bf16x8*)(W2T + (size_t)(32 * wid + r32) * 128 + 16 * ks + hi * 8);
            o2 = __builtin_amdgcn_mfma_f32_32x32x16_bf16(af, bfr, o2, 0, 0, 0);
        }
        bf16_t* dst = (bf16_t*)(ws + (kv ? WS_VC : WS_KC)) + (size_t)bg * 128 * 128;
#pragma unroll
        for (int r = 0; r < 16; ++r) { const int c2 = 32 * mb + crow(r, hi);
            dst[(size_t)c2 * 128 + 32 * wid + r32] = (bf16_t)(c2 < NCMP ? f2bf(o2[r]) : 0u); }
    }
    __syncthreads();
}

constexpr int SGU_UZ = 65536, SGU_UZ_LD = 264;
__device__ __forceinline__ void sgu_unit(const Args& a, LAS unsigned char* lds, int ch, int h, bool dry = false) {
    unsigned char* ws = a.ws;
    int tid = threadIdx.x; asm volatile("" : "+v"(tid));
    const int wid = __builtin_amdgcn_readfirstlane(tid >> 6), lane = tid & 63, r32 = lane & 31, hi = lane >> 5;
    const int tb = wid & 3, dh = wid >> 2, row0 = ch * 128;
    bf16_t* Z1 = (bf16_t*)(ws + WS_Z1); const float* LNS = (const float*)(ws + WS_LNS);
    const float* lng = a.in[15]; const float* lnb = a.in[16]; const float* bsp = a.in[18];
    LAS bf16_t* UZ = (LAS bf16_t*)(lds + SGU_UZ);
    const int sr = tid >> 4, sc = (tid & 15) * 8;
    {
#pragma unroll
        for (int dhh = 0; dhh < 2; ++dhh) {
            const int col = h * 256 + dhh * 128 + sc;
            const f32x4 g0 = *(const f32x4*)(lng + col), g1 = *(const f32x4*)(lng + col + 4), b0 = *(const f32x4*)(lnb + col), b1 = *(const f32x4*)(lnb + col + 4);
#pragma unroll
            for (int q = 0; q < 4; ++q) {
                const int s = 32 * q + sr, row = row0 + s;
                const bf16_t* zp = Z1 + (size_t)row * N1 + col;
                const u32x4 uu = *(const u32x4*)zp, vv = *(const u32x4*)(zp + MIXW), zz = *(const u32x4*)(zp + 2 * MIXW);
                const float sum = LNS[2 * row], sq = LNS[2 * row + 1]; const float mu = sum * (1.0f / MIXW);
                const float rstd = __builtin_amdgcn_rsqf(fmaxf(sq * (1.0f / MIXW) - mu * mu, 0.f) + EPS);
                f32x4 x0 = {bf_lo(vv.x), bf_hi(vv.x), bf_lo(vv.y), bf_hi(vv.y)}, x1 = {bf_lo(vv.z), bf_hi(vv.z), bf_lo(vv.w), bf_hi(vv.w)};
                x0 = (x0 - mu) * rstd * g0 + b0; x1 = (x1 - mu) * rstd * g1 + b1;
                *(LAS bf16x8*)(lds + L_V + ((q >> 1) * 2 + dhh) * SHM + v_st(32 * (q & 1) + sr, sc)) = pack8(x0, x1);
                f32x4 y0 = {bf_lo(uu.x) * silu_f(bf_lo(zz.x)), bf_hi(uu.x) * silu_f(bf_hi(zz.x)), bf_lo(uu.y) * silu_f(bf_lo(zz.y)), bf_hi(uu.y) * silu_f(bf_hi(zz.y))};
                f32x4 y1 = {bf_lo(uu.z) * silu_f(bf_lo(zz.z)), bf_hi(uu.z) * silu_f(bf_hi(zz.z)), bf_lo(uu.w) * silu_f(bf_lo(zz.w)), bf_hi(uu.w) * silu_f(bf_hi(zz.w))};
                *(LAS bf16x8*)(UZ + s * SGU_UZ_LD + dhh * 128 + sc) = pack8(y0, y1);
            }
        }
    }
    __syncthreads();
    f32x16 o[4] = {};
    {
        const bf16_t* wp = (const bf16_t*)(ws + WS_SW) + (size_t)(h * 128 + 32 * tb + r32) * 128 + hi * 8;
        const int vb0 = (int)(unsigned)(uintptr_t)lds + v_rd_base(lane);
        bf16x8 pa0 = *(const bf16x8*)(wp), pa1 = *(const bf16x8*)(wp + 16), pa2 = *(const bf16x8*)(wp + 32), pa3 = *(const bf16x8*)(wp + 48);
        if (dh == 0) pv_tile<0>(o, vb0, pa0, pa1, pa2, pa3); else pv_tile<1>(o, vb0, pa0, pa1, pa2, pa3);
        if (tb >= 2) {
            pa0 = *(const bf16x8*)(wp + 64); pa1 = *(const bf16x8*)(wp + 80); pa2 = *(const bf16x8*)(wp + 96); pa3 = *(const bf16x8*)(wp + 112);
            if (dh == 0) pv_tile<2>(o, vb0, pa0, pa1, pa2, pa3); else pv_tile<3>(o, vb0, pa0, pa1, pa2, pa3);
        }
    }
#pragma unroll
    for (int r = 0; r < 16; ++r) { const int t = 32 * tb + crow(r, hi); const float bias = bsp[h * 128 + t];
        LAS bf16_t* up = UZ + t * SGU_UZ_LD + dh * 128 + r32;
#pragma unroll
        for (int d0 = 0; d0 < 4; ++d0) up[d0 * 32] = (bf16_t)f2bf(bf2f(up[d0 * 32]) * (o[d0][r] + bias)); }
    __syncthreads();
#pragma unroll
    for (int dhh = 0; dhh < 2; ++dhh)
#pragma unroll
        for (int q = 0; q < 4; ++q) { const int s = 32 * q + sr;
            const u32x4 yv = *(const LAS u32x4*)(UZ + s * SGU_UZ_LD + dhh * 128 + sc);
            *(u32x4*)(dry ? (bf16_t*)(ws + WS_DUMMY) + tid * 8 : Z1 + (size_t)(row0 + s) * N1 + h * 256 + dhh * 128 + sc) = yv; }
    __syncthreads();
}
}

__device__ __forceinline__ void p6_sgu_naive(const Args& a, LAS unsigned char* lds, int blk, int G, int tid) {
    LAS float* vn = (LAS float*)lds;
    LAS float* Wt = (LAS float*)(lds + 65536);
    bf16_t* Z1 = (bf16_t*)(a.ws + WS_Z1); const float* LNS = (const float*)(a.ws + WS_LNS);
    const float* lng = a.in[15]; const float* lnb = a.in[16]; const float* wsp = a.in[17]; const float* bsp = a.in[18];
    const int d = tid & 127, tq = tid >> 7;
    for (int unit = blk; unit < 64 * 16 * 2; unit += G) {
        const int dh = unit & 1, h = (unit >> 1) & 15, ch = unit >> 5;
        const int row0 = ch * 128, col = h * 256 + dh * 128;
        __syncthreads();
        for (int i = tid; i < 128 * 128; i += NTHREADS) { const int s = i >> 7, dd = i & 127; const int row = row0 + s;
            const float sum = LNS[2 * row], sq = LNS[2 * row + 1]; const float mu = sum * (1.0f / MIXW); const float var = sq * (1.0f / MIXW) - mu * mu;
            const float rstd = 1.0f / sqrtf(fmaxf(var, 0.f) + EPS);
            const float v = bf2f(Z1[(size_t)row * N1 + MIXW + col + dd]);
            vn[i] = (v - mu) * rstd * lng[col + dd] + lnb[col + dd];
            Wt[i] = wsp[(size_t)h * 16384 + i]; }
        __syncthreads();
        for (int tt = 0; tt < 32; ++tt) {
            const int t = tq + 4 * tt;
            float mix = 0.f;
            for (int s = 0; s <= t; ++s) mix += Wt[t * 128 + s] * vn[s * 128 + d];
            mix += bsp[h * 128 + t];
            const size_t off = (size_t)(row0 + t) * N1 + col + d;
            const float u = bf2f(Z1[off]), zg = bf2f(Z1[off + 2 * MIXW]);
            Z1[off] = (bf16_t)f2bf(u * mix * silu_f(zg));
        }
    }
    __syncthreads();
}

__device__ __forceinline__ void p8_final(const Args& a, int gw, int NGW, int lane, bool dry = false) {
    const float* gf = a.in[20];
    for (int m = gw; m < MTOK; m += NGW) {
        f32x4* xr = (f32x4*)(a.out + (size_t)m * DM) + lane;
        f32x4 v[8]; float s = 0.f;
#pragma unroll
        for (int j = 0; j < 8; ++j) { v[j] = xr[64 * j]; s += (v[j].x * v[j].x + v[j].y * v[j].y) + (v[j].z * v[j].z + v[j].w * v[j].w); }
        s = wave_sum(s);
        const float rs = 1.0f / sqrtf(s * (1.0f / DM) + EPS);
#pragma unroll
        for (int j = 0; j < 8; ++j) { const f32x4 gg = *((const f32x4*)gf + lane + 64 * j); if (dry) *((f32x4*)(a.ws + WS_DUMMY) + lane) = v[j] * rs * gg; else xr[64 * j] = v[j] * rs * gg; }
    }
}

#define GAS __attribute__((address_space(1)))
typedef GAS unsigned gu32;
#define XB_TMO      128
#define XB_XCNT(j)  (256  + 64 * (j))
#define XB_XSUB(j)  (1280 + 64 * (j))
#define XB_XGEN(j)  (2304 + 64 * (j))
#define XB_TOP      3328
#define XB_TOPGEN   3392
#define XCD_BAR_WORDS 3456
#define XB_SPIN_CAP (1u << 18)

__device__ __forceinline__ unsigned xb_ld(unsigned* p)              { return __hip_atomic_load(p, __ATOMIC_RELAXED, __HIP_MEMORY_SCOPE_AGENT); }
__device__ __forceinline__ unsigned xb_add(unsigned* p, unsigned v) { return __hip_atomic_fetch_add(p, v, __ATOMIC_RELAXED, __HIP_MEMORY_SCOPE_AGENT); }
__device__ __forceinline__ unsigned xb_xcc_id() { return (unsigned)__builtin_amdgcn_s_getreg((3 << 11) | 20) & 0xFu; }
#define XB_SPIN(cond, bar) do { unsigned _sp = 0; while (cond) { __builtin_amdgcn_s_sleep(1); \
    if ((++_sp & 255u) == 0u) { if (xb_ld(&(bar)[XB_TMO])) break; if (_sp > XB_SPIN_CAP) { atomicAdd(&(bar)[XB_TMO], 1u); break; } } } } while (0)

struct XcdBarrier {
    unsigned* bar; unsigned x;
    volatile LAS unsigned* st;
};

__device__ __forceinline__ XcdBarrier xcd_barrier_post(unsigned* bar, volatile LAS unsigned* st) {
    XcdBarrier b; b.bar = bar; b.x = xb_xcc_id(); b.st = st;
    if (threadIdx.x == 0) (void)xb_add(&bar[XB_XCNT(b.x)], 1u);
    return b;
}
__device__ __forceinline__ void xcd_barrier_complete(unsigned* bar, unsigned x, unsigned& nloc, unsigned& nx) {
    const unsigned G = gridDim.x * gridDim.y * gridDim.z;
    unsigned sum, cnt, mine, sp = 0u;
    for (;;) {
        sum = 0u; cnt = 0u; mine = 0u;
#pragma unroll
        for (unsigned j = 0; j < 16; ++j) { const unsigned c = xb_ld(&bar[XB_XCNT(j)]); sum += c; cnt += (c > 0u) ? 1u : 0u; mine = (j == x) ? c : mine; }
        if (sum == G) break;
        __builtin_amdgcn_s_sleep(1);
        if ((++sp & 255u) == 0u) { if (xb_ld(&bar[XB_TMO])) break; if (sp > XB_SPIN_CAP) { atomicAdd(&bar[XB_TMO], 1u); break; } }
    }
    nloc = mine > 0u ? mine : 1u; nx = cnt > 0u ? cnt : 1u;
}

__device__ __forceinline__ void xcd_barrier(const XcdBarrier& b) {
    asm volatile("s_waitcnt vmcnt(0)" ::: "memory");
    __syncthreads();
    if (threadIdx.x == 0) {
        unsigned* bar = b.bar;
        __builtin_amdgcn_s_waitcnt(0);
        unsigned nloc = b.st[0], nx = b.st[1];
        if (nloc == 0u) { xcd_barrier_complete(bar, b.x, nloc, nx); b.st[0] = nloc; b.st[1] = nx; }
        const unsigned old = xb_add(&bar[XB_XSUB(b.x)], 1u);
        const unsigned gen = old / nloc;
        if (old + 1u == (gen + 1u) * nloc) {
            __builtin_amdgcn_fence(__ATOMIC_RELEASE, "agent");
            asm volatile("s_waitcnt vmcnt(0)" ::: "memory");
            const unsigned og = xb_add(&bar[XB_TOP], 1u);
            const unsigned tg = og / nx;
            if (og + 1u == (tg + 1u) * nx) xb_add(&bar[XB_TOPGEN], 1u);
            else XB_SPIN(xb_ld(&bar[XB_TOPGEN]) == tg, bar);
            __builtin_amdgcn_fence(__ATOMIC_ACQUIRE, "agent");
            xb_add(&bar[XB_XGEN(b.x)], 1u);
            asm volatile("s_waitcnt vmcnt(0)" ::: "memory");
        } else {
            XB_SPIN(xb_ld(&bar[XB_XGEN(b.x)]) == gen, bar);
            __builtin_amdgcn_fence(__ATOMIC_ACQUIRE, "agent");
            asm volatile("s_waitcnt vmcnt(0)" ::: "memory");
        }
    }
    __syncthreads();
}

#ifndef STAG_TICKS
#define STAG_TICKS 250
#endif
__device__ __forceinline__ void stagger_ticks(unsigned d) {
    const unsigned long long t0 = __builtin_amdgcn_s_memrealtime();
    while (__builtin_amdgcn_s_memrealtime() - t0 < (unsigned long long)d) __builtin_amdgcn_s_sleep(16);
}
__device__ __forceinline__ void stagger(int vcu) { stagger_ticks((unsigned)((vcu & 7) * STAG_TICKS)); }
__device__ __forceinline__ void stagger_p1(int bx) {
    const unsigned d = bx < 160 ? (unsigned)(((bx >> 3) % 5) * 250) : (unsigned)(1500 + (((bx - 160) >> 3) % 3) * 1000);
    stagger_ticks(d);
}

constexpr int NPHASE = 9;
template <bool COOP>
__global__ void __launch_bounds__(NTHREADS, 2) fwd_kernel(Args args) {
    extern __shared__ __attribute__((aligned(16))) unsigned char lds_raw[];
    LAS unsigned char* lds = (LAS unsigned char*)lds_raw;
    const int tid = threadIdx.x, lane = tid & 63, wave = __builtin_amdgcn_readfirstlane(tid >> 6);
    const int G = gridDim.x, bx = blockIdx.x;
    const int vcu = (G % 8 == 0) ? (bx % 8) * (G / 8) + bx / 8 : bx;
    const int gw = vcu * NWAVES + wave, NGW = G * NWAVES, gt = gw * 64 + lane, NGT = NGW * 64;
    const int lo = args.ph_lo, hi = args.ph_hi;
    unsigned char* ws = args.ws;
#define IN(k) (lo <= (k) && (k) < hi)
    unsigned* barw = (unsigned*)(ws + WS_BAR);
    volatile LAS unsigned* bst = (volatile LAS unsigned*)(lds + LDS_BYTES - 64);
    XcdBarrier bar; bar.bar = barw; bar.x = 0; bar.st = bst;
    if (COOP) {
        if (args.ph_lo < 0) cg::this_grid().sync();
        if (tid == 0) { bst[0] = 0u; bst[1] = 0u; }
        __syncthreads();
        bar = xcd_barrier_post(barw, bst);
    }
#define SEAM(k) do { if (COOP) { if (IN(k) && IN((k) + 1)) { xcd_barrier(bar); } } } while (0)

    if (IN(0)) {
#ifdef REP_P0
        p0_prologue(args, lds, vcu, G, wave, lane, COOP && G == 256); __syncthreads();
#endif
        p0_prologue(args, lds, vcu, G, wave, lane, COOP && G == 256);
    }
    SEAM(0);
#define P1_BODY do { \
        pg8::Gemm g{(const bf16_t*)(ws + WS_XB), (const bf16_t*)(ws + WS_WT0), MTOK, N0, DM, DM}; \
        pg8::StaticOrder S; S.init(MTOK, N0, G, bx); \
        pg8::Epi0 E{(const float*)(ws + WS_RSTD0), (bf16_t*)(ws + WS_ZC), (bf16_t*)(ws + WS_Q), (bf16_t*)(ws + WS_KV), (bf16_t*)(ws + WS_NG), (float*)(ws + WS_GL), \
                    (const float*)(ws + WS_COS), (const float*)(ws + WS_SIN)}; \
        pg8::gemm_phase<pg8::Epi0, pg8::StaticOrder, true, true>(lds, g, S, E); } while (0)
    if (IN(1)) {
#ifdef REP_P1
        P1_BODY; __syncthreads();
#endif
#if defined(REP_P1SLAB) || defined(REP_P1LIN)
        { pg8::Gemm g{(const bf16_t*)(ws + WS_XB), (const bf16_t*)(ws + WS_WT0), MTOK, N0, DM, DM}; pg8::StaticOrder S; S.init(MTOK, N0, G, bx);
#ifdef REP_P1SLAB
          typedef pg8::Epi0T<1> EP;
#else
          typedef pg8::Epi0T<2> EP;
#endif
          EP E{(const float*)(ws + WS_RSTD0), (bf16_t*)(ws + WS_ZC), (bf16_t*)(ws + WS_Q), (bf16_t*)(ws + WS_KV), (bf16_t*)(ws + WS_NG), (float*)(ws + WS_GL), (const float*)(ws + WS_COS), (const float*)(ws + WS_SIN)};
          pg8::gemm_phase<EP, pg8::StaticOrder, true, true>(lds, g, S, E); __syncthreads(); xcd_barrier(bar); }
#endif
#ifdef REP_P1DRY2
        { pg8::Gemm g{(const bf16_t*)(ws + WS_XB), (const bf16_t*)(ws + WS_WT0), MTOK, N0, DM, DM}; pg8::StaticOrder S; S.init(MTOK, N0, G, bx);
          pg8::EpiNull E{(float*)(ws + WS_PBP)}; pg8::gemm_phase<pg8::EpiNull, pg8::StaticOrder, true, true>(lds, g, S, E); __syncthreads(); }
#define REP_P1DRY 1
#endif
#ifdef REP_P1DRY
        { pg8::Gemm g{(const bf16_t*)(ws + WS_XB), (const bf16_t*)(ws + WS_WT0), MTOK, N0, DM, DM}; pg8::StaticOrder S; S.init(MTOK, N0, G, bx);
          pg8::EpiNull E{(float*)(ws + WS_PBP)}; pg8::gemm_phase<pg8::EpiNull, pg8::StaticOrder, true, true>(lds, g, S, E); __syncthreads(); }
#endif
        P1_BODY;
        if (COOP && G == 256 && bx >= 160) { __syncthreads(); p0_late_weights(args, lds, (bx - 160) * NWAVES + wave, 96 * NWAVES, wave, lane); }
    }
    SEAM(1);
    if (IN(2)) {
#ifdef REP_P2C
        for (int task = vcu; task < 128; task += G) nsa::compress_unit(args, lds, task);
#endif
#ifdef REP_P2W
        for (int item = vcu; item < 256; item += G) { const int bg = item >> 4, p = item & 15; for (int k = 0; k < 2; ++k) nsa::window_unit(args, lds, bg, k ? 31 - p : p); }
#endif
        for (int task = vcu; task < 128; task += G) nsa::compress_unit(args, lds, task);
        if (G == 256) {
            const int u0 = vcu < 128 ? vcu : 128 + 3 * (vcu - 128), nu = vcu < 128 ? 1 : 3;
            for (int k = 0; k < nu; ++k) { const int u = u0 + k; nsa::window_unit(args, lds, u >> 5, u & 31); }
        } else {
            for (int item = vcu; item < 256; item += G) { const int bg = item >> 4, p = item & 15; for (int k = 0; k < 2; ++k) nsa::window_unit(args, lds, bg, k ? 31 - p : p); }
        }
#ifdef REP_CONV
        p2_conv(args, gt, MTOK * 256, NGT, true);
#endif
        p2_conv(args, gt, MTOK * 256, NGT);
    }
    SEAM(2);
    if (IN(3)) {
#ifdef REP_P3
      for (int rep = 0; rep < 2; ++rep)
#endif
        for (int item = vcu; item < 256; item += G) { const int bg = item >> 4, p = item & 15;
#ifndef NO_CMPSEL
            for (int k = 0; k < 2; ++k) nsa::cmpsel_unit(args, lds, bg, k ? 31 - p : p);
#endif
        }
    }
    SEAM(3);
    if (IN(4)) {
#ifdef REP_P4DRY
        { pg8::Gemm g{(const bf16_t*)(ws + WS_ZC), (const bf16_t*)(ws + WS_WTO0), MTOK, DM, MIXW, ZC_LD}; pg8::StaticOrder S; S.init(MTOK, DM, G, bx);
          pg8::EpiNull E{(float*)(ws + WS_PBP)}; pg8::gemm_phase<pg8::EpiNull, pg8::StaticOrder, true, true>(lds, g, S, E); __syncthreads(); }
#endif
        pg8::Gemm g{(const bf16_t*)(ws + WS_ZC), (const bf16_t*)(ws + WS_WTO0), MTOK, DM, MIXW, ZC_LD};
        pg8::StaticOrder S; S.init(MTOK, DM, G, bx);
        pg8::EpiOut0 E{args.in[0], args.out, (bf16_t*)(ws + WS_XB), (float*)(ws + WS_SS1)};
        pg8::gemm_phase<pg8::EpiOut0, pg8::StaticOrder, true, true>(lds, g, S, E);
    }
    SEAM(4);
    if (IN(5)) {
        pg8::Gemm g{(const bf16_t*)(ws + WS_XB), (const bf16_t*)(ws + WS_WT1), MTOK, N1, DM, DM};
        pg8::StaticOrder S; S.init(MTOK, N1, G, bx);
        pg8::Epi1 E{(const float*)(ws + WS_SS1), (bf16_t*)(ws + WS_Z1), (float*)(ws + WS_LNS)};
        pg8::gemm_phase<pg8::Epi1, pg8::StaticOrder, true, true>(lds, g, S, E);
    }
    SEAM(5);
    if (IN(6)) {
#ifdef REP_P6
        for (int unit = vcu; unit < 1024; unit += G) nsa::sgu_unit(args, lds, unit >> 4, unit & 15, true);
#endif
        for (int unit = vcu; unit < 1024; unit += G) nsa::sgu_unit(args, lds, unit >> 4, unit & 15); }
    SEAM(6);
    if (IN(7)) {
        pg8::Gemm g{(const bf16_t*)(ws + WS_Z1), (const bf16_t*)(ws + WS_WTO1), MTOK, DM, MIXW, N1};
        pg8::StaticOrder S; S.init(MTOK, DM, G, bx);
        pg8::EpiOut1 E{args.out};
        pg8::gemm_phase<pg8::EpiOut1, pg8::StaticOrder, true, true>(lds, g, S, E);
    }
    SEAM(7);
#ifdef REP_P8
    if (IN(8)) { p8_final(args, gw, NGW, lane, true); }
#endif
    if (IN(8)) { p8_final(args, gw, NGW, lane); }
#undef IN
#undef SEAM
}

#ifndef MK_COOP
#define MK_COOP 1
#endif

extern "C" void kernel_launch(void* const* d_in, const int* in_sizes, int n_in, void* d_out, int out_size, void* d_ws, size_t ws_size, hipStream_t stream) {
    static int grid = 0;
    if (grid == 0) {
        if (n_in != 21 || out_size != MTOK * DM || ws_size < WS_END) { fprintf(stderr, "kernel_launch: unexpected shapes (n_in %d out %d ws %zu)\n", n_in, out_size, ws_size); grid = -1; return; }
        int dev = 0, cus = 0, per_cu = 0;
        (void)hipGetDevice(&dev); (void)hipDeviceGetAttribute(&cus, hipDeviceAttributeMultiprocessorCount, dev);
        (void)hipFuncSetAttribute((const void*)fwd_kernel<true>, hipFuncAttributeMaxDynamicSharedMemorySize, LDS_BYTES);
        (void)hipFuncSetAttribute((const void*)fwd_kernel<false>, hipFuncAttributeMaxDynamicSharedMemorySize, LDS_BYTES);
        (void)hipOccupancyMaxActiveBlocksPerMultiprocessor(&per_cu, (const void*)fwd_kernel<true>, NTHREADS, LDS_BYTES);
        if (per_cu < 1) { fprintf(stderr, "kernel_launch: occupancy query says %d blocks per CU\n", per_cu); per_cu = 1; }
        (void)hipGetLastError();
        grid = cus;
        fprintf(stderr, "kernel_launch: grid %d (per_cu %d)\n", grid, per_cu);
    }
    if (grid < 0) return;
    Args a{};
    for (int i = 0; i < 21; ++i) a.in[i] = (const float*)d_in[i];
    a.out = (float*)d_out; a.ws = (unsigned char*)d_ws;
#if MK_COOP
    if (hipMemsetAsync((char*)d_ws + WS_BAR, 0, 16384, stream) != hipSuccess) { fprintf(stderr, "kernel_launch: memset of the barrier words failed\n"); return; }
    a.ph_lo = 0; a.ph_hi = NPHASE;
    void* kargs[] = {&a};
    hipError_t e = hipLaunchCooperativeKernel((const void*)fwd_kernel<true>, dim3(grid), dim3(NTHREADS), kargs, LDS_BYTES, stream);
    if (e != hipSuccess) fprintf(stderr, "cooperative launch failed: %s (grid %d)\n", hipGetErrorString(e), grid);
#else
    for (int p = 0; p < NPHASE; ++p) {
        a.ph_lo = p; a.ph_hi = p + 1;
        hipLaunchKernelGGL(fwd_kernel<false>, dim3(grid), dim3(NTHREADS), LDS_BYTES, stream, a);
    }
#endif
}
```
